# Optimizing an MI355X kernel written in HIP

```python
import math
import jax
import jax.numpy as jnp
from jax import lax
import numpy as np

D_MODEL = 1024
BATCH = 2
SEQ = 8192
DEPTH = 2

GRID_W = 64
CTX_LEN = 256
EPS = 1e-6
N_MOD = 6
F32 = jnp.float32

FNET_GROUPS = 4
FNET_GROUP_DIM = 64
FNET_DIM = FNET_GROUPS * FNET_GROUP_DIM
NA_HEADS = 4
NA_HEAD_DIM = 64
NA_DIM = NA_HEADS * NA_HEAD_DIM
NA_WIN_ROWS = 8
NA_WIN_COLS = 16
CONV_DIM = 256
CONV_WIDTH = 3
DIFF_HEADS = 4
DIFF_QK_DIM = 32
DIFF_V_DIM = 64
DIFF_QK_WIDTH = DIFF_HEADS * 2 * DIFF_QK_DIM
DIFF_V_WIDTH = DIFF_HEADS * DIFF_V_DIM
ROPE_BASE = 10000.0
Q_BLOCK = 128
N_BRANCHES = 4
BRANCH_DIM = 256

OFF_A = 0
OFF_B_Q = OFF_A + FNET_DIM
OFF_B_K = OFF_B_Q + NA_DIM
OFF_B_V = OFF_B_K + NA_DIM
OFF_C_B = OFF_B_V + NA_DIM
OFF_C_C = OFF_C_B + CONV_DIM
OFF_C_X = OFF_C_C + CONV_DIM
OFF_D_Q = OFF_C_X + CONV_DIM
OFF_D_K = OFF_D_Q + DIFF_QK_WIDTH
OFF_D_V = OFF_D_K + DIFF_QK_WIDTH
IN_DIM = OFF_D_V + DIFF_V_WIDTH

N_EXPERTS = 256
TOP_K = 8
N_GROUPS = 8
TOPK_GROUPS = 4
EXPERT_DIM = 256
SHARED_DIM = 256
ROUTED_SCALE = 2.5
MOE_BLOCK = 128

kernel_name = 'hybrid_parallel_mixer_moe_dit'


def rmsnorm(x, g):
    xf = x.astype(F32)
    y = xf * lax.rsqrt(jnp.mean(xf * xf, axis=-1, keepdims=True) + EPS)
    return (y * g.astype(F32)).astype(x.dtype)


def ada_chunks(cvec, w, b):
    m = jax.nn.silu(cvec) @ w + b
    return jnp.split(m, N_MOD, axis=-1)


def modulate(h, shift, scale):
    return h * (1.0 + scale) + shift


def fourier_mix(u):
    b, n, _ = u.shape
    ug = u.reshape(b, n, FNET_GROUPS, FNET_GROUP_DIM).astype(F32)
    f = jnp.fft.fft2(ug, axes=(1, 3), norm='ortho').real
    return f.reshape(b, n, FNET_DIM).astype(u.dtype)


def short_conv_mix(gate_b, gate_c, xs, w_conv):
    u = gate_c * xs
    y = lax.conv_general_dilated(
        u, w_conv[:, None, :].astype(u.dtype), window_strides=(1,),
        padding=[(CONV_WIDTH // 2, CONV_WIDTH // 2)],
        dimension_numbers=('NWC', 'WIO', 'NWC'), feature_group_count=CONV_DIM)
    return gate_b * y


def neighbourhood_attention(q, k, v, k_ctx, v_ctx, rel_bias, rows):
    b, s, h, d = q.shape
    wr = min(NA_WIN_ROWS, rows)
    scale = d ** -0.5
    qg = q.reshape(b, rows, GRID_W, h, d)
    kg = k.reshape(b, rows, GRID_W, h, d)
    vg = v.reshape(b, rows, GRID_W, h, d)
    r = jnp.arange(rows)
    row_idx = jnp.clip(r - wr // 2, 0, rows - wr)[:, None] + jnp.arange(wr)[None, :]
    k_band = kg[:, row_idx]
    v_band = vg[:, row_idx]
    cq = jnp.arange(GRID_W)
    col_lo = jnp.clip(cq - NA_WIN_COLS // 2, 0, GRID_W - NA_WIN_COLS)
    col_ok = (cq[None, :] >= col_lo[:, None]) & (cq[None, :] < col_lo[:, None] + NA_WIN_COLS)
    dr_idx = row_idx - r[:, None] + NA_WIN_ROWS - 1
    dc_idx = jnp.clip(cq[None, :] - cq[:, None] + NA_WIN_COLS - 1, 0, 2 * NA_WIN_COLS - 2)
    bias = rel_bias[:, dr_idx[:, None, :, None], dc_idx[None, :, None, :]]
    s_win = jnp.einsum('brqhd,brwkhd->bhrqwk', qg, k_band).astype(F32) * scale + bias.astype(F32)
    s_win = jnp.where(col_ok[:, None, :], s_win, -jnp.inf)
    s_ctx = jnp.einsum('brqhd,blhd->bhrql', qg, k_ctx).astype(F32) * scale
    n_win = wr * GRID_W
    scores = jnp.concatenate([s_win.reshape(b, h, rows, GRID_W, n_win), s_ctx], axis=-1)
    p = jax.nn.softmax(scores, axis=-1).astype(v.dtype)
    p_win = p[..., :n_win].reshape(b, h, rows, GRID_W, wr, GRID_W)
    p_ctx = p[..., n_win:]
    o = (jnp.einsum('bhrqwk,brwkhd->brqhd', p_win, v_band)
         + jnp.einsum('bhrql,blhd->brqhd', p_ctx, v_ctx))
    return o.reshape(b, s, h * d)


def dense_attention(q, k, v):
    b, n, h, d = q.shape
    s = jnp.einsum('bqhd,bkhd->bhqk', q, k).astype(F32) * d ** -0.5
    p = jax.nn.softmax(s, axis=-1).astype(v.dtype)
    return jnp.einsum('bhqk,bkhd->bqhd', p, v).reshape(b, n, h * d)


def axial_rope_tables(row, col):
    half = DIFF_QK_DIM // 2
    inv = 1.0 / (ROPE_BASE ** (jnp.arange(0, half, 2, dtype=F32) / half))
    ang_r = row.astype(F32)[:, None] * inv
    ang_c = col.astype(F32)[:, None] * inv
    return (jnp.cos(ang_r), jnp.sin(ang_r), jnp.cos(ang_c), jnp.sin(ang_c))


def rotate_section(x, cos, sin):
    x1, x2 = jnp.split(x, 2, axis=-1)
    cos = cos[:, None, None, :].astype(x.dtype)
    sin = sin[:, None, None, :].astype(x.dtype)
    return jnp.concatenate([x1 * cos - x2 * sin, x1 * sin + x2 * cos], axis=-1)


def apply_axial_rope(x, tables):
    cos_r, sin_r, cos_c, sin_c = tables
    half = x.shape[-1] // 2
    return jnp.concatenate([rotate_section(x[..., :half], cos_r, sin_r),
                            rotate_section(x[..., half:], cos_c, sin_c)], axis=-1)


def diff_lambda_value(lp, lam_init):
    lp = lp.astype(F32)
    return jnp.exp(jnp.sum(lp[0] * lp[1])) - jnp.exp(jnp.sum(lp[2] * lp[3])) + lam_init


def diff_attention_dense(q, k, v, lam):
    s = jnp.einsum('bqhmd,bkhmd->bhmqk', q, k).astype(F32) * DIFF_QK_DIM ** -0.5
    p = jax.nn.softmax(s, axis=-1)
    a = (p[:, :, 0] - lam * p[:, :, 1]).astype(v.dtype)
    return jnp.einsum('bhqk,bkhd->bqhd', a, v)


def diff_attention_blocked(q, k, v, lam):
    b, s = q.shape[:2]
    nb = s // Q_BLOCK
    qb = jnp.moveaxis(q.reshape(b, nb, Q_BLOCK, DIFF_HEADS, 2, DIFF_QK_DIM), 1, 0)
    o = lax.map(lambda qi: diff_attention_dense(qi, k, v, lam), qb)
    return jnp.moveaxis(o, 0, 1).reshape(b, s, DIFF_HEADS, DIFF_V_DIM)


def diff_out(o, sub_g, lam_init):
    b, n = o.shape[:2]
    return (rmsnorm(o, sub_g) * (1.0 - lam_init)).reshape(b, n, DIFF_V_WIDTH)


def latent_branches(p, kv_b_ctx, kv_d_ctx, rows, rope, conv_w, rel_bias, lam, sub_g, lam_init):
    b, s, _ = p.shape
    l = kv_b_ctx.shape[1]
    y_a = fourier_mix(p[..., OFF_A:OFF_B_Q])
    q_b = p[..., OFF_B_Q:OFF_B_K].reshape(b, s, NA_HEADS, NA_HEAD_DIM)
    k_b = p[..., OFF_B_K:OFF_B_V].reshape(b, s, NA_HEADS, NA_HEAD_DIM)
    v_b = p[..., OFF_B_V:OFF_C_B].reshape(b, s, NA_HEADS, NA_HEAD_DIM)
    k_bc = kv_b_ctx[..., :NA_DIM].reshape(b, l, NA_HEADS, NA_HEAD_DIM)
    v_bc = kv_b_ctx[..., NA_DIM:].reshape(b, l, NA_HEADS, NA_HEAD_DIM)
    y_b = neighbourhood_attention(q_b, k_b, v_b, k_bc, v_bc, rel_bias, rows)
    y_c = short_conv_mix(p[..., OFF_C_B:OFF_C_C], p[..., OFF_C_C:OFF_C_X], p[..., OFF_C_X:OFF_D_Q], conv_w)
    q_d = apply_axial_rope(p[..., OFF_D_Q:OFF_D_K].reshape(b, s, DIFF_HEADS, 2, DIFF_QK_DIM), rope)
    k_d = apply_axial_rope(p[..., OFF_D_K:OFF_D_V].reshape(b, s, DIFF_HEADS, 2, DIFF_QK_DIM), rope)
    v_d = p[..., OFF_D_V:].reshape(b, s, DIFF_HEADS, DIFF_V_DIM)
    k_dc = kv_d_ctx[..., :DIFF_QK_WIDTH].reshape(b, l, DIFF_HEADS, 2, DIFF_QK_DIM)
    v_dc = kv_d_ctx[..., DIFF_QK_WIDTH:].reshape(b, l, DIFF_HEADS, DIFF_V_DIM)
    o_d = diff_attention_blocked(q_d, jnp.concatenate([k_d, k_dc], axis=1),
                                 jnp.concatenate([v_d, v_dc], axis=1), lam)
    y_d = diff_out(o_d, sub_g, lam_init)
    return [y_a, y_b, y_c, y_d]


def context_branches(pc, conv_w, lam, sub_g, lam_init):
    b, l, _ = pc.shape
    y_a = fourier_mix(pc[..., OFF_A:OFF_B_Q])
    q_b = pc[..., OFF_B_Q:OFF_B_K].reshape(b, l, NA_HEADS, NA_HEAD_DIM)
    k_b = pc[..., OFF_B_K:OFF_B_V].reshape(b, l, NA_HEADS, NA_HEAD_DIM)
    v_b = pc[..., OFF_B_V:OFF_C_B].reshape(b, l, NA_HEADS, NA_HEAD_DIM)
    y_b = dense_attention(q_b, k_b, v_b)
    y_c = short_conv_mix(pc[..., OFF_C_B:OFF_C_C], pc[..., OFF_C_C:OFF_C_X], pc[..., OFF_C_X:OFF_D_Q], conv_w)
    q_d = pc[..., OFF_D_Q:OFF_D_K].reshape(b, l, DIFF_HEADS, 2, DIFF_QK_DIM)
    k_d = pc[..., OFF_D_K:OFF_D_V].reshape(b, l, DIFF_HEADS, 2, DIFF_QK_DIM)
    v_d = pc[..., OFF_D_V:].reshape(b, l, DIFF_HEADS, DIFF_V_DIM)
    y_d = diff_out(diff_attention_dense(q_d, k_d, v_d, lam), sub_g, lam_init)
    return [y_a, y_b, y_c, y_d]


def merge_branches(h, branches, w_gate, w_branch, w_o):
    merged = jax.nn.sigmoid(h @ w_gate[0]) * (branches[0] @ w_branch[0])
    for i in range(1, N_BRANCHES):
        merged = merged + jax.nn.sigmoid(h @ w_gate[i]) * (branches[i] @ w_branch[i])
    return merged @ w_o


def route(h, w_router, bias):
    n = h.shape[0]
    scores = jax.nn.sigmoid((h @ w_router).astype(F32))
    grp = (scores + bias.astype(F32)).reshape(n, N_GROUPS, N_EXPERTS // N_GROUPS)
    grp_score = jnp.sum(lax.top_k(grp, 2)[0], axis=-1)
    _, grp_idx = lax.top_k(grp_score, TOPK_GROUPS)
    grp_mask = jnp.any(grp_idx[..., None] == jnp.arange(N_GROUPS), axis=-2)
    choice = jnp.where(grp_mask[..., None], grp, -jnp.inf).reshape(n, N_EXPERTS)
    _, idx = lax.top_k(choice, TOP_K)
    w = jnp.take_along_axis(scores, idx, axis=-1)
    w = w / jnp.sum(w, axis=-1, keepdims=True) * ROUTED_SCALE
    return idx, w


def routed_experts(h, idx, wts, w_g, w_u, w_d):
    n, d = h.shape
    a = n * TOP_K
    flat_e = idx.reshape(a)
    order = jnp.argsort(flat_e)
    sorted_e = flat_e[order]
    counts = jnp.bincount(flat_e, length=N_EXPERTS)
    padded = (counts + MOE_BLOCK - 1) // MOE_BLOCK * MOE_BLOCK
    pad_end = jnp.cumsum(padded)
    pad_start = pad_end - padded
    grp_start = jnp.cumsum(counts) - counts
    dest = pad_start[sorted_e] + jnp.arange(a) - grp_start[sorted_e]
    n_blocks = (a + N_EXPERTS * (MOE_BLOCK - 1)) // MOE_BLOCK
    n_rows = n_blocks * MOE_BLOCK
    row_tok = jnp.full((n_rows,), n, jnp.int32).at[dest].set((order // TOP_K).astype(jnp.int32))
    row_w = jnp.zeros((n_rows,), F32).at[dest].set(wts.reshape(a)[order])
    block_e = jnp.minimum(jnp.searchsorted(pad_end, jnp.arange(n_blocks) * MOE_BLOCK, side='right'),
                          N_EXPERTS - 1)
    h_pad = jnp.concatenate([h, jnp.zeros((1, d), h.dtype)], axis=0)

    def block(acc, args):
        toks, e, w = args
        xb = h_pad[toks]
        yb = (jax.nn.silu(xb @ w_g[e]) * (xb @ w_u[e])) @ w_d[e]
        return acc.at[toks].add(yb * w[:, None].astype(yb.dtype)), None

    acc, _ = lax.scan(block, jnp.zeros((n + 1, d), h.dtype),
                      (row_tok.reshape(n_blocks, MOE_BLOCK), block_e, row_w.reshape(n_blocks, MOE_BLOCK)))
    return acc[:n]


def moe_ffn(h, w_router, router_bias, w_g, w_u, w_d, sw_g, sw_u, sw_d):
    idx, wts = route(h, w_router, router_bias)
    shared = (jax.nn.silu(h @ sw_g) * (h @ sw_u)) @ sw_d
    return shared + routed_experts(h, idx, wts, w_g, w_u, w_d)


def setup_inputs(seed: int = 0) -> dict:
    key = jax.random.key(seed)
    ks = iter(jax.random.split(key, 32))
    D = D_MODEL

    def nrm(shape, scale):
        return jax.random.normal(next(ks), shape, F32) * scale

    return {
        'x': nrm((BATCH, SEQ, D), 1.0),
        'c': nrm((BATCH, D), 1.0),
        'ctx': nrm((BATCH, CTX_LEN, D), 1.0),
        'c_ctx': nrm((D,), 1.0),
        'ada_w': nrm((DEPTH, D, N_MOD * D), 0.3 * D ** -0.5),
        'ada_b': nrm((DEPTH, N_MOD * D), 0.02),
        'norm1_g': 1.0 + nrm((DEPTH, D), 0.02),
        'w_in': nrm((DEPTH, D, IN_DIM), D ** -0.5),
        'conv_w': nrm((DEPTH, CONV_WIDTH, CONV_DIM), CONV_WIDTH ** -0.5),
        'na_rel_bias': nrm((DEPTH, NA_HEADS, 2 * NA_WIN_ROWS - 1, 2 * NA_WIN_COLS - 1), 0.1),
        'diff_lambda': nrm((DEPTH, 4, DIFF_QK_DIM), 0.1),
        'diff_subln_g': 1.0 + nrm((DEPTH, DIFF_V_DIM), 0.02),
        'w_branch_gate': nrm((DEPTH, N_BRANCHES, D, D), D ** -0.5),
        'w_branch': nrm((DEPTH, N_BRANCHES, BRANCH_DIM, D), BRANCH_DIM ** -0.5),
        'w_out': nrm((DEPTH, D, D), D ** -0.5),
        'norm2_g': 1.0 + nrm((DEPTH, D), 0.02),
        'router_w': nrm((DEPTH, D, N_EXPERTS), D ** -0.5),
        'router_bias': nrm((DEPTH, N_EXPERTS), 0.01),
        'expert_w_gate': nrm((DEPTH, N_EXPERTS, D, EXPERT_DIM), D ** -0.5),
        'expert_w_up': nrm((DEPTH, N_EXPERTS, D, EXPERT_DIM), D ** -0.5),
        'expert_w_down': nrm((DEPTH, N_EXPERTS, EXPERT_DIM, D), EXPERT_DIM ** -0.5),
        'shared_w_gate': nrm((DEPTH, D, SHARED_DIM), D ** -0.5),
        'shared_w_up': nrm((DEPTH, D, SHARED_DIM), D ** -0.5),
        'shared_w_down': nrm((DEPTH, SHARED_DIM, D), SHARED_DIM ** -0.5),
        'final_norm_g': 1.0 + nrm((D,), 0.02),
    }


def reference(x, c, ctx, c_ctx, ada_w, ada_b, norm1_g, w_in, conv_w, na_rel_bias, diff_lambda,
              diff_subln_g, w_branch_gate, w_branch, w_out, norm2_g, router_w, router_bias,
              expert_w_gate, expert_w_up, expert_w_down, shared_w_gate, shared_w_up, shared_w_down,
              final_norm_g):
    b, s, d = x.shape
    l_ctx = ctx.shape[1]
    rows = s // GRID_W
    t = jnp.arange(s)
    rope = axial_rope_tables(t // GRID_W, t % GRID_W)
    xc = ctx
    for layer in range(DEPTH):
        last = layer == DEPTH - 1
        lam_init = 0.8 - 0.6 * math.exp(-0.3 * layer)
        lam = diff_lambda_value(diff_lambda[layer], lam_init)
        m_lat = [u[:, None, :] for u in ada_chunks(c, ada_w[layer], ada_b[layer])]
        m_ctx = ada_chunks(c_ctx, ada_w[layer], ada_b[layer])
        w_in_l = w_in[layer]

        h = modulate(rmsnorm(x, norm1_g[layer]), m_lat[0], m_lat[1])
        hc = modulate(rmsnorm(xc, norm1_g[layer]), m_ctx[0], m_ctx[1])
        p = h @ w_in_l
        if last:
            kv_b_ctx = hc @ w_in_l[:, OFF_B_K:OFF_C_B]
            kv_d_ctx = hc @ w_in_l[:, OFF_D_K:]
        else:
            pc = hc @ w_in_l
            kv_b_ctx = pc[..., OFF_B_K:OFF_C_B]
            kv_d_ctx = pc[..., OFF_D_K:]
        br = latent_branches(p, kv_b_ctx, kv_d_ctx, rows, rope, conv_w[layer], na_rel_bias[layer],
                             lam, diff_subln_g[layer], lam_init)
        x_new = x + m_lat[2] * merge_branches(h, br, w_branch_gate[layer], w_branch[layer], w_out[layer])
        if not last:
            brc = context_branches(pc, conv_w[layer], lam, diff_subln_g[layer], lam_init)
            xc = xc + m_ctx[2] * merge_branches(hc, brc, w_branch_gate[layer], w_branch[layer], w_out[layer])
        x = x_new

        h2 = modulate(rmsnorm(x, norm2_g[layer]), m_lat[3], m_lat[4]).reshape(b * s, d)
        if last:
            tokens = h2
        else:
            hc2 = modulate(rmsnorm(xc, norm2_g[layer]), m_ctx[3], m_ctx[4]).reshape(b * l_ctx, d)
            tokens = jnp.concatenate([h2, hc2], axis=0)
        y = moe_ffn(tokens, router_w[layer], router_bias[layer], expert_w_gate[layer], expert_w_up[layer],
                    expert_w_down[layer], shared_w_gate[layer], shared_w_up[layer], shared_w_down[layer])
        x = x + m_lat[5] * y[:b * s].reshape(b, s, d)
        if not last:
            xc = xc + m_ctx[5] * y[b * s:].reshape(b, l_ctx, d)
    return rmsnorm(x, final_norm_g)
```

```cpp
#include <hip/hip_runtime.h>
#include <cstdio>
#include <cstdint>

#define GAS __attribute__((address_space(1)))
#define LAS __attribute__((address_space(3)))
typedef unsigned short bf16_t;
typedef short bf16x8 __attribute__((ext_vector_type(8)));
typedef float f32x4 __attribute__((ext_vector_type(4)));
typedef float f32x2 __attribute__((ext_vector_type(2)));
typedef float f32x16 __attribute__((ext_vector_type(16)));
typedef unsigned u32x4 __attribute__((ext_vector_type(4)));
typedef unsigned u32x2 __attribute__((ext_vector_type(2)));

constexpr int DM = 1024, NBATCH = 2, SEQ = 8192, NLAT = NBATCH * SEQ, LCTX = 256, NCTX = NBATCH * LCTX, NTOK = NLAT + NCTX;
constexpr int IN_DIM = 2560, NEXP = 256, TOPK = 8, EDIM = 256, NKEY = SEQ + LCTX, NSLOT = 9;
constexpr float EPS = 1e-6f, LOG2E = 1.4426950408889634f;
constexpr float QD_SCALE = 0.17677669529663687f * LOG2E;
constexpr float QB_SCALE = 0.125f * LOG2E;

constexpr size_t MiB = 1u << 20;
constexpr size_t WS_CTL = 0, CTL_ZERO_BYTES = 1 * MiB;
constexpr size_t WS_MODS = 1 * MiB;
constexpr size_t WS_WIN = 2 * MiB, WS_WG = 12 * MiB, WS_WB = 28 * MiB, WS_WO = 32 * MiB, WS_WR = 36 * MiB, WS_WSGU = 37 * MiB  , WS_WSD = 39 * MiB  ;
constexpr size_t WS_X = 40 * MiB, WS_H = 106 * MiB, WS_P = 140 * MiB, WS_VTD = 224 * MiB, WS_VTB = 233 * MiB;
constexpr size_t WS_Z2R = 242 * MiB, WS_Z2I = 258 * MiB, WS_YBR = 274 * MiB, WS_PB = 308 * MiB, WS_MACC = 440 * MiB, WS_MRG = 506 * MiB;
constexpr size_t WS_LOG = 540 * MiB, WS_TOPW = 558 * MiB, WS_LIST = 560 * MiB, WS_YS = 580 * MiB, WS_TC = 880 * MiB  , WS_END = 888 * MiB;
constexpr int CW_TMO = 0, CW_BAR = 4096, CW_KMAX = 8192  , CW_ECNT = 12288  , CW_GS = 16384, CW_PROG = 49152  , CW_RANK = 32768  , CW_MOEQ = 65792  ;

typedef __bf16 bf16x2_t __attribute__((ext_vector_type(2)));
__device__ __forceinline__ unsigned pk2a(float lo, float hi) { unsigned r; asm("v_cvt_pk_bf16_f32 %0, %1, %2" : "=v"(r) : "v"(lo), "v"(hi)); return r; }
__device__ __forceinline__ unsigned pk2(float lo, float hi) { const f32x2 v = {lo, hi}; const bf16x2_t b = __builtin_convertvector(v, bf16x2_t); return __builtin_bit_cast(unsigned, b); }
__device__ __forceinline__ float bflo(unsigned w) { return __uint_as_float(w << 16); }
__device__ __forceinline__ float bfhi(unsigned w) { return __uint_as_float(w & 0xffff0000u); }
__device__ __forceinline__ float bf1(bf16_t b) { return __uint_as_float(((unsigned)b) << 16); }
__device__ __forceinline__ float ex2(float x) { return __builtin_amdgcn_exp2f(x); }
__device__ __forceinline__ int crow(int r, int hi) { return (r & 3) + 8 * (r >> 2) + 4 * hi; }
__device__ __forceinline__ float sx(float v, int o, int lane) { return __int_as_float(__builtin_amdgcn_ds_bpermute((lane ^ o) << 2, __float_as_int(v))); }
__device__ __forceinline__ int sxi(int v, int o, int lane) { return __builtin_amdgcn_ds_bpermute((lane ^ o) << 2, v); }
__device__ __forceinline__ float shf(float v, int src) { return __int_as_float(__builtin_amdgcn_ds_bpermute(src << 2, __float_as_int(v))); }
__device__ __forceinline__ float wave_sum(float v, int lane) {
#pragma unroll
    for (int o = 1; o < 64; o <<= 1) v += sx(v, o, lane);
    return v;
}
#define LDS_WAIT() asm volatile("s_waitcnt lgkmcnt(0)" ::: "memory")
#define VM_WAIT() asm volatile("s_waitcnt vmcnt(0)" ::: "memory")

#define XB_TMO      128
#define XB_XCNT(j)  (256  + 64 * (j))
#define XB_XSUB(j)  (1280 + 64 * (j))
#define XB_XGEN(j)  (2304 + 64 * (j))
#define XB_TOP      3328
#define XB_TOPGEN   3392
#define XCD_BAR_WORDS 3456
#define XB_SPIN_CAP (1u << 22)
__device__ __forceinline__ unsigned xb_ld(unsigned* p)              { return __hip_atomic_load(p, __ATOMIC_RELAXED, __HIP_MEMORY_SCOPE_AGENT); }
__device__ __forceinline__ unsigned xb_add(unsigned* p, unsigned v) { return __hip_atomic_fetch_add(p, v, __ATOMIC_RELAXED, __HIP_MEMORY_SCOPE_AGENT); }
__device__ __forceinline__ unsigned xb_xcc_id() { return (unsigned)__builtin_amdgcn_s_getreg((3 << 11) | 20) & 0xFu; }
#define XB_SPIN(cond, bar) do { unsigned _sp = 0; while (cond) { __builtin_amdgcn_s_sleep(1); \
    if ((++_sp & 255u) == 0u) { if (xb_ld(&(bar)[XB_TMO])) break; if (_sp > XB_SPIN_CAP) { atomicAdd(&(bar)[XB_TMO], 1u); break; } } } } while (0)
struct XcdBarrier { unsigned* bar; unsigned x; volatile LAS unsigned* st; };
__device__ __forceinline__ XcdBarrier xcd_barrier_post(unsigned* bar, volatile LAS unsigned* st) {
    XcdBarrier b; b.bar = bar; b.x = xb_xcc_id(); b.st = st;
    if (threadIdx.x == 0) (void)xb_add(&bar[XB_XCNT(b.x)], 1u);
    return b;
}
__device__ __forceinline__ void xcd_barrier_complete(unsigned* bar, unsigned x, unsigned& nloc, unsigned& nx) {
    const unsigned G = gridDim.x * gridDim.y * gridDim.z;
    unsigned sum, cnt, mine, sp = 0u;
    for (;;) {
        sum = 0u; cnt = 0u; mine = 0u;
#pragma unroll
        for (unsigned j = 0; j < 16; ++j) { const unsigned c = xb_ld(&bar[XB_XCNT(j)]); sum += c; cnt += (c > 0u) ? 1u : 0u; mine = (j == x) ? c : mine; }
        if (sum == G) break;
        __builtin_amdgcn_s_sleep(1);
        if ((++sp & 255u) == 0u) { if (xb_ld(&bar[XB_TMO])) break; if (sp > XB_SPIN_CAP) { atomicAdd(&bar[XB_TMO], 1u); break; } }
    }
    nloc = mine > 0u ? mine : 1u; nx = cnt > 0u ? cnt : 1u;
}
__device__ __forceinline__ void xcd_barrier(const XcdBarrier& b) {
    asm volatile("s_waitcnt vmcnt(0)" ::: "memory");
    __syncthreads();
    if (threadIdx.x == 0) {
        unsigned* bar = b.bar;
        __builtin_amdgcn_s_waitcnt(0);
        unsigned nloc = b.st[0], nx = b.st[1];
        if (nloc == 0u) { xcd_barrier_complete(bar, b.x, nloc, nx); b.st[0] = nloc; b.st[1] = nx; }
        const unsigned old = xb_add(&bar[XB_XSUB(b.x)], 1u);
        const unsigned gen = old / nloc;
        if (old + 1u == (gen + 1u) * nloc) {
            __builtin_amdgcn_fence(__ATOMIC_RELEASE, "agent");
            asm volatile("s_waitcnt vmcnt(0)" ::: "memory");
            const unsigned og = xb_add(&bar[XB_TOP], 1u);
            const unsigned tg = og / nx;
            if (og + 1u == (tg + 1u) * nx) xb_add(&bar[XB_TOPGEN], 1u);
            else XB_SPIN(xb_ld(&bar[XB_TOPGEN]) == tg, bar);
            __builtin_amdgcn_fence(__ATOMIC_ACQUIRE, "agent");
            xb_add(&bar[XB_XGEN(b.x)], 1u);
            asm volatile("s_waitcnt vmcnt(0)" ::: "memory");
        } else {
            XB_SPIN(xb_ld(&bar[XB_XGEN(b.x)]) == gen, bar);
            __builtin_amdgcn_fence(__ATOMIC_ACQUIRE, "agent");
            asm volatile("s_waitcnt vmcnt(0)" ::: "memory");
        }
    }
    __syncthreads();
}
namespace pg8 {
constexpr int BM = 256, BK = 64, HALF = 128, HTB = HALF * BK * 2, STAGE_BYTES = 8 * HTB, NXCD = 8, WGM = 8;
__host__ __device__ __forceinline__ int lds_byte(int r, int c) { const int st = (r >> 4) * 2 + (c >> 5), rr = r & 15, cc = c & 31, ob = rr * 64 + cc * 2; return st * 1024 + (ob ^ (((ob >> 9) & 1) << 5)); }
__host__ __device__ __forceinline__ void stage_rc(int b, int& R, int& C) { const int st = b / 1024, sb = b % 1024, swz = sb ^ (((sb >> 9) & 1) << 5); R = (st >> 1) * 16 + swz / 64; C = (st & 1) * 32 + (swz % 64) / 2; }
__host__ __device__ __forceinline__ int perm32(int rho) { const int n = rho >> 4, i = rho & 15; return 8 * (i >> 2) + 4 * n + (i & 3); }

struct Unit { int pm, pn, ao; };
struct Gemm { const bf16_t* A; const bf16_t* Bt; int lda, ldb, K; };

struct StaticOrder {
    int nM, nN, nwg, G, c, aostep = 0;
    __device__ void init(int M, int N, int G_, int c_) { nM = M / BM; nN = N / BM; nwg = nM * nN; G = G_; c = c_; }
    __device__ bool next(int i, Unit& u) const {
        const long L = (long)i * G + c; if (L >= nwg) return false;
        int wgid = (int)L; { const int q = nwg / NXCD, r = nwg % NXCD, xcd = wgid % NXCD, off = wgid / NXCD; wgid = (xcd < r ? xcd * (q + 1) : r * (q + 1) + (xcd - r) * q) + off; }
        const int nig = WGM * nN, gid = wgid / nig, fm = gid * WGM, gsz = (nM - fm) < WGM ? (nM - fm) : WGM;
        u.pm = fm + ((wgid % nig) % gsz); u.pn = (wgid % nig) / gsz; u.ao = (u.pn >> 2) * aostep; return true;
    }
};
struct ExtraOrder {
    StaticOrder base; int xpm, xpn;
    __device__ bool next(int i, Unit& u) const {
        const int nb = (base.c < base.nwg) ? (base.nwg - base.c + base.G - 1) / base.G : 0;
        if (i < nb) return base.next(i, u);
        if (i == nb && xpm >= 0) { u.pm = xpm; u.pn = xpn; u.ao = 0; return true; }
        return false;
    }
};
struct ComboOrder {
    int ncombo, G, c, aostep, xpm, xpn;
    __device__ bool next(int i, Unit& u) const {
        const int ncb = (c < ncombo) ? (ncombo - c + G - 1) / G : 0;
        if (i < 4 * ncb) { const int combo = c + (i >> 2) * G; const int g = i & 3; u.pm = combo >> 2; u.pn = g * 4 + (combo & 3); u.ao = g * aostep; return true; }
        if (i == 4 * ncb && xpm >= 0) { u.pm = xpm; u.pn = xpn; u.ao = (xpn >> 2) * aostep; return true; }
        return false;
    }
};
struct PanelOrder {
    int nM, G, c;
    __device__ bool next(int i, Unit& u) const { const int p = c + i * G; if (p >= nM) return false; u.pm = p; u.pn = 0; u.ao = 0; return true; }
};

template <class Epi, class Sched>
__device__ __forceinline__ void gemm_phase(LAS unsigned char* lds, const Gemm g, const Sched& S, const Epi& E, const int tid) {
    const int wid = __builtin_amdgcn_readfirstlane(tid >> 6), lane = tid & 63, wr = wid >> 2, wc = wid & 3, fr = lane & 15, fq = lane >> 4;
    const int K = g.K, nt = K / BK;
    unsigned voffA[2], voffB[2];
#pragma unroll
    for (int i = 0; i < 2; ++i) { int R, C; stage_rc(tid * 16 + i * 8192, R, C); const int Rb = Epi::PERM ? ((R & ~31) + perm32(R & 31)) : R;
        voffA[i] = (unsigned)(R * g.lda + C) * 2u; voffB[i] = (unsigned)(Rb * g.ldb + C) * 2u; }
    const size_t kstep = (size_t)(BK * 2);
    const size_t hsA = (size_t)HALF * g.lda * 2, hsB = (size_t)HALF * g.ldb * 2;
    const size_t tsA = 2 * hsA, tsB = 2 * hsB;
    const unsigned ldsw = (unsigned)wid * 1024u;
    const int aoff = lds_byte(wr * 64 + fr, fq * 8), boff = lds_byte(wc * 32 + fr, fq * 8);
#define PG8_SA(b, h) (((b) * 2 + (h)) * HTB)
#define PG8_SB(b, h) ((4 + (b) * 2 + (h)) * HTB)
#define PG8_STAGE(bufoff, gbase, voff) do { _Pragma("unroll") for (int _i = 0; _i < 2; ++_i) \
        __builtin_amdgcn_global_load_lds((const unsigned*)((const char*)(gbase) + (voff)[_i]), (LAS unsigned*)(lds + (bufoff) + ldsw + _i * 8192), 16, 0, 0); } while (0)
#define PG8_LDA(dst, b, h) do { _Pragma("unroll") for (int m = 0; m < 4; ++m) _Pragma("unroll") for (int k = 0; k < 2; ++k) dst[m][k] = *(const LAS bf16x8*)(lds + PG8_SA(b, h) + aoff + m * 2048 + k * 1024); } while (0)
#define PG8_LDB(dst, b, h) do { _Pragma("unroll") for (int n = 0; n < 2; ++n) _Pragma("unroll") for (int k = 0; k < 2; ++k) dst[n][k] = *(const LAS bf16x8*)(lds + PG8_SB(b, h) + boff + n * 2048 + k * 1024); } while (0)
#define PG8_MMA(ai, bj, At, Bt) do { __builtin_amdgcn_s_setprio(1); _Pragma("unroll") for (int m = 0; m < 4; ++m) _Pragma("unroll") for (int n = 0; n < 2; ++n) _Pragma("unroll") for (int k = 0; k < 2; ++k) \
        acc[ai][bj][m][n] = __builtin_amdgcn_mfma_f32_16x16x32_bf16(Bt[n][k], At[m][k], acc[ai][bj][m][n], 0, 0, 0); __builtin_amdgcn_s_setprio(0); } while (0)
#define PG8_WAIT_V(n) asm volatile("s_waitcnt vmcnt(" #n ")" ::: "memory")
#define PG8_WAIT_L(n) asm volatile("s_waitcnt lgkmcnt(" #n ")" ::: "memory")
#define PG8_BAR __builtin_amdgcn_s_barrier()
#define PG8_SCHED __builtin_amdgcn_sched_barrier(0)
    Unit cur, nxt; int ui = 0;
    if (!S.next(0, cur)) return;
    f32x4 acc[2][2][4][2];
#pragma unroll
    for (int a = 0; a < 2; ++a)
#pragma unroll
        for (int b = 0; b < 2; ++b)
#pragma unroll
            for (int m = 0; m < 4; ++m)
#pragma unroll
                for (int n = 0; n < 2; ++n) acc[a][b][m][n] = (f32x4){0.f, 0.f, 0.f, 0.f};
    bf16x8 At[4][2], B0[2][2], B1[2][2];
    const char* cA = (const char*)g.A + (size_t)cur.pm * tsA + (size_t)cur.ao * 2; const char* cB = (const char*)g.Bt + (size_t)cur.pn * tsB;
    PG8_STAGE(PG8_SB(0, 0), cB, voffB); PG8_STAGE(PG8_SB(0, 1), cB + hsB, voffB); PG8_STAGE(PG8_SA(0, 0), cA, voffA); PG8_STAGE(PG8_SA(0, 1), cA + hsA, voffA);
    if (wr == 1) PG8_BAR;
    PG8_WAIT_V(2); PG8_BAR;
    PG8_STAGE(PG8_SB(1, 0), cB + kstep, voffB); PG8_STAGE(PG8_SA(1, 0), cA + kstep, voffA); PG8_STAGE(PG8_SB(1, 1), cB + hsB + kstep, voffB);
    PG8_WAIT_V(6); PG8_BAR;
    for (;;) {
        const bool has_next = S.next(ui + 1, nxt);
        const char* nA = has_next ? (const char*)g.A + (size_t)nxt.pm * tsA + (size_t)nxt.ao * 2 : cA; const char* nB = has_next ? (const char*)g.Bt + (size_t)nxt.pn * tsB : cB;
#pragma unroll 1
        for (int t = 0; t < nt; t += 2) {
            const bool last = (t == nt - 2);
            const char* a1 = cA + (size_t)(t + 1) * kstep;
            const char* a2 = last ? nA : cA + (size_t)(t + 2) * kstep; const char* b2 = last ? nB : cB + (size_t)(t + 2) * kstep;
            const char* a3 = a2 + kstep; const char* b3 = b2 + kstep;
            PG8_LDB(B0, 0, 0); PG8_LDB(B1, 0, 1); PG8_SCHED; PG8_LDA(At, 0, 0); PG8_STAGE(PG8_SA(1, 1), a1 + hsA, voffA);
            PG8_WAIT_V(8); PG8_WAIT_L(0); PG8_BAR; PG8_MMA(0, 0, At, B0); PG8_MMA(0, 1, At, B1); PG8_BAR; PG8_SCHED;
            PG8_LDA(At, 0, 1); PG8_STAGE(PG8_SB(0, 0), b2, voffB); PG8_STAGE(PG8_SB(0, 1), b2 + hsB, voffB); PG8_STAGE(PG8_SA(0, 0), a2, voffA);
            PG8_WAIT_V(8); PG8_WAIT_L(0); PG8_BAR; PG8_MMA(1, 0, At, B0); PG8_MMA(1, 1, At, B1); PG8_BAR; PG8_SCHED;
            PG8_LDB(B0, 1, 0); PG8_LDB(B1, 1, 1); PG8_SCHED; PG8_LDA(At, 1, 0); PG8_STAGE(PG8_SA(0, 1), a2 + hsA, voffA);
            PG8_WAIT_V(8); PG8_WAIT_L(0); PG8_BAR; PG8_MMA(0, 0, At, B0); PG8_MMA(0, 1, At, B1); PG8_BAR; PG8_SCHED;
            PG8_LDA(At, 1, 1); PG8_STAGE(PG8_SB(1, 0), b3, voffB); PG8_STAGE(PG8_SB(1, 1), b3 + hsB, voffB); PG8_STAGE(PG8_SA(1, 0), a3, voffA);
            PG8_WAIT_V(8); PG8_WAIT_L(0); PG8_BAR; PG8_MMA(1, 0, At, B0); PG8_MMA(1, 1, At, B1); PG8_BAR; PG8_SCHED;
        }
        if (wr == 0) PG8_BAR;
        { int fr_ = fr, fq_ = fq; asm volatile("" : "+v"(fr_), "+v"(fq_)); E(acc, cur, wr, wc, fr_, fq_); }
        if (!has_next) break;
#pragma unroll
        for (int a = 0; a < 2; ++a)
#pragma unroll
            for (int b = 0; b < 2; ++b)
#pragma unroll
                for (int m = 0; m < 4; ++m)
#pragma unroll
                    for (int n = 0; n < 2; ++n) acc[a][b][m][n] = (f32x4){0.f, 0.f, 0.f, 0.f};
        cur = nxt; cA = nA; cB = nB; ++ui;
        if (wr == 1) PG8_BAR;
    }
    PG8_WAIT_V(0);
    PG8_BAR;
#undef PG8_SA
#undef PG8_SB
#undef PG8_STAGE
#undef PG8_LDA
#undef PG8_LDB
#undef PG8_MMA
#undef PG8_WAIT_V
#undef PG8_WAIT_L
#undef PG8_BAR
#undef PG8_SCHED
}
}
namespace pg8 {
struct EpiInproj {
    static constexpr bool PERM = true;
    bf16_t* P;
    __device__ __forceinline__ void operator()(const f32x4 (&acc)[2][2][4][2], const Unit& u, int wr, int wc, int fr, int fq) const {
        const int row0 = u.pm * BM + wr * 64 + fr, col0 = u.pn * BM + wc * 32 + 8 * fq;
        const bool rope = (u.pn == 7 || u.pn == 8) && (u.pm < NLAT / BM);
        const float sc = (u.pn == 7) ? QD_SCALE : (u.pn == 1 ? QB_SCALE : 1.0f);
#pragma unroll
        for (int ai = 0; ai < 2; ++ai)
#pragma unroll
            for (int m = 0; m < 4; ++m) {
                const int row = row0 + ai * HALF + m * 16;
                bf16_t* rowp = P + (size_t)row * IN_DIM + col0;
                float cs[8], sn[8];
                if (rope) {
                    const int t = row & (SEQ - 1); const float pos = (float)((fq < 2) ? (t >> 6) : (t & 63));
                    const float sg = (fq & 1) ? 1.0f : -1.0f;
#pragma unroll
                    for (int i = 0; i < 8; ++i) {
                        constexpr float INVREV[8] = {0.15915494309189535f, 0.050329212104487034f, 0.015915494309189534f, 0.0050329212104487035f,
                                                     0.0015915494309189536f, 0.00050329212104487036f, 0.00015915494309189535f, 0.000050329212104487036f};
                        const float rev = pos * INVREV[i]; const float fr_ = rev - __builtin_floorf(rev);
                        cs[i] = __builtin_amdgcn_cosf(fr_); sn[i] = __builtin_amdgcn_sinf(fr_) * sg;
                    }
                }
#pragma unroll
                for (int bj = 0; bj < 2; ++bj) {
                    float v[8];
#pragma unroll
                    for (int i = 0; i < 4; ++i) { v[i] = acc[ai][bj][m][0][i]; v[4 + i] = acc[ai][bj][m][1][i]; }
                    if (rope) {
#pragma unroll
                        for (int i = 0; i < 8; ++i) { const float pr = sx(v[i], 16, fr + 16 * fq); v[i] = v[i] * cs[i] + pr * sn[i]; }
                    }
                    u32x4 w; w.x = pk2a(v[0] * sc, v[1] * sc); w.y = pk2a(v[2] * sc, v[3] * sc); w.z = pk2a(v[4] * sc, v[5] * sc); w.w = pk2a(v[6] * sc, v[7] * sc);
                    *(u32x4*)(rowp + bj * HALF) = w;
                }
            }
    }
};
struct EpiBf16 {
    static constexpr bool PERM = true;
    bf16_t* O; int ldc;
    __device__ __forceinline__ void operator()(const f32x4 (&acc)[2][2][4][2], const Unit& u, int wr, int wc, int fr, int fq) const {
        const int row0 = u.pm * BM + wr * 64 + fr, col0 = u.pn * BM + wc * 32 + 8 * fq;
#pragma unroll
        for (int ai = 0; ai < 2; ++ai)
#pragma unroll
            for (int m = 0; m < 4; ++m) { bf16_t* rowp = O + (size_t)(row0 + ai * HALF + m * 16) * ldc + col0;
#pragma unroll
                for (int bj = 0; bj < 2; ++bj) { const f32x4 v0 = acc[ai][bj][m][0], v1 = acc[ai][bj][m][1];
                    u32x4 w; w.x = pk2a(v0[0], v0[1]); w.y = pk2a(v0[2], v0[3]); w.z = pk2a(v1[0], v1[1]); w.w = pk2a(v1[2], v1[3]);
                    *(u32x4*)(rowp + bj * HALF) = w; } }
    }
};
struct EpiGate {
    static constexpr bool PERM = true;
    const bf16_t* PB; bf16_t* MACC; bf16_t* MRG; float* TC;
    __device__ __forceinline__ void operator()(const f32x4 (&acc)[2][2][4][2], const Unit& u, int wr, int wc, int fr, int fq) const {
        const int gate = u.pn >> 2, ct = u.pn & 3;
        const int row0 = u.pm * BM + wr * 64 + fr, col0 = ct * BM + wc * 32 + 8 * fq;
        const bool ctx = u.pm >= NLAT / BM, rmw = !ctx && gate != 0;
#pragma unroll
        for (int ai = 0; ai < 2; ++ai)
#pragma unroll
            for (int m = 0; m < 4; ++m) {
                const size_t row = (size_t)(row0 + ai * HALF + m * 16);
                u32x4 pw[2], ow[2];
#pragma unroll
                for (int bj = 0; bj < 2; ++bj) { const int col = col0 + bj * HALF;
                    pw[bj] = *(const u32x4*)(PB + row * 4096 + gate * 1024 + col);
                    if (rmw) ow[bj] = *(const u32x4*)(MACC + row * DM + col); }
#pragma unroll
                for (int bj = 0; bj < 2; ++bj) {
                    const int col = col0 + bj * HALF;
                    float t[8];
                    const float pv[8] = {bflo(pw[bj].x), bfhi(pw[bj].x), bflo(pw[bj].y), bfhi(pw[bj].y), bflo(pw[bj].z), bfhi(pw[bj].z), bflo(pw[bj].w), bfhi(pw[bj].w)};
#pragma unroll
                    for (int i = 0; i < 8; ++i) { const float a = (i < 4) ? acc[ai][bj][m][0][i & 3] : acc[ai][bj][m][1][i & 3];
                        t[i] = pv[i] * __builtin_amdgcn_rcpf(1.0f + ex2(-a * LOG2E)); }
                    if (ctx) { float* tp = TC + ((size_t)gate * NCTX + (row - NLAT)) * DM + col;
                        *(f32x4*)tp = (f32x4){t[0], t[1], t[2], t[3]}; *(f32x4*)(tp + 4) = (f32x4){t[4], t[5], t[6], t[7]}; continue; }
                    if (rmw) {
#pragma unroll
                        for (int i = 0; i < 4; ++i) { t[2 * i] += bflo(ow[bj][i]); t[2 * i + 1] += bfhi(ow[bj][i]); } }
                    u32x4 w; w.x = pk2a(t[0], t[1]); w.y = pk2a(t[2], t[3]); w.z = pk2a(t[4], t[5]); w.w = pk2a(t[6], t[7]);
                    *(u32x4*)((gate != 3 ? MACC : MRG) + row * DM + col) = w;
                }
                asm volatile("" ::: "memory");
            }
    }
};
struct EpiGate4 {
    static constexpr bool PERM = true;
    const bf16_t* PB; bf16_t* MRG;
    __device__ __forceinline__ void operator()(const f32x4 (&acc)[2][2][4][2], const Unit& u, int wr, int wc, int fr, int fq) const {
        const int row0 = u.pm * BM + wr * 64 + fr, oc0 = u.pn * 64 + 16 * wc + 4 * fq;
#pragma unroll
        for (int ai = 0; ai < 2; ++ai)
#pragma unroll
            for (int m = 0; m < 4; ++m) {
                const size_t row = (size_t)(row0 + ai * HALF + m * 16);
                u32x2 pw[4];
#pragma unroll
                for (int g = 0; g < 4; ++g) pw[g] = *(const u32x2*)(PB + row * 4096 + g * 1024 + oc0);
                float t[4] = {0.f, 0.f, 0.f, 0.f};
#pragma unroll
                for (int g = 0; g < 4; ++g) { const f32x4 a = acc[ai][g >> 1][m][g & 1]; const float pv[4] = {bflo(pw[g].x), bfhi(pw[g].x), bflo(pw[g].y), bfhi(pw[g].y)};
#pragma unroll
                    for (int i = 0; i < 4; ++i) t[i] += pv[i] * __builtin_amdgcn_rcpf(1.0f + ex2(-a[i] * LOG2E)); }
                u32x2 w; w.x = pk2a(t[0], t[1]); w.y = pk2a(t[2], t[3]);
                *(u32x2*)(MRG + row * DM + oc0) = w;
                if (m & 1) asm volatile("" ::: "memory");
            }
    }
};
struct EpiResid {
    static constexpr bool PERM = false;
    const float* base_lat; const float* base_ctx; float* X; const float* mods;
    __device__ __forceinline__ void operator()(const f32x4 (&acc)[2][2][4][2], const Unit& u, int wr, int wc, int fr, int fq) const {
        const int row0 = u.pm * BM + wr * 64 + fr, col0 = u.pn * BM + wc * 32 + 4 * fq;
        const int vec = u.pm < 32 ? 0 : (u.pm < 64 ? 1 : 2);
        const float* gv = mods + (vec * 6 + 2) * DM;
        f32x4 g4[2][2];
#pragma unroll
        for (int bj = 0; bj < 2; ++bj)
#pragma unroll
            for (int n = 0; n < 2; ++n) g4[bj][n] = *(const f32x4*)(gv + col0 + bj * HALF + n * 16);
#pragma unroll
        for (int ai = 0; ai < 2; ++ai)
#pragma unroll
            for (int m = 0; m < 4; ++m) { const int row = row0 + ai * HALF + m * 16;
                const float* bp = (row < NLAT) ? base_lat + (size_t)row * DM : base_ctx + (size_t)(row - NLAT) * DM;
                float* xp = X + (size_t)row * DM;
#pragma unroll
                for (int bj = 0; bj < 2; ++bj)
#pragma unroll
                    for (int n = 0; n < 2; ++n) { const int c = col0 + bj * HALF + n * 16;
                        const f32x4 b = *(const f32x4*)(bp + c); *(f32x4*)(xp + c) = b + g4[bj][n] * acc[ai][bj][m][n]; }
                asm volatile("" ::: "memory"); }
    }
};
struct EpiSwiGLU {
    static constexpr bool PERM = true;
    bf16_t* ACT;
    __device__ __forceinline__ void operator()(const f32x4 (&acc)[2][2][4][2], const Unit& u, int wr, int wc, int fr, int fq) const {
        const int row0 = u.pm * BM + wr * 64 + fr, col0 = u.pn * 128 + wc * 32 + 8 * fq;
#pragma unroll
        for (int ai = 0; ai < 2; ++ai)
#pragma unroll
            for (int m = 0; m < 4; ++m) {
                float a[8];
#pragma unroll
                for (int i = 0; i < 8; ++i) { const float g = (i < 4) ? acc[ai][0][m][0][i & 3] : acc[ai][0][m][1][i & 3], uu = (i < 4) ? acc[ai][1][m][0][i & 3] : acc[ai][1][m][1][i & 3];
                    a[i] = g * __builtin_amdgcn_rcpf(1.0f + ex2(-g * LOG2E)) * uu; }
                u32x4 w; w.x = pk2a(a[0], a[1]); w.y = pk2a(a[2], a[3]); w.z = pk2a(a[4], a[5]); w.w = pk2a(a[6], a[7]);
                *(u32x4*)(ACT + (size_t)(row0 + ai * HALF + m * 16) * EDIM + col0) = w;
            }
    }
};
struct EpiSlot8 {
    static constexpr bool PERM = true;
    bf16_t* YSP;
    __device__ __forceinline__ void operator()(const f32x4 (&acc)[2][2][4][2], const Unit& u, int wr, int wc, int fr, int fq) const {
        const int row0 = u.pm * BM + wr * 64 + fr, col0 = u.pn * BM + wc * 32 + 8 * fq;
#pragma unroll
        for (int ai = 0; ai < 2; ++ai)
#pragma unroll
            for (int m = 0; m < 4; ++m) { bf16_t* rowp = YSP + ((size_t)(row0 + ai * HALF + m * 16) * NSLOT + 8) * DM + col0;
#pragma unroll
                for (int bj = 0; bj < 2; ++bj) { const f32x4 v0 = acc[ai][bj][m][0], v1 = acc[ai][bj][m][1];
                    u32x4 w; w.x = pk2a(v0[0], v0[1]); w.y = pk2a(v0[2], v0[3]); w.z = pk2a(v1[0], v1[1]); w.w = pk2a(v1[2], v1[3]);
                    *(u32x4*)(rowp + bj * HALF) = w; } }
    }
};
struct OffsetOrder {
    int nM, nN, G, c, off;
    __device__ bool next(int i, Unit& u) const { const int q = ((c + G - off) % G) + i * G; if (q >= nM * nN) return false; u.pm = q / nN; u.pn = q % nN; u.ao = 0; return true; }
};
struct EpiF32 {
    static constexpr bool PERM = false;
    float* C; int ldc;
    __device__ __forceinline__ void operator()(const f32x4 (&acc)[2][2][4][2], const Unit& u, int wr, int wc, int fr, int fq) const {
        const int row0 = u.pm * BM + wr * 64 + fr, col0 = u.pn * BM + wc * 32 + 4 * fq;
#pragma unroll
        for (int ai = 0; ai < 2; ++ai)
#pragma unroll
            for (int m = 0; m < 4; ++m) { float* rowp = C + (size_t)(row0 + ai * HALF + m * 16) * ldc + col0;
#pragma unroll
                for (int bj = 0; bj < 2; ++bj)
#pragma unroll
                    for (int n = 0; n < 2; ++n) *(f32x4*)(rowp + bj * HALF + n * 16) = acc[ai][bj][m][n]; }
    }
};
}
__device__ __forceinline__ void transpose_item(const float* W, int K, int N, bf16_t* WT, LAS float* scr, int item, int lane, int gu = 0) {
    const int nblk = N / 32, kb = item / nblk, nb = item % nblk, k0 = 64 * kb, n0 = 32 * nb;
    const int d0 = (gu == 1 || gu == 2) ? ((n0 >> 7) * 256 + (gu - 1) * 128 + (n0 & 127)) : n0;
    const int gg = (gu >= 3) ? (gu - 3) : -1;
#pragma unroll 8
    for (int i = 0; i < 32; ++i) { const int kk = 2 * i + (lane >> 5); scr[kk * 33 + (lane & 31)] = W[(size_t)(k0 + kk) * N + n0 + (lane & 31)]; }
    LDS_WAIT(); asm volatile("" ::: "memory");
    const int c = lane & 7;
#pragma unroll
    for (int j = 0; j < 4; ++j) { const int n = (lane >> 3) + 8 * j; const LAS float* s = scr + (8 * c) * 33 + n;
        u32x4 o; o.x = pk2(s[0 * 33], s[1 * 33]); o.y = pk2(s[2 * 33], s[3 * 33]); o.z = pk2(s[4 * 33], s[5 * 33]); o.w = pk2(s[6 * 33], s[7 * 33]);
        const int oc = n0 + n; const int drow = (gg >= 0) ? ((oc >> 6) * 256 + 128 * (gg >> 1) + 32 * ((oc >> 4) & 3) + 8 * ((oc >> 2) & 3) + 4 * (gg & 1) + (oc & 3)) : (d0 + n);
        *(u32x4*)(WT + (size_t)drow * K + k0 + 8 * c) = o; }
    LDS_WAIT(); asm volatile("" ::: "memory");
}

__device__ __forceinline__ void norm_mod_row(const f32x4 (&v)[4], const float* g, const float* shift, const float* scale, bf16_t* orow, int lane) {
    float ss = 0.f;
#pragma unroll
    for (int j = 0; j < 4; ++j) ss += (v[j].x * v[j].x + v[j].y * v[j].y) + (v[j].z * v[j].z + v[j].w * v[j].w);
    const float rstd = __builtin_amdgcn_rsqf(wave_sum(ss, lane) * (1.f / DM) + EPS);
#pragma unroll
    for (int j = 0; j < 4; ++j) {
        const int c = 4 * lane + 256 * j;
        const f32x4 gg = *(const f32x4*)(g + c), sh = *(const f32x4*)(shift + c), sc = *(const f32x4*)(scale + c);
        const f32x4 y = v[j] * rstd * gg * (sc + 1.0f) + sh;
        u32x2 w; w.x = pk2(y.x, y.y); w.y = pk2(y.z, y.w);
        *(u32x2*)(orow + c) = w;
    }
}

__device__ __forceinline__ void conv_phase(const bf16_t* P, const float* cw  , bf16_t* YBR, int ntok, int gtid, int gthreads) {
    for (int idx = gtid; idx < ntok * 32; idx += gthreads) {
        const int tok = idx >> 5, p = idx & 31;
        int t, n; if (tok < NLAT) { t = tok & (SEQ - 1); n = SEQ; } else { t = (tok - NLAT) & (LCTX - 1); n = LCTX; }
        const bf16_t* r = P + (size_t)tok * IN_DIM + 8 * p;
        const u32x4 gb = *(const u32x4*)(r + 1024);
        const u32x4 z = {0u, 0u, 0u, 0u};
        const u32x4 c0 = (t > 0) ? *(const u32x4*)(r - IN_DIM + 1280) : z, x0 = (t > 0) ? *(const u32x4*)(r - IN_DIM + 1536) : z;
        const u32x4 c1 = *(const u32x4*)(r + 1280), x1 = *(const u32x4*)(r + 1536);
        const u32x4 c2 = (t < n - 1) ? *(const u32x4*)(r + IN_DIM + 1280) : z, x2 = (t < n - 1) ? *(const u32x4*)(r + IN_DIM + 1536) : z;
        float o[8];
#pragma unroll
        for (int i = 0; i < 4; ++i) {
            const int ch = 8 * p + 2 * i;
            const float w00 = cw[ch], w01 = cw[256 + ch], w02 = cw[512 + ch], w10 = cw[ch + 1], w11 = cw[256 + ch + 1], w12 = cw[512 + ch + 1];
            const float u0l = bflo(c0[i]) * bflo(x0[i]), u0h = bfhi(c0[i]) * bfhi(x0[i]);
            const float u1l = bflo(c1[i]) * bflo(x1[i]), u1h = bfhi(c1[i]) * bfhi(x1[i]);
            const float u2l = bflo(c2[i]) * bflo(x2[i]), u2h = bfhi(c2[i]) * bfhi(x2[i]);
            o[2 * i] = bflo(gb[i]) * (w00 * u0l + w01 * u1l + w02 * u2l);
            o[2 * i + 1] = bfhi(gb[i]) * (w10 * u0h + w11 * u1h + w12 * u2h);
        }
        u32x4 w; w.x = pk2(o[0], o[1]); w.y = pk2(o[2], o[3]); w.z = pk2(o[4], o[5]); w.w = pk2(o[6], o[7]);
        *(u32x4*)(YBR + (size_t)tok * DM + 512 + 8 * p) = w;
    }
}

__device__ __forceinline__ int key_row(int b, int key) { return key < SEQ ? b * SEQ + key : NLAT + b * LCTX + (key - SEQ); }
__device__ __forceinline__ void kvprep_item(const bf16_t* P, bf16_t* VTD, bf16_t* VTB, unsigned* kmax, LAS unsigned char* lds, int b, int kblk, int tid) {
    LAS bf16_t* T = (LAS bf16_t*)lds;
    LAS unsigned* mx = (LAS unsigned*)(lds + 64 * 264 * 2);
    const int key0 = kblk * 64, row0 = key_row(b, key0);
    if (tid < 12) mx[tid] = 0u;
#pragma unroll
    for (int which = 0; which < 2; ++which) {
        const int coff = which ? 768 : 2304; bf16_t* VT = which ? VTB : VTD;
        __syncthreads();
#pragma unroll
        for (int j = 0; j < 4; ++j) { const int pid = tid + 512 * j, kr = pid >> 5, seg = pid & 31;
            *(LAS u32x4*)(T + kr * 264 + seg * 8) = *(const u32x4*)(P + (size_t)(row0 + kr) * IN_DIM + coff + seg * 8); }
        __syncthreads();
#pragma unroll
        for (int j = 0; j < 4; ++j) { const int pid = tid + 512 * j, col = pid >> 3, kp = pid & 7;
            unsigned w[4];
#pragma unroll
            for (int i = 0; i < 4; ++i) w[i] = (unsigned)T[(kp * 8 + 2 * i) * 264 + col] | ((unsigned)T[(kp * 8 + 2 * i + 1) * 264 + col] << 16);
            *(u32x4*)(VT + ((size_t)(b * 4 + (col >> 6)) * 64 + (col & 63)) * NKEY + key0 + kp * 8) = (u32x4){w[0], w[1], w[2], w[3]}; }
    }
    {
        const int kr = tid >> 3, hm = tid & 7;
        const bf16_t* rp = P + (size_t)(row0 + kr) * IN_DIM + hm * 32;
        float sd = 0.f, sb = 0.f;
#pragma unroll
        for (int j = 0; j < 4; ++j) { const u32x4 a = *(const u32x4*)(rp + 2048 + 8 * j), c = *(const u32x4*)(rp + 512 + 8 * j);
#pragma unroll
            for (int i = 0; i < 4; ++i) { sd += bflo(a[i]) * bflo(a[i]) + bfhi(a[i]) * bfhi(a[i]); sb += bflo(c[i]) * bflo(c[i]) + bfhi(c[i]) * bfhi(c[i]); } }
        sb += sx(sb, 1, tid & 63);
        atomicMax((unsigned*)&mx[hm], __float_as_uint(sd));
        if ((hm & 1) == 0) atomicMax((unsigned*)&mx[8 + (hm >> 1)], __float_as_uint(sb));
    }
    __syncthreads();
    if (tid < 8) atomicMax(&kmax[b * 8 + tid], mx[tid]);
    else if (tid < 12) atomicMax(&kmax[16 + b * 4 + (tid - 8)], mx[tid]);
    __syncthreads();
}
#define MFMA_F32(a, b, c) __builtin_amdgcn_mfma_f32_32x32x2f32((a), (b), (c), 0, 0, 0)
#define MFMA_BF(a, b, c) __builtin_amdgcn_mfma_f32_32x32x16_bf16((a), (b), (c), 0, 0, 0)
__device__ __forceinline__ f32x16 zero16() { f32x16 z;
#pragma unroll
    for (int i = 0; i < 16; ++i) z[i] = 0.f; return z; }
__device__ __forceinline__ void f1_unit(const bf16_t* P, float* Z2R, float* Z2I, LAS unsigned char* lds, int b, int c, int g, int tid) {
    LAS float* V = (LAS float*)lds;
    LAS float* tab = (LAS float*)(lds + 128 * 132 * 4);
    const int lane = tid & 63, w = __builtin_amdgcn_readfirstlane(tid >> 6), l32 = lane & 31, hi = lane >> 5;
    if (tid < 64) { const float x = (float)tid * (1.f / 64.f); tab[tid] = __builtin_amdgcn_cosf(x); tab[64 + tid] = __builtin_amdgcn_sinf(x); }
    else if (tid < 192) { const int i = tid - 64; const float x = (float)i * (1.f / 128.f); tab[128 + i] = __builtin_amdgcn_cosf(x); tab[256 + i] = __builtin_amdgcn_sinf(x); }
    __syncthreads();
    {
        const int mt = w >> 1, part = w & 1, r = mt * 32 + l32;
        const bf16_t* up = P + (size_t)(b * SEQ + r * 64 + c) * IN_DIM + g * 64;
        u32x4 uq[8];
#pragma unroll
        for (int i = 0; i < 8; ++i) uq[i] = *(const u32x4*)(up + 8 * i);
        f32x16 a0 = zero16(), a1 = zero16();
        const LAS float* tb = tab + part * 64; const float sgn = part ? -1.f : 1.f;
#pragma unroll
        for (int s = 0; s < 32; ++s) {
            const unsigned wv = uq[s >> 2][s & 3]; const float a = hi ? bfhi(wv) : bflo(wv);
            const int j = 2 * s + hi;
            const float b0 = tb[(j * l32) & 63] * sgn, b1 = tb[(j * (32 + l32)) & 63] * sgn;
            a0 = MFMA_F32(a, b0, a0); a1 = MFMA_F32(a, b1, a1);
        }
#pragma unroll
        for (int q = 0; q < 16; ++q) { const int rr = mt * 32 + crow(q, hi); V[rr * 132 + part * 64 + l32] = a0[q]; V[rr * 132 + part * 64 + 32 + l32] = a1[q]; }
    }
    __syncthreads();
    {
        const int mt = w >> 1, mh = w & 1, ka = mt * 32 + l32;
        f32x16 Tr = zero16(), Ti = zero16();
#pragma unroll 4
        for (int s = 0; s < 64; ++s) {
            const int r = 2 * s + hi, idx = (ka * r) & 127;
            const float aC = tab[128 + idx], aS = tab[256 + idx];
            const float bR = V[r * 132 + mh * 32 + l32], bI = V[r * 132 + 64 + mh * 32 + l32];
            Tr = MFMA_F32(aC, bR, Tr); Tr = MFMA_F32(aS, bI, Tr); Ti = MFMA_F32(aC, bI, Ti); Ti = MFMA_F32(-aS, bR, Ti);
        }
#pragma unroll
        for (int q = 0; q < 16; ++q) {
            const int k = mt * 32 + crow(q, hi); const float x = (float)((k * c) & 8191) * (1.f / 8192.f);
            const float cs = __builtin_amdgcn_cosf(x), sn = __builtin_amdgcn_sinf(x);
            const size_t o = ((((size_t)(b * 128 + k) * 4 + g) * 64 + c) * 64) + mh * 32 + l32;
            Z2R[o] = Tr[q] * cs + Ti[q] * sn; Z2I[o] = Ti[q] * cs - Tr[q] * sn;
        }
    }
    __syncthreads();
}

constexpr int F1_TSTR = 272, F1_TC = 0, F1_TS = 128 * F1_TSTR, F1_TF = 2 * 128 * F1_TSTR, F1_FSTR = 144, F1_VT = F1_TF + 128 * F1_FSTR;
__device__ __forceinline__ void f1b_tables(LAS unsigned char* lds, int tid) {
    for (int i = tid; i < 128 * 128; i += 512) { const int ka = i >> 7, r = i & 127; const float x = (float)((ka * r) & 127) * (1.f / 128.f);
        *(LAS bf16_t*)(lds + F1_TC + ka * F1_TSTR + r * 2) = (bf16_t)(pk2(__builtin_amdgcn_cosf(x), 0.f) & 0xffffu);
        *(LAS bf16_t*)(lds + F1_TS + ka * F1_TSTR + r * 2) = (bf16_t)(pk2(__builtin_amdgcn_sinf(x), 0.f) & 0xffffu); }
    for (int i = tid; i < 128 * 64; i += 512) { const int xx = i >> 6, j = i & 63; const float x = (float)((j * (xx & 63)) & 63) * (1.f / 64.f);
        const float v = (xx < 64) ? __builtin_amdgcn_cosf(x) : -__builtin_amdgcn_sinf(x);
        *(LAS bf16_t*)(lds + F1_TF + xx * F1_FSTR + j * 2) = (bf16_t)(pk2(v, 0.f) & 0xffffu); }
    __syncthreads();
}
__device__ __forceinline__ void f1b_unit(const bf16_t* P, float* Z2R, float* Z2I, LAS unsigned char* lds, int b, int c, int g, int tid) {
    const int lane = tid & 63, w = __builtin_amdgcn_readfirstlane(tid >> 6), l32 = lane & 31, hi = lane >> 5;
    {
        const int mt = w >> 1, xh = w & 1, r = mt * 32 + l32;
        const bf16_t* up = P + (size_t)(b * SEQ + r * 64 + c) * IN_DIM + g * 64;
        f32x16 a0 = zero16(), a1 = zero16();
#pragma unroll
        for (int ks = 0; ks < 4; ++ks) {
            const bf16x8 uf = *(const bf16x8*)(up + ks * 16 + 8 * hi);
            const bf16x8 f0 = *(const LAS bf16x8*)(lds + F1_TF + (xh * 64 + l32) * F1_FSTR + (ks * 16 + 8 * hi) * 2), f1 = *(const LAS bf16x8*)(lds + F1_TF + (xh * 64 + 32 + l32) * F1_FSTR + (ks * 16 + 8 * hi) * 2);
            a0 = MFMA_BF(uf, f0, a0); a1 = MFMA_BF(uf, f1, a1);
        }
#pragma unroll
        for (int rg = 0; rg < 4; ++rg) {
            const int r0 = mt * 32 + 8 * rg + 4 * hi;
            u32x2 v0, v1; v0.x = pk2(a0[4 * rg], a0[4 * rg + 1]); v0.y = pk2(a0[4 * rg + 2], a0[4 * rg + 3]); v1.x = pk2(a1[4 * rg], a1[4 * rg + 1]); v1.y = pk2(a1[4 * rg + 2], a1[4 * rg + 3]);
            *(LAS u32x2*)(lds + F1_VT + (xh * 64 + l32) * F1_TSTR + r0 * 2) = v0; *(LAS u32x2*)(lds + F1_VT + (xh * 64 + 32 + l32) * F1_TSTR + r0 * 2) = v1;
            if (xh == 0) { v0.x ^= 0x80008000u; v0.y ^= 0x80008000u; v1.x ^= 0x80008000u; v1.y ^= 0x80008000u;
                *(LAS u32x2*)(lds + F1_VT + (128 + l32) * F1_TSTR + r0 * 2) = v0; *(LAS u32x2*)(lds + F1_VT + (160 + l32) * F1_TSTR + r0 * 2) = v1; }
        }
    }
    __syncthreads();
    {
        const int mt = w >> 1, mh = w & 1;
        f32x16 Tr = zero16(), Ti = zero16();
#pragma unroll
        for (int ks = 0; ks < 8; ++ks) {
            const int ko = (ks * 16 + 8 * hi) * 2;
            const bf16x8 aC = *(const LAS bf16x8*)(lds + F1_TC + (mt * 32 + l32) * F1_TSTR + ko), aS = *(const LAS bf16x8*)(lds + F1_TS + (mt * 32 + l32) * F1_TSTR + ko);
            const bf16x8 bR = *(const LAS bf16x8*)(lds + F1_VT + (mh * 32 + l32) * F1_TSTR + ko), bI = *(const LAS bf16x8*)(lds + F1_VT + (64 + mh * 32 + l32) * F1_TSTR + ko),
                         bN = *(const LAS bf16x8*)(lds + F1_VT + (128 + mh * 32 + l32) * F1_TSTR + ko);
            Tr = MFMA_BF(aC, bR, Tr); Tr = MFMA_BF(aS, bI, Tr); Ti = MFMA_BF(aC, bI, Ti); Ti = MFMA_BF(aS, bN, Ti);
        }
#pragma unroll
        for (int q = 0; q < 16; ++q) {
            const int k = mt * 32 + crow(q, hi); const float x = (float)((k * c) & 8191) * (1.f / 8192.f);
            const float cs = __builtin_amdgcn_cosf(x), sn = __builtin_amdgcn_sinf(x);
            const size_t o = ((((size_t)(b * 128 + k) * 4 + g) * 64 + c) * 64) + mh * 32 + l32;
            Z2R[o] = Tr[q] * cs + Ti[q] * sn; Z2I[o] = Ti[q] * cs - Tr[q] * sn;
        }
    }
    __syncthreads();
}
__device__ __forceinline__ void f2_unit(const float* Z2R, const float* Z2I, bf16_t* YBR, LAS unsigned char* lds, int b, int ka, int tid) {
    LAS float* tab = (LAS float*)lds;
    const int lane = tid & 63, w = __builtin_amdgcn_readfirstlane(tid >> 6), l32 = lane & 31, hi = lane >> 5;
    if (tid < 64) { const float x = (float)tid * (1.f / 64.f); tab[tid] = __builtin_amdgcn_cosf(x); tab[64 + tid] = __builtin_amdgcn_sinf(x); }
    __syncthreads();
    const int g = w >> 1, kbh = w & 1, kb = kbh * 32 + l32;
    const size_t base = ((size_t)(b * 128 + ka) * 4 + g) * 4096;
    f32x16 Y0 = zero16(), Y1 = zero16();
#pragma unroll 4
    for (int s = 0; s < 32; ++s) {
        const int c = 2 * s + hi, idx = (kb * c) & 63;
        const float aC = tab[idx], aS = tab[64 + idx];
        const float r0 = Z2R[base + c * 64 + l32], r1 = Z2R[base + c * 64 + 32 + l32], i0 = Z2I[base + c * 64 + l32], i1 = Z2I[base + c * 64 + 32 + l32];
        Y0 = MFMA_F32(aC, r0, Y0); Y0 = MFMA_F32(aS, i0, Y0); Y1 = MFMA_F32(aC, r1, Y1); Y1 = MFMA_F32(aS, i1, Y1);
    }
    constexpr float NORM = 0.0013810679320049757f;
#pragma unroll
    for (int q = 0; q < 16; ++q) {
        const int kbo = kbh * 32 + crow(q, hi); bf16_t* op = YBR + (size_t)(b * SEQ + ka + 128 * kbo) * DM + g * 64 + l32;
        op[0] = (bf16_t)(pk2(Y0[q] * NORM, 0.f) & 0xffffu); op[32] = (bf16_t)(pk2(Y1[q] * NORM, 0.f) & 0xffffu);
    }
    __syncthreads();
}

__device__ __forceinline__ void f2b_unit(const float* Z2R, const float* Z2I, bf16_t* YBR, LAS unsigned char* lds, int b, int ka, int tid) {
    const int lane = tid & 63, w = __builtin_amdgcn_readfirstlane(tid >> 6), l32 = lane & 31, hi = lane >> 5;
    for (int i = tid; i < 64 * 64; i += 512) { const int kb = i >> 6, cc = i & 63; const float x = (float)((kb * cc) & 63) * (1.f / 64.f);
        *(LAS bf16_t*)(lds + kb * 144 + cc * 2) = (bf16_t)(pk2(__builtin_amdgcn_cosf(x), 0.f) & 0xffffu);
        *(LAS bf16_t*)(lds + 9216 + kb * 144 + cc * 2) = (bf16_t)(pk2(__builtin_amdgcn_sinf(x), 0.f) & 0xffffu); }
    const int g = w >> 1, nt = w & 1;
    LAS unsigned char* zt = lds + 18432 + w * 9216;
    const size_t base = ((size_t)(b * 128 + ka) * 4 + g) * 4096 + nt * 32;
    {
        const int cp = lane >> 3, m4 = lane & 7;
#pragma unroll
        for (int part = 0; part < 2; ++part) {
            const float* zp = (part ? Z2I : Z2R) + base + 4 * m4;
#pragma unroll
            for (int j = 0; j < 4; ++j) { const int c0 = 2 * cp + 16 * j;
                const f32x4 v0 = *(const f32x4*)(zp + (size_t)c0 * 64), v1 = *(const f32x4*)(zp + (size_t)(c0 + 1) * 64);
#pragma unroll
                for (int q = 0; q < 4; ++q) *(LAS unsigned*)(zt + part * 4608 + (4 * m4 + q) * 144 + c0 * 2) = pk2(v0[q], v1[q]); }
        }
    }
    __syncthreads();
    f32x16 Y0 = zero16(), Y1 = zero16();
#pragma unroll
    for (int ks = 0; ks < 4; ++ks) {
        const int ko = (ks * 16 + 8 * hi) * 2;
        const bf16x8 bR = *(const LAS bf16x8*)(zt + l32 * 144 + ko), bI = *(const LAS bf16x8*)(zt + 4608 + l32 * 144 + ko);
        const bf16x8 c0 = *(const LAS bf16x8*)(lds + l32 * 144 + ko), s0 = *(const LAS bf16x8*)(lds + 9216 + l32 * 144 + ko);
        const bf16x8 c1 = *(const LAS bf16x8*)(lds + (32 + l32) * 144 + ko), s1 = *(const LAS bf16x8*)(lds + 9216 + (32 + l32) * 144 + ko);
        Y0 = MFMA_BF(c0, bR, Y0); Y0 = MFMA_BF(s0, bI, Y0); Y1 = MFMA_BF(c1, bR, Y1); Y1 = MFMA_BF(s1, bI, Y1);
    }
    constexpr float NORM = 0.0013810679320049757f;
#pragma unroll
    for (int q = 0; q < 16; ++q) {
        const int kb0 = crow(q, hi); bf16_t* op = YBR + (size_t)(b * SEQ + ka + 128 * kb0) * DM + g * 64 + nt * 32 + l32;
        op[0] = (bf16_t)(pk2(Y0[q] * NORM, 0.f) & 0xffffu); op[(size_t)128 * 32 * DM] = (bf16_t)(pk2(Y1[q] * NORM, 0.f) & 0xffffu);
    }
    __syncthreads();
}

constexpr int FC_TF = 0, FC_TC = 18432, FC_TS = FC_TC + 32 * 528, FC_VT = FC_TS + 32 * 528;
__device__ __forceinline__ void fctxb_unit(const bf16_t* P, bf16_t* YBR, LAS unsigned char* lds, int b, int g, int kq, int tid) {
    const int lane = tid & 63, w = __builtin_amdgcn_readfirstlane(tid >> 6), l32 = lane & 31, hi = lane >> 5;
    for (int i = tid; i < 128 * 64; i += 512) { const int xx = i >> 6, j = i & 63; const float x = (float)((j * (xx & 63)) & 63) * (1.f / 64.f);
        const float v = (xx < 64) ? __builtin_amdgcn_cosf(x) : -__builtin_amdgcn_sinf(x);
        *(LAS bf16_t*)(lds + FC_TF + xx * 144 + j * 2) = (bf16_t)(pk2(v, 0.f) & 0xffffu); }
    for (int i = tid; i < 32 * 256; i += 512) { const int kk = i >> 8, t = i & 255; const float x = (float)(((kq * 32 + kk) * t) & 255) * (1.f / 256.f);
        *(LAS bf16_t*)(lds + FC_TC + kk * 528 + t * 2) = (bf16_t)(pk2(__builtin_amdgcn_cosf(x), 0.f) & 0xffffu);
        *(LAS bf16_t*)(lds + FC_TS + kk * 528 + t * 2) = (bf16_t)(pk2(__builtin_amdgcn_sinf(x), 0.f) & 0xffffu); }
    __syncthreads();
    {
        const int t = w * 32 + l32;
        const bf16_t* up = P + (size_t)(NLAT + b * LCTX + t) * IN_DIM + g * 64;
        f32x16 a[4] = {zero16(), zero16(), zero16(), zero16()};
#pragma unroll
        for (int ks = 0; ks < 4; ++ks) {
            const bf16x8 uf = *(const bf16x8*)(up + ks * 16 + 8 * hi);
#pragma unroll
            for (int xt = 0; xt < 4; ++xt) { const bf16x8 ff = *(const LAS bf16x8*)(lds + FC_TF + (xt * 32 + l32) * 144 + (ks * 16 + 8 * hi) * 2); a[xt] = MFMA_BF(uf, ff, a[xt]); }
        }
#pragma unroll
        for (int xt = 0; xt < 4; ++xt)
#pragma unroll
            for (int rg = 0; rg < 4; ++rg) { u32x2 v; v.x = pk2(a[xt][4 * rg], a[xt][4 * rg + 1]); v.y = pk2(a[xt][4 * rg + 2], a[xt][4 * rg + 3]);
                *(LAS u32x2*)(lds + FC_VT + (xt * 32 + l32) * 528 + (w * 32 + 8 * rg + 4 * hi) * 2) = v; }
    }
    __syncthreads();
    if (w < 2) {
        f32x16 Y = zero16();
#pragma unroll
        for (int ks = 0; ks < 16; ++ks) {
            const int ko = (ks * 16 + 8 * hi) * 2;
            const bf16x8 aC = *(const LAS bf16x8*)(lds + FC_TC + l32 * 528 + ko), aS = *(const LAS bf16x8*)(lds + FC_TS + l32 * 528 + ko);
            const bf16x8 bR = *(const LAS bf16x8*)(lds + FC_VT + (w * 32 + l32) * 528 + ko), bI = *(const LAS bf16x8*)(lds + FC_VT + (64 + w * 32 + l32) * 528 + ko);
            Y = MFMA_BF(aC, bR, Y); Y = MFMA_BF(aS, bI, Y);
        }
#pragma unroll
        for (int q = 0; q < 16; ++q) { const int ko = kq * 32 + crow(q, hi);
            YBR[(size_t)(NLAT + b * LCTX + ko) * DM + g * 64 + w * 32 + l32] = (bf16_t)(pk2(Y[q] * (1.f / 128.f), 0.f) & 0xffffu); }
    }
    __syncthreads();
}
__device__ __forceinline__ void fctx_unit(const bf16_t* P, bf16_t* YBR, LAS unsigned char* lds, int b, int g, int kq, int tid) {
    LAS float* V = (LAS float*)lds;
    LAS float* tab = (LAS float*)(lds + 256 * 132 * 4);
    const int lane = tid & 63, w = __builtin_amdgcn_readfirstlane(tid >> 6), l32 = lane & 31, hi = lane >> 5;
    if (tid < 64) { const float x = (float)tid * (1.f / 64.f); tab[tid] = __builtin_amdgcn_cosf(x); tab[64 + tid] = __builtin_amdgcn_sinf(x); }
    else if (tid < 320) { const int i = tid - 64; const float x = (float)i * (1.f / 256.f); tab[128 + i] = __builtin_amdgcn_cosf(x); tab[384 + i] = __builtin_amdgcn_sinf(x); }
    __syncthreads();
    {
        const int t = w * 32 + l32;
        const bf16_t* up = P + (size_t)(NLAT + b * LCTX + t) * IN_DIM + g * 64;
        u32x4 uq[8];
#pragma unroll
        for (int i = 0; i < 8; ++i) uq[i] = *(const u32x4*)(up + 8 * i);
        f32x16 a0 = zero16(), a1 = zero16(), a2 = zero16(), a3 = zero16();
#pragma unroll
        for (int s = 0; s < 32; ++s) {
            const unsigned wv = uq[s >> 2][s & 3]; const float a = hi ? bfhi(wv) : bflo(wv);
            const int j = 2 * s + hi, i0 = (j * l32) & 63, i1 = (j * (32 + l32)) & 63;
            a0 = MFMA_F32(a, tab[i0], a0); a1 = MFMA_F32(a, tab[i1], a1); a2 = MFMA_F32(a, -tab[64 + i0], a2); a3 = MFMA_F32(a, -tab[64 + i1], a3);
        }
#pragma unroll
        for (int q = 0; q < 16; ++q) { const int rr = w * 32 + crow(q, hi); LAS float* vp = V + rr * 132 + l32; vp[0] = a0[q]; vp[32] = a1[q]; vp[64] = a2[q]; vp[96] = a3[q]; }
    }
    __syncthreads();
    {
        const int mt = w >> 1, nt = w & 1, k = kq * 128 + mt * 32 + l32;
        f32x16 Y = zero16();
#pragma unroll 4
        for (int s = 0; s < 128; ++s) {
            const int t = 2 * s + hi, idx = (k * t) & 255;
            const float aC = tab[128 + idx], aS = tab[384 + idx];
            const float bR = V[t * 132 + nt * 32 + l32], bI = V[t * 132 + 64 + nt * 32 + l32];
            Y = MFMA_F32(aC, bR, Y); Y = MFMA_F32(aS, bI, Y);
        }
#pragma unroll
        for (int q = 0; q < 16; ++q) { const int ko = kq * 128 + mt * 32 + crow(q, hi);
            YBR[(size_t)(NLAT + b * LCTX + ko) * DM + g * 64 + nt * 32 + l32] = (bf16_t)(pk2(Y[q] * (1.f / 128.f), 0.f) & 0xffffu); }
    }
    __syncthreads();
}
__device__ __forceinline__ bf16x8 mk8(u32x2 lo, u32x2 hi) { u32x4 t = {lo.x, lo.y, hi.x, hi.y}; return __builtin_bit_cast(bf16x8, t); }
__device__ __forceinline__ float ssq8(bf16x8 v) { const u32x4 t = __builtin_bit_cast(u32x4, v); float s = 0.f;
#pragma unroll
    for (int i = 0; i < 4; ++i) s += bflo(t[i]) * bflo(t[i]) + bfhi(t[i]) * bfhi(t[i]);
    return s; }
__device__ __forceinline__ bf16x8 packp(const f32x16& p, int j) { u32x4 t = {pk2(p[8 * j], p[8 * j + 1]), pk2(p[8 * j + 2], p[8 * j + 3]), pk2(p[8 * j + 4], p[8 * j + 5]), pk2(p[8 * j + 6], p[8 * j + 7])}; return __builtin_bit_cast(bf16x8, t); }

constexpr int DA_KSTR = 144, DA_TILE = 64 * DA_KSTR;
__device__ __forceinline__ float sum16(const f32x16& S) {
    float a, b;
    asm("s_nop 0\n\tv_add_f32 %0, %2, %3\n\tv_add_f32 %1, %4, %5\n\tv_add_f32 %0, %0, %6\n\tv_add_f32 %1, %1, %7\n\tv_add_f32 %0, %0, %8\n\tv_add_f32 %1, %1, %9\n\t"
        "v_add_f32 %0, %0, %10\n\tv_add_f32 %1, %1, %11\n\tv_add_f32 %0, %0, %12\n\tv_add_f32 %1, %1, %13\n\tv_add_f32 %0, %0, %14\n\tv_add_f32 %1, %1, %15\n\t"
        "v_add_f32 %0, %0, %16\n\tv_add_f32 %1, %1, %17\n\tv_add_f32 %0, %0, %1"
        : "=&v"(a), "=&v"(b)
        : "v"(S[0]), "v"(S[1]), "v"(S[2]), "v"(S[3]), "v"(S[4]), "v"(S[5]), "v"(S[6]), "v"(S[7]), "v"(S[8]), "v"(S[9]), "v"(S[10]), "v"(S[11]), "v"(S[12]), "v"(S[13]), "v"(S[14]), "v"(S[15]));
    return a;
}
template <bool FAST>
__device__ __forceinline__ void diff_loop(const bf16_t* P, const bf16_t* vsrc, LAS unsigned char* Kl, LAS unsigned char* Vl, const bf16x8 (&qf)[2][2], const float (&nb)[2],
                                          f32x16 (&O)[2][2], float (&ls)[2], int b, int h, int kt0, int kt1, int sr, int sg, int l32, int hi) {
    u32x4 kreg, vreg;
    { const int key0 = kt0 * 64; kreg = *(const u32x4*)(P + (size_t)key_row(b, key0 + sr) * IN_DIM + 2048 + h * 64 + sg * 8); vreg = *(const u32x4*)(vsrc + key0); }
    *(LAS u32x4*)(Kl + sr * DA_KSTR + sg * 16) = kreg; *(LAS u32x4*)(Vl + sr * DA_KSTR + sg * 16) = vreg;
    __syncthreads();
    for (int kt = kt0; kt < kt1; ++kt) {
        const int buf = (kt - kt0) & 1;
        if (kt + 1 < kt1) { const int key0 = (kt + 1) * 64; kreg = *(const u32x4*)(P + (size_t)key_row(b, key0 + sr) * IN_DIM + 2048 + h * 64 + sg * 8); vreg = *(const u32x4*)(vsrc + key0); }
        const LAS unsigned char* Kb = Kl + buf * DA_TILE; const LAS unsigned char* Vb = Vl + buf * DA_TILE;
#pragma unroll
        for (int kb = 0; kb < 2; ++kb) {
            bf16x8 pb[2][2];
#pragma unroll
            for (int mp = 0; mp < 2; ++mp) {
                f32x16 S;
                if (FAST) S = zero16();
                else {
#pragma unroll
                    for (int i = 0; i < 16; ++i) S[i] = nb[mp];
                }
#pragma unroll
                for (int ks = 0; ks < 2; ++ks) { const bf16x8 kf = *(const LAS bf16x8*)(Kb + (kb * 32 + l32) * DA_KSTR + (mp * 32 + ks * 16 + 8 * hi) * 2); S = MFMA_BF(kf, qf[mp][ks], S); }
#pragma unroll
                for (int i = 0; i < 16; ++i) S[i] = ex2(S[i]);
                ls[mp] += sum16(S);
                pb[mp][0] = packp(S, 0); pb[mp][1] = packp(S, 1);
            }
#pragma unroll
            for (int t = 0; t < 2; ++t)
#pragma unroll
                for (int j = 0; j < 2; ++j) {
                    const LAS unsigned char* vp = Vb + (t * 32 + l32) * DA_KSTR + (kb * 32 + 16 * j + 4 * hi) * 2;
                    const bf16x8 vf = mk8(*(const LAS u32x2*)vp, *(const LAS u32x2*)(vp + 16));
                    O[0][t] = MFMA_BF(vf, pb[0][j], O[0][t]); O[1][t] = MFMA_BF(vf, pb[1][j], O[1][t]);
                }
        }
        if (kt + 1 < kt1) { *(LAS u32x4*)(Kl + (buf ^ 1) * DA_TILE + sr * DA_KSTR + sg * 16) = kreg; *(LAS u32x4*)(Vl + (buf ^ 1) * DA_TILE + sr * DA_KSTR + sg * 16) = vreg; }
        __syncthreads();
    }
}
template <bool ALLOW_FAST>
__device__ __forceinline__ void diff_unit(const bf16_t* P, const bf16_t* VTD, bf16_t* YBR, const float* subg, float lam, float lam_init, const unsigned* kmax,
                                          LAS unsigned char* lds, int b, int h, int qrow0, int kt0, int kt1, int tid) {
    const int lane = tid & 63, w = __builtin_amdgcn_readfirstlane(tid >> 6), l32 = lane & 31, hi = lane >> 5;
    LAS unsigned char* Kl = lds; LAS unsigned char* Vl = lds + 2 * DA_TILE;
    const int qrow = qrow0 + 32 * w + l32;
    bf16x8 qf[2][2];
#pragma unroll
    for (int mp = 0; mp < 2; ++mp)
#pragma unroll
        for (int ks = 0; ks < 2; ++ks) qf[mp][ks] = *(const bf16x8*)(P + (size_t)qrow * IN_DIM + 1792 + h * 64 + mp * 32 + ks * 16 + 8 * hi);
    float nb[2];
#pragma unroll
    for (int mp = 0; mp < 2; ++mp) { float s = ssq8(qf[mp][0]) + ssq8(qf[mp][1]); s += sx(s, 32, lane);
        nb[mp] = -(__builtin_sqrtf(s * __uint_as_float(kmax[b * 8 + h * 2 + mp])) * 1.0002f + 0.01f); }
    f32x16 O[2][2]; float ls[2] = {0.f, 0.f};
#pragma unroll
    for (int mp = 0; mp < 2; ++mp)
#pragma unroll
        for (int t = 0; t < 2; ++t) O[mp][t] = zero16();
    const int sr = tid >> 3, sg = tid & 7;
    const bf16_t* vsrc = VTD + ((size_t)(b * 4 + h) * 64 + sr) * NKEY + sg * 8;
    if (ALLOW_FAST && __all(nb[0] > -64.f && nb[1] > -64.f)) diff_loop<true>(P, vsrc, Kl, Vl, qf, nb, O, ls, b, h, kt0, kt1, sr, sg, l32, hi);
    else diff_loop<false>(P, vsrc, Kl, Vl, qf, nb, O, ls, b, h, kt0, kt1, sr, sg, l32, hi);
    ls[0] += sx(ls[0], 32, lane); ls[1] += sx(ls[1], 32, lane);
    const float i0 = 1.0f / ls[0], i1 = lam / ls[1];
    float ss = 0.f;
#pragma unroll
    for (int t = 0; t < 2; ++t)
#pragma unroll
        for (int i = 0; i < 16; ++i) { const float o = O[0][t][i] * i0 - O[1][t][i] * i1; O[0][t][i] = o; ss += o * o; }
    ss += sx(ss, 32, lane);
    const float rs = __builtin_amdgcn_rsqf(ss * (1.f / 64.f) + EPS) * (1.0f - lam_init);
    bf16_t* op = YBR + (size_t)qrow * DM + 768 + h * 64;
#pragma unroll
    for (int t = 0; t < 2; ++t)
#pragma unroll
        for (int rg = 0; rg < 4; ++rg) { const int d0 = t * 32 + 8 * rg + 4 * hi; const f32x4 gg = *(const f32x4*)(subg + d0);
            u32x2 wv; wv.x = pk2(O[0][t][4 * rg] * rs * gg.x, O[0][t][4 * rg + 1] * rs * gg.y); wv.y = pk2(O[0][t][4 * rg + 2] * rs * gg.z, O[0][t][4 * rg + 3] * rs * gg.w);
            *(u32x2*)(op + d0) = wv; }
}

constexpr int NA_KSTR = 528, NA_KT = 32 * NA_KSTR, NA_VSTR = 80, NA_VT = 256 * NA_VSTR, NA_BIAS_OFF = 2 * NA_KT + 2 * NA_VT;
__device__ __forceinline__ void na_unit(const bf16_t* P, const bf16_t* VTB, bf16_t* YBR, const float* relb  , const unsigned* kmax,
                                        LAS unsigned char* lds, int b, int r, int qrow0, int nwin, int tid) {
    const int lane = tid & 63, w = __builtin_amdgcn_readfirstlane(tid >> 6), l32 = lane & 31, hi = lane >> 5;
    const int h = w >> 1, qb = w & 1;
    LAS unsigned char* Kl = lds; LAS unsigned char* Vl = lds + 2 * NA_KT; LAS float* bl = (LAS float*)(lds + NA_BIAS_OFF);
    const int R0 = min(max(r - 4, 0), 120);
    for (int i = tid; i < 4 * 15 * 32; i += 512) { const int hd = i >> 5, dc = i & 31; bl[i] = (dc < 31) ? relb[hd * 31 + dc] * LOG2E : -1e30f; }
    const int qrow = qrow0 + 32 * qb + l32, qc = 32 * qb + l32;
    bf16x8 qf[4];
#pragma unroll
    for (int ks = 0; ks < 4; ++ks) qf[ks] = *(const bf16x8*)(P + (size_t)qrow * IN_DIM + 256 + h * 64 + ks * 16 + 8 * hi);
    __syncthreads();
    float mb = 0.f;
    if (nwin) { for (int i = lane; i < 465; i += 64) mb = fmaxf(mb, fabsf(relb[h * 465 + i]) * LOG2E);
#pragma unroll
        for (int o = 1; o < 64; o <<= 1) mb = fmaxf(mb, sx(mb, o, lane)); }
    float nb; { float s = ssq8(qf[0]) + ssq8(qf[1]) + ssq8(qf[2]) + ssq8(qf[3]); s += sx(s, 32, lane);
        nb = -(__builtin_sqrtf(s * __uint_as_float(kmax[16 + b * 4 + h])) * 1.0002f + mb + 0.01f); }
    f32x16 O[2] = {zero16(), zero16()}; float ls = 0.f;
    const int ntile = nwin + 8;
    u32x4 kreg[2], vreg[2];
#define NA_LOAD(tile) do { int krow0, vkey0; if ((tile) < nwin) { const int kr = R0 + ((tile) >> 1); vkey0 = kr * 64 + 32 * ((tile) & 1); krow0 = b * SEQ + vkey0; } \
        else { const int j_ = (tile) - nwin; vkey0 = SEQ + 32 * j_; krow0 = NLAT + b * LCTX + 32 * j_; } \
        _Pragma("unroll") for (int j = 0; j < 2; ++j) { const int pid = tid + 512 * j; \
            kreg[j] = *(const u32x4*)(P + (size_t)(krow0 + (pid >> 5)) * IN_DIM + 512 + (pid & 31) * 8); \
            const int rowhd = pid >> 2; vreg[j] = *(const u32x4*)(VTB + ((size_t)(b * 4 + (rowhd >> 6)) * 64 + (rowhd & 63)) * NKEY + vkey0 + (pid & 3) * 8); } } while (0)
#define NA_STORE(buf) do { _Pragma("unroll") for (int j = 0; j < 2; ++j) { const int pid = tid + 512 * j; \
            *(LAS u32x4*)(Kl + (buf) * NA_KT + (pid >> 5) * NA_KSTR + (pid & 31) * 16) = kreg[j]; \
            *(LAS u32x4*)(Vl + (buf) * NA_VT + (pid >> 2) * NA_VSTR + (pid & 3) * 16) = vreg[j]; } } while (0)
    NA_LOAD(0); NA_STORE(0);
    __syncthreads();
    const int col_lo = min(max(qc - 8, 0), 48);
    int boff[2][16];
#pragma unroll
    for (int hf = 0; hf < 2; ++hf)
#pragma unroll
        for (int i = 0; i < 16; ++i) { const int kc = 32 * hf + crow(i, hi); const bool ok = (kc >= col_lo) && (kc < col_lo + 16); boff[hf][i] = 4 * (ok ? (kc - qc + 15) : 31); }
    for (int tile0 = 0; tile0 < ntile; tile0 += 2) {
#pragma unroll
    for (int tb = 0; tb < 2; ++tb) {
        const int tile = tile0 + tb, buf = tb;
        if (tile + 1 < ntile) NA_LOAD(tile + 1);
        const LAS unsigned char* Kb = Kl + buf * NA_KT; const LAS unsigned char* Vb = Vl + buf * NA_VT;
        f32x16 S;
#pragma unroll
        for (int i = 0; i < 16; ++i) S[i] = nb;
#pragma unroll
        for (int ks = 0; ks < 4; ++ks) { const bf16x8 kf = *(const LAS bf16x8*)(Kb + l32 * NA_KSTR + (h * 64 + ks * 16 + 8 * hi) * 2); S = MFMA_BF(kf, qf[ks], S); }
        float ps = 0.f;
        if (tile < nwin) {
            const int kr = R0 + (tile >> 1);
            const LAS unsigned char* bp = (const LAS unsigned char*)(bl + (h * 15 + (kr - r + 7)) * 32);
#pragma unroll
            for (int i = 0; i < 16; ++i) { const float bv = *(const LAS float*)(bp + boff[tb][i]); S[i] = ex2(S[i] + bv); ps += S[i]; }
        } else {
#pragma unroll
            for (int i = 0; i < 16; ++i) { S[i] = ex2(S[i]); ps += S[i]; }
        }
        ls += ps;
        const bf16x8 p0 = packp(S, 0), p1 = packp(S, 1);
#pragma unroll
        for (int t = 0; t < 2; ++t) {
            const LAS unsigned char* vp = Vb + (h * 64 + t * 32 + l32) * NA_VSTR + (4 * hi) * 2;
            const bf16x8 v0 = mk8(*(const LAS u32x2*)vp, *(const LAS u32x2*)(vp + 16)), v1 = mk8(*(const LAS u32x2*)(vp + 32), *(const LAS u32x2*)(vp + 48));
            O[t] = MFMA_BF(v0, p0, O[t]); O[t] = MFMA_BF(v1, p1, O[t]);
        }
        if (tile + 1 < ntile) NA_STORE(buf ^ 1);
        __syncthreads();
    }
    }
#undef NA_LOAD
#undef NA_STORE
    ls += sx(ls, 32, lane);
    const float il = 1.0f / ls;
    bf16_t* op = YBR + (size_t)qrow * DM + 256 + h * 64;
#pragma unroll
    for (int t = 0; t < 2; ++t)
#pragma unroll
        for (int rg = 0; rg < 4; ++rg) { const int d0 = t * 32 + 8 * rg + 4 * hi;
            u32x2 wv; wv.x = pk2(O[t][4 * rg] * il, O[t][4 * rg + 1] * il); wv.y = pk2(O[t][4 * rg + 2] * il, O[t][4 * rg + 3] * il);
            *(u32x2*)(op + d0) = wv; }
}
constexpr int MO_META = 2048, MO_XSTR = 144, MO_XT = 128 * MO_XSTR, MO_ASTR = 528, MO_WT_OFF = MO_META + 2 * MO_XT, MO_ACT_OFF = MO_WT_OFF + 8 * 4096;
__device__ __forceinline__ void moe_wt_store(LAS unsigned char* wt, const f32x4 (&f)[4], int kq, int n4) {
#pragma unroll
    for (int c = 0; c < 4; ++c) { u32x2 d; d.x = pk2(f[0][c], f[1][c]); d.y = pk2(f[2][c], f[3][c]);
        *(LAS u32x2*)(wt + (4 * n4 + c) * 64 + (((kq >> 1) ^ (n4 & 3)) << 4) + ((kq & 1) << 3)) = d; }
}
__device__ __forceinline__ bf16x8 moe_wt_frag(const LAS unsigned char* wt, int n, int gi) { return *(const LAS bf16x8*)(wt + n * 64 + ((gi ^ ((n >> 2) & 3)) << 4)); }
constexpr int MO_ROWS = 128, MO_D = 1, MO_D2 = 2;
template <int NMT>
__device__ __forceinline__ void moe_unit(const float* __restrict__ Wg, const float* __restrict__ Wu, const float* __restrict__ Wd, const bf16_t* __restrict__ H2, bf16_t* YS,
                                         LAS unsigned char* lds, int nrows, int tid) {
    const int lane = tid & 63, w = __builtin_amdgcn_readfirstlane(tid >> 6), l32 = lane & 31, hi = lane >> 5, kq = lane >> 3, n4 = lane & 7;
    LAS int* rtok = (LAS int*)lds; LAS int* rslot = rtok + 128; LAS float* rw = (LAS float*)(rslot + 128);
    LAS unsigned char* Xl = lds + MO_META; LAS unsigned char* Al = lds + MO_ACT_OFF; LAS unsigned char* wt = lds + MO_WT_OFF + w * 4096;
    VM_WAIT();
    {
        f32x16 ag[NMT], au[NMT];
#pragma unroll
        for (int m = 0; m < NMT; ++m) { ag[m] = zero16(); au[m] = zero16(); }
        const int n0 = 32 * w;
        const unsigned woff = (unsigned)((4 * kq) * EDIM + n0 + 4 * n4);
#define GP4(k, j) (*(const f32x4*)(Wg + (size_t)((k) + (j)) * EDIM + woff))
#define UP4(k, j) (*(const f32x4*)(Wu + (size_t)((k) + (j)) * EDIM + woff))
        const int xr0 = tid >> 3, xr1 = (tid + 512) >> 3, xs = tid & 7;
        const bf16_t* xp0 = H2 + (size_t)max(rtok[xr0], 0) * DM + xs * 8; const bf16_t* xp1 = H2 + (size_t)max(rtok[xr1], 0) * DM + xs * 8;
        u32x4 xa = *(const u32x4*)xp0, xb = xa; if (NMT > 2) xb = *(const u32x4*)xp1;
        *(LAS u32x4*)(Xl + xr0 * MO_XSTR + xs * 16) = xa; if (NMT > 2) *(LAS u32x4*)(Xl + xr1 * MO_XSTR + xs * 16) = xb;
        f32x4 fg[MO_D][4], fu[MO_D][4];
#pragma unroll
        for (int h = 0; h < MO_D; ++h)
#pragma unroll
            for (int j = 0; j < 4; ++j) { fg[h][j] = GP4(h * 32, j); fu[h][j] = UP4(h * 32, j); }
        __syncthreads();
        for (int kc = 0; kc < 16; ++kc) {
            const int buf = kc & 1;
            if (kc + 1 < 16) { xa = *(const u32x4*)(xp0 + (kc + 1) * 64); if (NMT > 2) xb = *(const u32x4*)(xp1 + (kc + 1) * 64); }
#pragma unroll
            for (int hf = 0; hf < 2; ++hf) {
                moe_wt_store(wt, fg[hf % MO_D], kq, n4); moe_wt_store(wt + 2048, fu[hf % MO_D], kq, n4);
                __builtin_amdgcn_sched_barrier(0);
                const int knext = kc * 64 + (hf + MO_D) * 32;
                if (knext < DM) {
#pragma unroll
                    for (int j = 0; j < 4; ++j) { fg[hf % MO_D][j] = GP4(knext, j); fu[hf % MO_D][j] = UP4(knext, j); }
                }
                __builtin_amdgcn_sched_barrier(0);
#pragma unroll
                for (int ks = 0; ks < 2; ++ks) {
                    const bf16x8 wgf = moe_wt_frag(wt, l32, 2 * ks + hi), wuf = moe_wt_frag(wt + 2048, l32, 2 * ks + hi);
#pragma unroll
                    for (int m = 0; m < NMT; ++m) {
                        const bf16x8 xf = *(const LAS bf16x8*)(Xl + buf * MO_XT + (m * 32 + l32) * MO_XSTR + (hf * 32 + ks * 16 + 8 * hi) * 2);
                        ag[m] = MFMA_BF(wgf, xf, ag[m]); au[m] = MFMA_BF(wuf, xf, au[m]);
                    }
                }
                __builtin_amdgcn_sched_barrier(0);
            }
            if (kc + 1 < 16) { *(LAS u32x4*)(Xl + (buf ^ 1) * MO_XT + xr0 * MO_XSTR + xs * 16) = xa; if (NMT > 2) *(LAS u32x4*)(Xl + (buf ^ 1) * MO_XT + xr1 * MO_XSTR + xs * 16) = xb; }
            __syncthreads();
        }
#pragma unroll
        for (int m = 0; m < NMT; ++m) {
#pragma unroll
            for (int rg = 0; rg < 4; ++rg) {
                float a[4];
#pragma unroll
                for (int i = 0; i < 4; ++i) { const float g = ag[m][4 * rg + i]; a[i] = g * __builtin_amdgcn_rcpf(1.0f + ex2(-g * LOG2E)) * au[m][4 * rg + i]; }
                u32x2 wv; wv.x = pk2(a[0], a[1]); wv.y = pk2(a[2], a[3]);
                *(LAS u32x2*)(Al + (m * 32 + l32) * MO_ASTR + (n0 + 8 * rg + 4 * hi) * 2) = wv;
            }
        }
#undef GP4
#undef UP4
    }
    __syncthreads();
#pragma unroll 1
    for (int pass = 0; pass < 2; ++pass) {
        const int c0 = 128 * w + 64 * pass;
        VM_WAIT();
        f32x16 ac[2][NMT];
#pragma unroll
        for (int n = 0; n < 2; ++n)
#pragma unroll
            for (int m = 0; m < NMT; ++m) ac[n][m] = zero16();
        const unsigned doff = (unsigned)((4 * kq) * DM + c0 + 4 * n4);
#define DP4(k, j, n) (*(const f32x4*)(Wd + (size_t)((k) + (j)) * DM + (n) * 32 + doff))
        f32x4 f0[MO_D2][4], f1[MO_D2][4];
#pragma unroll
        for (int h = 0; h < MO_D2; ++h)
#pragma unroll
            for (int j = 0; j < 4; ++j) { f0[h][j] = DP4(h * 32, j, 0); f1[h][j] = DP4(h * 32, j, 1); }
#pragma unroll
        for (int kh = 0; kh < 8; ++kh) {
            moe_wt_store(wt, f0[kh % MO_D2], kq, n4); moe_wt_store(wt + 2048, f1[kh % MO_D2], kq, n4);
            __builtin_amdgcn_sched_barrier(0);
            if (kh + MO_D2 < 8) {
#pragma unroll
                for (int j = 0; j < 4; ++j) { f0[kh % MO_D2][j] = DP4((kh + MO_D2) * 32, j, 0); f1[kh % MO_D2][j] = DP4((kh + MO_D2) * 32, j, 1); }
            }
            __builtin_amdgcn_sched_barrier(0);
#pragma unroll
            for (int ks = 0; ks < 2; ++ks) {
                const bf16x8 w0 = moe_wt_frag(wt, l32, 2 * ks + hi), w1 = moe_wt_frag(wt + 2048, l32, 2 * ks + hi);
#pragma unroll
                for (int m = 0; m < NMT; ++m) {
                    const bf16x8 af = *(const LAS bf16x8*)(Al + (m * 32 + l32) * MO_ASTR + (kh * 32 + ks * 16 + 8 * hi) * 2);
                    ac[0][m] = MFMA_BF(w0, af, ac[0][m]); ac[1][m] = MFMA_BF(w1, af, ac[1][m]);
                }
            }
            __builtin_amdgcn_sched_barrier(0);
        }
#undef DP4
        int ln2 = lane; asm volatile("" : "+v"(ln2));
        const int l32e = ln2 & 31, hie = ln2 >> 5;
#pragma unroll
        for (int m = 0; m < NMT; ++m) {
            const float wt_ = rw[m * 32 + l32e];
#pragma unroll
            for (int n = 0; n < 2; ++n)
#pragma unroll
                for (int rg = 0; rg < 4; ++rg) { u32x2 wv; wv.x = pk2(ac[n][m][4 * rg] * wt_, ac[n][m][4 * rg + 1] * wt_); wv.y = pk2(ac[n][m][4 * rg + 2] * wt_, ac[n][m][4 * rg + 3] * wt_);
                    *(LAS u32x2*)(wt + l32e * 128 + (((n * 4 + rg) ^ (l32e & 7)) << 4) + hie * 8) = wv; }
#pragma unroll
            for (int jj = 0; jj < 4; ++jj) { const int rl = (ln2 >> 3) + 8 * jj, sg_ = ln2 & 7, grow = m * 32 + rl;
                const u32x4 v = *(const LAS u32x4*)(wt + rl * 128 + ((sg_ ^ (rl & 7)) << 4));
                if (grow < nrows) *(u32x4*)(YS + (size_t)rslot[grow] * DM + c0 + sg_ * 8) = v; }
        }
    }
    __syncthreads();
}

__device__ __forceinline__ void route_token(const float* logits, const float* rbias, int tok, unsigned* ecnt, int* lists, float* topw, int lane) {
    const f32x4 lg = *(const f32x4*)(logits + (size_t)tok * NEXP + 4 * lane);
    const f32x4 bs = *(const f32x4*)(rbias + 4 * lane);
    float sc[4], sel[4];
#pragma unroll
    for (int i = 0; i < 4; ++i) { sc[i] = 1.0f / (1.0f + __expf(-lg[i])); sel[i] = sc[i] + bs[i]; }
    float t1 = fmaxf(fmaxf(sel[0], sel[1]), fmaxf(sel[2], sel[3]));
    float t2; { const float a = fmaxf(sel[0], sel[1]), bq = fminf(sel[0], sel[1]), c = fmaxf(sel[2], sel[3]), d = fminf(sel[2], sel[3]); t2 = fmaxf(fminf(a, c), fmaxf(bq, d)); }
#pragma unroll
    for (int o = 1; o < 8; o <<= 1) { const float o1 = sx(t1, o, lane), o2 = sx(t2, o, lane); const float n1 = fmaxf(t1, o1); t2 = fmaxf(fminf(t1, o1), fmaxf(t2, o2)); t1 = n1; }
    const float gs = t1 + t2; const int grp = lane >> 3;
    int rank = 0;
#pragma unroll
    for (int j = 0; j < 8; ++j) { const float oj = shf(gs, 8 * j); rank += (oj > gs || (oj == gs && j < grp)) ? 1 : 0; }
    const bool gsel = rank < 4;
    float cand[4];
#pragma unroll
    for (int i = 0; i < 4; ++i) cand[i] = gsel ? sel[i] : -__builtin_inff();
    float wk[8]; int ek[8]; float wsum = 0.f;
#pragma unroll
    for (int k = 0; k < 8; ++k) {
        float bv = cand[0]; int bi = 0;
#pragma unroll
        for (int i = 1; i < 4; ++i) if (cand[i] > bv) { bv = cand[i]; bi = i; }
        int be = 4 * lane + bi;
#pragma unroll
        for (int o = 1; o < 64; o <<= 1) { const float ov = sx(bv, o, lane); const int oe = sxi(be, o, lane); if (ov > bv || (ov == bv && oe < be)) { bv = ov; be = oe; } }
        float s = 0.f;
#pragma unroll
        for (int i = 0; i < 4; ++i) if ((be & 3) == i) s = sc[i];
        s = shf(s, be >> 2);
        if ((be >> 2) == lane) {
#pragma unroll
            for (int i = 0; i < 4; ++i) if ((be & 3) == i) cand[i] = -__builtin_inff();
        }
        wk[k] = s; ek[k] = be; wsum += s;
    }
    const float inv = 2.5f / wsum;
    if (lane < 8) {
        float wv = 0.f; int e = 0;
#pragma unroll
        for (int k = 0; k < 8; ++k) if (lane == k) { wv = wk[k]; e = ek[k]; }
        const unsigned pos = atomicAdd(&ecnt[e], 1u);
        lists[(size_t)e * NTOK + pos] = tok * 8 + lane;
        topw[tok * 8 + lane] = wv * inv;
    }
}
constexpr int NTHREADS = 512, NWAVES = 8;
constexpr int LDS_BYTES = 147456;
constexpr int LDS_MISC = 147456 - 256;
constexpr int N_PHASES = 24;
struct Args { const float* in[25]; float* out; unsigned char* ws; int ph_lo, ph_hi; };

__global__ void __launch_bounds__(NTHREADS, 2) fwd_kernel(Args args) {
    extern __shared__ __attribute__((aligned(16))) unsigned char lds_raw[];
    LAS unsigned char* lds = (LAS unsigned char*)lds_raw;
    volatile LAS unsigned* MISC = (volatile LAS unsigned*)(lds + LDS_MISC);
    const int wave0 = __builtin_amdgcn_readfirstlane((int)threadIdx.x >> 6);
    const int G = gridDim.x, bx0 = blockIdx.x;
    const int NGW = G * NWAVES, GT = G * NTHREADS;
#define FRESH_TID(t) do { asm volatile("v_mbcnt_lo_u32_b32 %0, -1, 0\n\tv_mbcnt_hi_u32_b32 %0, -1, %0" : "=v"(t)); t += wave0 * 64; } while (0)
#define PHASE_BEGIN() LAUNDER(); int tid; FRESH_TID(tid); int bx = bx0; asm volatile("" : "+s"(bx)); \
    const int lane = tid & 63, wave = __builtin_amdgcn_readfirstlane(tid >> 6); const int gw = bx * NWAVES + wave, gtid = bx * NTHREADS + tid; \
    const int vcu = (G % 8 == 0) ? (bx % 8) * (G / 8) + bx / 8 : bx; (void)lane; (void)gw; (void)gtid; (void)vcu;
    typedef const __attribute__((address_space(1))) float* gfp_t;
    typedef __attribute__((address_space(1))) unsigned char* gws_t;
    typedef gfp_t __attribute__((address_space(4))) const* kargp_t;
    kargp_t kap = (kargp_t)__builtin_amdgcn_kernarg_segment_ptr();
    gws_t ws = (gws_t)kap[26];
    unsigned* ctl = (unsigned*)(ws + WS_CTL);
#define LAUNDER() asm volatile("" : "+s"(kap), "+s"(ws))
#define INP(k) ((const float*)kap[k])
#define in_x INP(0)
#define in_c INP(1)
#define in_ctx INP(2)
#define in_cctx INP(3)
#define ada_w INP(4)
#define ada_b INP(5)
#define norm1_g INP(6)
#define w_in INP(7)
#define conv_w INP(8)
#define na_rel_bias INP(9)
#define diff_lambda INP(10)
#define diff_subln_g INP(11)
#define w_branch_gate INP(12)
#define w_branch INP(13)
#define w_out INP(14)
#define norm2_g INP(15)
#define router_w INP(16)
#define router_bias INP(17)
#define e_wg INP(18)
#define e_wu INP(19)
#define e_wd INP(20)
#define s_wg INP(21)
#define s_wu INP(22)
#define s_wd INP(23)
#define final_g INP(24)
#define OUTP ((float*)kap[25])
#define MODS ((float*)(ws + WS_MODS))
#define LAM ((float*)(ws + WS_MODS + 512 * 1024))
#define Win_t ((bf16_t*)(ws + WS_WIN))
#define Wg_t ((bf16_t*)(ws + WS_WG))
#define Wb_t ((bf16_t*)(ws + WS_WB))
#define Wo_t ((bf16_t*)(ws + WS_WO))
#define Wr_t ((bf16_t*)(ws + WS_WR))
#define Wsgu_t ((bf16_t*)(ws + WS_WSGU))
#define Wsd_t ((bf16_t*)(ws + WS_WSD))
#define X ((float*)(ws + WS_X))
#define H ((bf16_t*)(ws + WS_H))
#define P ((bf16_t*)(ws + WS_P))
#define VTD ((bf16_t*)(ws + WS_VTD))
#define VTB ((bf16_t*)(ws + WS_VTB))
#define Z2R ((float*)(ws + WS_Z2R))
#define Z2I ((float*)(ws + WS_Z2I))
#define YBR ((bf16_t*)(ws + WS_YBR))
#define PB ((bf16_t*)(ws + WS_PB))
#define MACC ((bf16_t*)(ws + WS_MACC))
#define MRG ((bf16_t*)(ws + WS_MRG))
#define LOG ((float*)(ws + WS_LOG))
#define TOPW ((float*)(ws + WS_TOPW))
#define LIST ((int*)(ws + WS_LIST))
#define YS ((bf16_t*)(ws + WS_YS))
#define TCB ((float*)(ws + WS_TC))
    if (threadIdx.x < 64) MISC[threadIdx.x] = 0u;
    __syncthreads();
    const int lo = args.ph_lo, hi_ph = args.ph_hi;
    const bool multi = (hi_ph - lo) > 1;
    XcdBarrier bar; bar.bar = ctl + CW_BAR; bar.x = 0; bar.st = nullptr;
    if (multi) bar = xcd_barrier_post(ctl + CW_BAR, MISC + 8);
    if (multi && threadIdx.x == 0) MISC[16] = __hip_atomic_fetch_add(ctl + CW_RANK + 16 * bar.x, 1u, __ATOMIC_RELAXED, __HIP_MEMORY_SCOPE_AGENT);
    __syncthreads();
#ifndef PHMASK
#define PHMASK 0xFFFF
#endif
#define KIND(k) (((PHMASK) >> (k)) & 1)
#ifndef REPKIND
#define REPKIND -1
#endif
#ifndef REPN
#define REPN 1
#endif
#define NREP(k) (((k) == REPKIND) ? (1 + REPN) : 1)
#define IN(k) (lo <= (k) && (k) < hi_ph)
#define SEAM(k) do { if (IN(k) && IN((k) + 1)) xcd_barrier(bar); } while (0)

    for (int rep_ = 0; rep_ < NREP(0); ++rep_) if (KIND(0) && IN(0)) { if (rep_) { VM_WAIT(); __syncthreads(); } PHASE_BEGIN();
        LAS float* scr = (LAS float*)(lds + wave * 16384);
        for (int it = gw; it < 2 * 4864; it += NGW) {
            const int L = it / 4864; int r = it % 4864;
            if (r < 1280) { transpose_item(w_in + (size_t)L * DM * IN_DIM, DM, IN_DIM, Win_t + (size_t)L * IN_DIM * DM, scr, r, lane); continue; } r -= 1280;
            if (r < 2048) { const int i = r >> 9; transpose_item(w_branch_gate + (size_t)(L * 4 + i) * DM * DM, DM, DM, Wg_t + (size_t)L * 4096 * DM, scr, r & 511, lane, 3 + i); continue; } r -= 2048;
            if (r < 512) { const int i = r >> 7; transpose_item(w_branch + (size_t)(L * 4 + i) * 256 * DM, 256, DM, Wb_t + (size_t)(L * 4 + i) * DM * 256, scr, r & 127, lane); continue; } r -= 512;
            if (r < 512) { transpose_item(w_out + (size_t)L * DM * DM, DM, DM, Wo_t + (size_t)L * DM * DM, scr, r, lane); continue; } r -= 512;
            if (r < 128) { transpose_item(router_w + (size_t)L * DM * NEXP, DM, NEXP, Wr_t + (size_t)L * NEXP * DM, scr, r, lane); continue; } r -= 128;
            if (r < 128) { transpose_item(s_wg + (size_t)L * DM * EDIM, DM, EDIM, Wsgu_t + (size_t)L * 512 * DM, scr, r, lane, 1); continue; } r -= 128;
            if (r < 128) { transpose_item(s_wu + (size_t)L * DM * EDIM, DM, EDIM, Wsgu_t + (size_t)L * 512 * DM, scr, r, lane, 2); continue; } r -= 128;
            transpose_item(s_wd + (size_t)L * EDIM * DM, EDIM, DM, Wsd_t + (size_t)L * DM * EDIM, scr, r, lane);
        }
        __syncthreads();
        {
            LAS float* sv = (LAS float*)lds;
            LAS float* part = sv + 3 * DM;
            for (int i = tid; i < 3 * DM; i += NTHREADS) { const int v = i >> 10, k = i & 1023; const float c = (v < 2) ? in_c[v * DM + k] : in_cctx[k]; sv[i] = c / (1.0f + __expf(-c)); }
            __syncthreads();
            for (int item = bx; item < 2 * 96; item += G) {
                const int L = item / 96, col = (item % 96) * 64 + lane;
                const float* wp = ada_w + (size_t)L * DM * 6 * DM + col;
                float a0 = 0.f, a1 = 0.f, a2 = 0.f;
#pragma unroll 32
                for (int k = wave * 128; k < wave * 128 + 128; ++k) { const float wv = wp[(size_t)k * 6 * DM]; a0 += sv[k] * wv; a1 += sv[DM + k] * wv; a2 += sv[2 * DM + k] * wv; }
                part[(wave * 3 + 0) * 64 + lane] = a0; part[(wave * 3 + 1) * 64 + lane] = a1; part[(wave * 3 + 2) * 64 + lane] = a2;
                __syncthreads();
                if (tid < 192) { const int v = tid >> 6, l = tid & 63; float s = ada_b[(size_t)L * 6 * DM + (item % 96) * 64 + l];
#pragma unroll
                    for (int q = 0; q < 8; ++q) s += part[(q * 3 + v) * 64 + l];
                    MODS[((size_t)L * 3 + v) * 6 * DM + (item % 96) * 64 + l] = s; }
                __syncthreads();
            }
        }
        if (bx == 0 && tid < 2) {
            const float* lp = diff_lambda + tid * 128; float s0 = 0.f, s1 = 0.f;
            for (int i = 0; i < 32; ++i) { s0 += lp[i] * lp[32 + i]; s1 += lp[64 + i] * lp[96 + i]; }
            const float li = tid ? 0.35550906759f : 0.2f;
            LAM[tid] = __expf(s0) - __expf(s1) + li;
        }
    }
    SEAM(0);

    for (int L = 0; L < 2; ++L) {
        const int pb = 1 + 10 * L - (L ? 1 : 0);
        const int P_NORM1 = 1, P_INPROJ = L ? 13 : 2, P_MIX1 = P_INPROJ + 1, P_MIX2 = P_INPROJ + 2, P_MERGE = P_INPROJ + 3, P_GATE = P_INPROJ + 4, P_WOUT = P_INPROJ + 5,
                  P_NORM2 = P_WOUT + 1, P_ROUTE = P_WOUT + 2, P_TOPK = P_WOUT + 3, P_MOE = P_WOUT + 4, P_COMB = P_WOUT + 5;
        (void)pb;
#define mods (MODS + (size_t)L * 3 * 6 * DM)
        const int ntok = L ? NLAT : NTOK;
        const float lam_init = L ? 0.35550906759f : 0.2f;
#define kmax (ctl + CW_KMAX + 32 * L)
#define ecnt (ctl + CW_ECNT + 256 * L)

        if (KIND(1) && L == 0 && IN(P_NORM1)) { PHASE_BEGIN();
            for (int row = gw; row < NTOK; row += NGW) {
                const float* xr = row < NLAT ? in_x + (size_t)row * DM : in_ctx + (size_t)(row - NLAT) * DM;
                const int vec = row < SEQ ? 0 : (row < NLAT ? 1 : 2);
                f32x4 v[4];
#pragma unroll
                for (int j = 0; j < 4; ++j) v[j] = *(const f32x4*)(xr + 4 * lane + 256 * j);
                norm_mod_row(v, norm1_g, mods + (vec * 6 + 0) * DM, mods + (vec * 6 + 1) * DM, H + (size_t)row * DM, lane);
            }
        }
        if (L == 0) SEAM(P_NORM1);

        for (int rep_ = 0; rep_ < NREP(2); ++rep_) if (KIND(2) && IN(P_INPROJ)) { if (rep_) { VM_WAIT(); __syncthreads(); } PHASE_BEGIN();
            pg8::Gemm g{H, Win_t + (size_t)L * IN_DIM * DM, DM, DM, DM}; pg8::StaticOrder S; S.init(NTOK, IN_DIM, G, bx);
            pg8::EpiInproj E{P};
            pg8::gemm_phase(lds, g, S, E, tid);
        }
        SEAM(P_INPROJ);

        for (int rep_ = 0; rep_ < NREP(3); ++rep_) if (KIND(3) && IN(P_MIX1)) { if (rep_) { VM_WAIT(); __syncthreads(); } PHASE_BEGIN();
            f1b_tables(lds, tid);
            for (int u = bx; u < 512; u += G) { const int b = u >> 8, c = (u >> 2) & 63, g = u & 3; f1b_unit(P, Z2R, Z2I, lds, b, c, g, tid); }
            FRESH_TID(tid);
            for (int u = bx; u < 2 * 132; u += G) kvprep_item(P, VTD, VTB, kmax, lds, u / 132, u % 132, tid);
            FRESH_TID(tid);
            if (L == 0) for (int u = G - 1 - bx; u < 64; u += G) fctxb_unit(P, YBR, lds, u >> 5, (u >> 3) & 3, u & 7, tid);
            conv_phase(P, conv_w + (size_t)L * 3 * 256, YBR, ntok, gtid, GT);
        }
        SEAM(P_MIX1);

        for (int rep_ = 0; rep_ < NREP(4); ++rep_) if (KIND(4) && IN(P_MIX2)) { if (rep_) { VM_WAIT(); __syncthreads(); } PHASE_BEGIN();
            const float lam = LAM[L];
            for (int u = bx; u < 256; u += G) diff_unit<true>(P, VTD, YBR, diff_subln_g + L * 64, lam, lam_init, kmax, lds, u >> 7, (u >> 5) & 3, (u >> 7) * SEQ + (u & 31) * 256, 0, 132, tid);
            FRESH_TID(tid);
            for (int u = bx; u < 256; u += G) { const int b = u >> 7, r = u & 127; na_unit(P, VTB, YBR, na_rel_bias + (size_t)L * 1860, kmax, lds, b, r, b * SEQ + r * 64, 16, tid); }
            FRESH_TID(tid);
            for (int u = bx; u < 256; u += G) f2b_unit(Z2R, Z2I, YBR, lds, u >> 7, u & 127, tid);
            if (L == 0) {
                FRESH_TID(tid);
                for (int u = G - 1 - bx; u < 8; u += G) diff_unit<false>(P, VTD, YBR, diff_subln_g, lam, lam_init, kmax, lds, u >> 2, u & 3, NLAT + (u >> 2) * LCTX, 128, 132, tid);
                FRESH_TID(tid);
                for (int u = G - 9 - bx; u >= 0 && u < 8; u += G) { const int b = u >> 2, cq = u & 3; na_unit(P, VTB, YBR, na_rel_bias, kmax, lds, b, 0, NLAT + b * LCTX + cq * 64, 0, tid); }
            }
        }
        SEAM(P_MIX2);

        if (KIND(5) && IN(P_MERGE)) { PHASE_BEGIN();
            pg8::Gemm g{YBR, Wb_t + (size_t)L * 4 * DM * 256, DM, 256, 256}; pg8::StaticOrder S; S.init(ntok, 4096, G, bx); S.aostep = 256; pg8::EpiBf16 E{PB, 4096};
            pg8::gemm_phase(lds, g, S, E, tid);
        }
        SEAM(P_MERGE);

        for (int rep_ = 0; rep_ < NREP(5); ++rep_) if (KIND(5) && IN(P_GATE)) { if (rep_) { VM_WAIT(); __syncthreads(); } PHASE_BEGIN();
            const int xj = G - 1 - bx;
            pg8::ExtraOrder S; S.base.init(NLAT, 4096, G, bx); S.xpm = (L == 0 && xj < 32) ? 64 + (xj >> 4) : -1; S.xpn = xj & 15;
            pg8::Gemm g{H, Wg_t + (size_t)L * 4096 * DM, DM, DM, DM}; pg8::EpiGate4 E{PB, MRG};
            pg8::gemm_phase(lds, g, S, E, tid);
        }
        SEAM(P_GATE);

        if (KIND(6) && IN(P_WOUT)) { PHASE_BEGIN();
            pg8::Gemm g{MRG, Wo_t + (size_t)L * DM * DM, DM, DM, DM}; pg8::StaticOrder S; S.init(ntok, DM, G, bx);
            pg8::EpiResid E{L ? X : in_x, L ? X + (size_t)NLAT * DM : in_ctx, X, mods};
            pg8::gemm_phase(lds, g, S, E, tid);
        }
        SEAM(P_WOUT);

        for (int rep_ = 0; rep_ < NREP(7); ++rep_) if (KIND(7) && IN(P_NORM2)) { if (rep_) { VM_WAIT(); __syncthreads(); } PHASE_BEGIN();
            for (int row = gw; row < ntok; row += NGW) {
                const int vec = row < SEQ ? 0 : (row < NLAT ? 1 : 2);
                f32x4 v[4];
#pragma unroll
                for (int j = 0; j < 4; ++j) v[j] = *(const f32x4*)(X + (size_t)row * DM + 4 * lane + 256 * j);
                norm_mod_row(v, norm2_g + L * DM, mods + (vec * 6 + 3) * DM, mods + (vec * 6 + 4) * DM, H + (size_t)row * DM, lane);
            }
        }
        SEAM(P_NORM2);

        if (KIND(8) && IN(P_ROUTE)) { PHASE_BEGIN();
            const int nM = ntok / 256;
            { pg8::Gemm g{H, Wr_t + (size_t)L * NEXP * DM, DM, DM, DM}; pg8::PanelOrder S{nM, G, bx}; pg8::EpiF32 E{LOG, NEXP};
              pg8::gemm_phase(lds, g, S, E, tid); }
            __syncthreads();
            FRESH_TID(tid);
            { pg8::Gemm g{H, Wsgu_t + (size_t)L * 512 * DM, DM, DM, DM}; pg8::OffsetOrder S{nM, 2, G, bx, nM % G}; pg8::EpiSwiGLU E{MRG};
              pg8::gemm_phase(lds, g, S, E, tid); }
        }
        SEAM(P_ROUTE);

        if (KIND(8) && IN(P_TOPK)) { PHASE_BEGIN();
            for (int t = gw; t < ntok; t += NGW) route_token(LOG, router_bias + L * NEXP, t, ecnt, LIST, TOPW, lane);
            __syncthreads();
            FRESH_TID(tid);
            { pg8::Gemm g{MRG, Wsd_t + (size_t)L * DM * EDIM, EDIM, EDIM, EDIM}; pg8::StaticOrder S; S.init(ntok, DM, G, bx); pg8::EpiSlot8 E{YS};
              pg8::gemm_phase(lds, g, S, E, tid); }
        }
        SEAM(P_TOPK);

        for (int rep_ = 0; rep_ < NREP(9); ++rep_) if (KIND(9) && IN(P_MOE)) { if (rep_) { VM_WAIT(); __syncthreads(); } PHASE_BEGIN();
            LAS int* pref = (LAS int*)(lds + LDS_MISC - 2048);
            __syncthreads();
            if (tid < 256) pref[1 + tid] = (int)((__hip_atomic_load(&ecnt[tid], __ATOMIC_RELAXED, __HIP_MEMORY_SCOPE_AGENT) + (unsigned)(MO_ROWS - 1)) / (unsigned)MO_ROWS);
            if (tid == 0) pref[0] = 0;
            __syncthreads();
            if (tid == 0) { int s = 0; for (int e = 0; e < 256; ++e) { s += pref[1 + e]; pref[1 + e] = s; } }
            __syncthreads();
            const int total = pref[256];
            int xcu = vcu;
            if (multi) {
                int base = 0, tot = 0;
                for (int j = 0; j < 16; ++j) { const int cj = (int)xb_ld(ctl + CW_BAR + XB_XCNT(j)); base += (j < (int)bar.x) ? cj : 0; tot += cj; }
                if (tot == G) xcu = base + (int)MISC[16];
            }
            xcu = __builtin_amdgcn_readfirstlane(xcu);
            for (int uid = xcu; uid < total; uid += G) {
                int e = 0; { int a = 0, bq = 256; while (bq - a > 1) { const int m = (a + bq) >> 1; if (pref[m] <= uid) a = m; else bq = m; } e = a; }
                const int t = uid - pref[e], cnt = (int)__hip_atomic_load(&ecnt[e], __ATOMIC_RELAXED, __HIP_MEMORY_SCOPE_AGENT), r0 = t * MO_ROWS, nrows = min(MO_ROWS, cnt - r0);
                __syncthreads();
                if (tid < 128) { LAS int* rtok = (LAS int*)lds; int ent = (tid < nrows) ? LIST[(size_t)e * NTOK + r0 + tid] : -8;
                    rtok[tid] = ent >> 3; rtok[128 + tid] = (ent >> 3) * NSLOT + (ent & 7); ((LAS float*)lds)[256 + tid] = (tid < nrows) ? TOPW[ent] : 0.f; }
                __syncthreads();
                const size_t eo = (size_t)(L * NEXP + e);
                const int nm = __builtin_amdgcn_readfirstlane((nrows + 31) >> 5);
                if (nm == 4)      { int t4; FRESH_TID(t4); moe_unit<4>(e_wg + eo * DM * EDIM, e_wu + eo * DM * EDIM, e_wd + eo * EDIM * DM, H, YS, lds, nrows, t4); }
                else if (nm == 3) { int t3; FRESH_TID(t3); moe_unit<3>(e_wg + eo * DM * EDIM, e_wu + eo * DM * EDIM, e_wd + eo * EDIM * DM, H, YS, lds, nrows, t3); }
                else if (nm == 2) { int t2; FRESH_TID(t2); moe_unit<2>(e_wg + eo * DM * EDIM, e_wu + eo * DM * EDIM, e_wd + eo * EDIM * DM, H, YS, lds, nrows, t2); }
                else              { int t1; FRESH_TID(t1); moe_unit<1>(e_wg + eo * DM * EDIM, e_wu + eo * DM * EDIM, e_wd + eo * EDIM * DM, H, YS, lds, nrows, t1); }
            }
        }
        SEAM(P_MOE);

        if (KIND(10) && IN(P_COMB)) { PHASE_BEGIN();
            const float* mods1 = MODS + (size_t)3 * 6 * DM;
            for (int row = gw; row < ntok; row += NGW) {
                const int vec = row < SEQ ? 0 : (row < NLAT ? 1 : 2);
                float v[2][8];
#pragma unroll
                for (int j = 0; j < 2; ++j) {
                    const int c = 8 * lane + 512 * j;
                    float a[8] = {0.f, 0.f, 0.f, 0.f, 0.f, 0.f, 0.f, 0.f};
#pragma unroll
                    for (int k = 0; k < NSLOT; ++k) { const u32x4 y = __builtin_nontemporal_load((const u32x4*)(YS + ((size_t)row * NSLOT + k) * DM + c));
#pragma unroll
                        for (int i = 0; i < 4; ++i) { a[2 * i] += bflo(y[i]); a[2 * i + 1] += bfhi(y[i]); } }
                    const f32x4 g0 = *(const f32x4*)(mods + (vec * 6 + 5) * DM + c), g1 = *(const f32x4*)(mods + (vec * 6 + 5) * DM + c + 4);
                    const f32x4 x0 = *(const f32x4*)(X + (size_t)row * DM + c), x1 = *(const f32x4*)(X + (size_t)row * DM + c + 4);
#pragma unroll
                    for (int i = 0; i < 4; ++i) { v[j][i] = x0[i] + g0[i] * a[i]; v[j][4 + i] = x1[i] + g1[i] * a[4 + i]; }
                }
                float ss = 0.f;
#pragma unroll
                for (int j = 0; j < 2; ++j)
#pragma unroll
                    for (int i = 0; i < 8; ++i) ss += v[j][i] * v[j][i];
                const float rstd = __builtin_amdgcn_rsqf(wave_sum(ss, lane) * (1.f / DM) + EPS);
#pragma unroll
                for (int j = 0; j < 2; ++j) {
                    const int c = 8 * lane + 512 * j;
                    if (L == 0) {
                        *(f32x4*)(X + (size_t)row * DM + c) = (f32x4){v[j][0], v[j][1], v[j][2], v[j][3]}; *(f32x4*)(X + (size_t)row * DM + c + 4) = (f32x4){v[j][4], v[j][5], v[j][6], v[j][7]};
                        const float* gp = norm1_g + DM + c; const float* shp = mods1 + (vec * 6 + 0) * DM + c; const float* scp = mods1 + (vec * 6 + 1) * DM + c;
                        float y[8];
#pragma unroll
                        for (int i = 0; i < 8; ++i) y[i] = v[j][i] * rstd * gp[i] * (scp[i] + 1.0f) + shp[i];
                        u32x4 w; w.x = pk2(y[0], y[1]); w.y = pk2(y[2], y[3]); w.z = pk2(y[4], y[5]); w.w = pk2(y[6], y[7]);
                        *(u32x4*)(H + (size_t)row * DM + c) = w;
                    } else {
                        const float* gp = final_g + c;
                        f32x4 o0, o1;
#pragma unroll
                        for (int i = 0; i < 4; ++i) { o0[i] = v[j][i] * rstd * gp[i]; o1[i] = v[j][4 + i] * rstd * gp[4 + i]; }
                        *(f32x4*)(OUTP + (size_t)row * DM + c) = o0; *(f32x4*)(OUTP + (size_t)row * DM + c + 4) = o1;
                    }
                }
            }
        }
        if (L == 0) SEAM(P_COMB);
    }
#undef IN
#undef SEAM
#undef KIND
}

extern "C" void kernel_launch(void* const* d_in, const int* in_sizes, int n_in, void* d_out, int out_size, void* d_ws, size_t ws_size, hipStream_t stream) {
    static int grid = 0;
    if (grid == 0) {
        if (n_in != 25 || in_sizes[0] != NLAT * DM || out_size != NLAT * DM || ws_size < WS_END) { fprintf(stderr, "kernel_launch: unexpected shapes (n_in %d, ws %zu)\n", n_in, ws_size); grid = -1; return; }
        int dev = 0, cus = 0, per_cu = 0;
        if (hipGetDevice(&dev) != hipSuccess || hipDeviceGetAttribute(&cus, hipDeviceAttributeMultiprocessorCount, dev) != hipSuccess) { grid = -1; return; }
        if (hipFuncSetAttribute((const void*)fwd_kernel, hipFuncAttributeMaxDynamicSharedMemorySize, LDS_BYTES) != hipSuccess) { fprintf(stderr, "kernel_launch: hipFuncSetAttribute failed\n"); grid = -1; return; }
        if (hipOccupancyMaxActiveBlocksPerMultiprocessor(&per_cu, (const void*)fwd_kernel, NTHREADS, LDS_BYTES) != hipSuccess || per_cu < 1) fprintf(stderr, "kernel_launch: occupancy query says %d\n", per_cu);
        (void)hipGetLastError();
        grid = cus;
    }
    if (grid < 0) return;
    (void)hipMemsetAsync((char*)d_ws + WS_CTL, 0, CTL_ZERO_BYTES, stream);
    Args a{};
    for (int i = 0; i < 25; ++i) a.in[i] = (const float*)d_in[i];
    a.out = (float*)d_out; a.ws = (unsigned char*)d_ws;
#ifndef MK_LAUNCHES
#define MK_LAUNCHES 1
#endif
    if (MK_LAUNCHES == 1) { a.ph_lo = 0; a.ph_hi = N_PHASES; hipLaunchKernelGGL(fwd_kernel, dim3(grid), dim3(NTHREADS), LDS_BYTES, stream, a); }
    else for (int p = 0; p < N_PHASES; ++p) { a.ph_lo = p; a.ph_hi = p + 1; hipLaunchKernelGGL(fwd_kernel, dim3(grid), dim3(NTHREADS), LDS_BYTES, stream, a); }
}
```

```cpp
#include <hip/hip_runtime.h>
#include <cstdio>
#include <cstdint>

#define GAS __attribute__((address_space(1)))
#define LAS __attribute__((address_space(3)))
typedef unsigned short bf16_t;
typedef short bf16x8 __attribute__((ext_vector_type(8)));
typedef float f32x4 __attribute__((ext_vector_type(4)));
typedef float f32x2 __attribute__((ext_vector_type(2)));
typedef float f32x16 __attribute__((ext_vector_type(16)));
typedef unsigned u32x4 __attribute__((ext_vector_type(4)));
typedef unsigned u32x2 __attribute__((ext_vector_type(2)));

constexpr int DM = 1024, NBATCH = 2, SEQ = 8192, NLAT = NBATCH * SEQ, LCTX = 256, NCTX = NBATCH * LCTX, NTOK = NLAT + NCTX;
constexpr int IN_DIM = 2560, NEXP = 256, TOPK = 8, EDIM = 256, NKEY = SEQ + LCTX, NSLOT = 9;
constexpr float EPS = 1e-6f, LOG2E = 1.4426950408889634f;
constexpr float QD_SCALE = 0.17677669529663687f * LOG2E;
constexpr float QB_SCALE = 0.125f * LOG2E;

constexpr size_t MiB = 1u << 20;
constexpr size_t WS_CTL = 0, CTL_ZERO_BYTES = 1 * MiB;
constexpr size_t WS_MODS = 1 * MiB;
constexpr size_t WS_WIN = 2 * MiB, WS_WG = 12 * MiB, WS_WB = 28 * MiB, WS_WO = 32 * MiB, WS_WR = 36 * MiB, WS_WSGU = 37 * MiB  , WS_WSD = 39 * MiB  ;
constexpr size_t WS_X = 40 * MiB, WS_H = 106 * MiB, WS_P = 140 * MiB, WS_VTD = 224 * MiB, WS_VTB = 233 * MiB;
constexpr size_t WS_Z2R = 242 * MiB, WS_Z2I = 258 * MiB, WS_YBR = 274 * MiB, WS_PB = 308 * MiB, WS_MACC = 440 * MiB, WS_MRG = 506 * MiB;
constexpr size_t WS_LOG = 540 * MiB, WS_TOPW = 558 * MiB, WS_LIST = 560 * MiB, WS_YS = 580 * MiB, WS_TC = 880 * MiB  , WS_END = 888 * MiB;
constexpr int CW_TMO = 0, CW_BAR = 4096, CW_KMAX = 8192  , CW_ECNT = 12288  , CW_GS = 16384, CW_PROG = 49152  , CW_RANK = 32768  , CW_MOEQ = 65792  ;

typedef __bf16 bf16x2_t __attribute__((ext_vector_type(2)));
__device__ __forceinline__ unsigned pk2a(float lo, float hi) { unsigned r; asm("v_cvt_pk_bf16_f32 %0, %1, %2" : "=v"(r) : "v"(lo), "v"(hi)); return r; }
__device__ __forceinline__ unsigned pk2(float lo, float hi) { const f32x2 v = {lo, hi}; const bf16x2_t b = __builtin_convertvector(v, bf16x2_t); return __builtin_bit_cast(unsigned, b); }
__device__ __forceinline__ float bflo(unsigned w) { return __uint_as_float(w << 16); }
__device__ __forceinline__ float bfhi(unsigned w) { return __uint_as_float(w & 0xffff0000u); }
__device__ __forceinline__ float bf1(bf16_t b) { return __uint_as_float(((unsigned)b) << 16); }
__device__ __forceinline__ float ex2(float x) { return __builtin_amdgcn_exp2f(x); }
__device__ __forceinline__ int crow(int r, int hi) { return (r & 3) + 8 * (r >> 2) + 4 * hi; }
__device__ __forceinline__ float sx(float v, int o, int lane) { return __int_as_float(__builtin_amdgcn_ds_bpermute((lane ^ o) << 2, __float_as_int(v))); }
__device__ __forceinline__ int sxi(int v, int o, int lane) { return __builtin_amdgcn_ds_bpermute((lane ^ o) << 2, v); }
__device__ __forceinline__ float shf(float v, int src) { return __int_as_float(__builtin_amdgcn_ds_bpermute(src << 2, __float_as_int(v))); }
__device__ __forceinline__ float wave_sum(float v, int lane) {
#pragma unroll
    for (int o = 1; o < 64; o <<= 1) v += sx(v, o, lane);
    return v;
}
#define LDS_WAIT() asm volatile("s_waitcnt lgkmcnt(0)" ::: "memory")
#define VM_WAIT() asm volatile("s_waitcnt vmcnt(0)" ::: "memory")

#define XB_TMO      128
#define XB_XCNT(j)  (256  + 64 * (j))
#define XB_XSUB(j)  (1280 + 64 * (j))
#define XB_XGEN(j)  (2304 + 64 * (j))
#define XB_TOP      3328
#define XB_TOPGEN   3392
#define XCD_BAR_WORDS 3456
#define XB_SPIN_CAP (1u << 22)
__device__ __forceinline__ unsigned xb_ld(unsigned* p)              { return __hip_atomic_load(p, __ATOMIC_RELAXED, __HIP_MEMORY_SCOPE_AGENT); }
__device__ __forceinline__ unsigned xb_add(unsigned* p, unsigned v) { return __hip_atomic_fetch_add(p, v, __ATOMIC_RELAXED, __HIP_MEMORY_SCOPE_AGENT); }
__device__ __forceinline__ unsigned xb_xcc_id() { return (unsigned)__builtin_amdgcn_s_getreg((3 << 11) | 20) & 0xFu; }
#define XB_SPIN(cond, bar) do { unsigned _sp = 0; while (cond) { __builtin_amdgcn_s_sleep(1); \
    if ((++_sp & 255u) == 0u) { if (xb_ld(&(bar)[XB_TMO])) break; if (_sp > XB_SPIN_CAP) { atomicAdd(&(bar)[XB_TMO], 1u); break; } } } } while (0)
struct XcdBarrier { unsigned* bar; unsigned x; volatile LAS unsigned* st; };
__device__ __forceinline__ XcdBarrier xcd_barrier_post(unsigned* bar, volatile LAS unsigned* st) {
    XcdBarrier b; b.bar = bar; b.x = xb_xcc_id(); b.st = st;
    if (threadIdx.x == 0) (void)xb_add(&bar[XB_XCNT(b.x)], 1u);
    return b;
}
__device__ __forceinline__ void xcd_barrier_complete(unsigned* bar, unsigned x, unsigned& nloc, unsigned& nx) {
    const unsigned G = gridDim.x * gridDim.y * gridDim.z;
    unsigned sum, cnt, mine, sp = 0u;
    for (;;) {
        sum = 0u; cnt = 0u; mine = 0u;
#pragma unroll
        for (unsigned j = 0; j < 16; ++j) { const unsigned c = xb_ld(&bar[XB_XCNT(j)]); sum += c; cnt += (c > 0u) ? 1u : 0u; mine = (j == x) ? c : mine; }
        if (sum == G) break;
        __builtin_amdgcn_s_sleep(1);
        if ((++sp & 255u) == 0u) { if (xb_ld(&bar[XB_TMO])) break; if (sp > XB_SPIN_CAP) { atomicAdd(&bar[XB_TMO], 1u); break; } }
    }
    nloc = mine > 0u ? mine : 1u; nx = cnt > 0u ? cnt : 1u;
}
__device__ __forceinline__ void xcd_barrier(const XcdBarrier& b) {
    asm volatile("s_waitcnt vmcnt(0)" ::: "memory");
    __syncthreads();
    if (threadIdx.x == 0) {
        unsigned* bar = b.bar;
        __builtin_amdgcn_s_waitcnt(0);
        unsigned nloc = b.st[0], nx = b.st[1];
        if (nloc == 0u) { xcd_barrier_complete(bar, b.x, nloc, nx); b.st[0] = nloc; b.st[1] = nx; }
        const unsigned old = xb_add(&bar[XB_XSUB(b.x)], 1u);
        const unsigned gen = old / nloc;
        if (old + 1u == (gen + 1u) * nloc) {
            __builtin_amdgcn_fence(__ATOMIC_RELEASE, "agent");
            asm volatile("s_waitcnt vmcnt(0)" ::: "memory");
            const unsigned og = xb_add(&bar[XB_TOP], 1u);
            const unsigned tg = og / nx;
            if (og + 1u == (tg + 1u) * nx) xb_add(&bar[XB_TOPGEN], 1u);
            else XB_SPIN(xb_ld(&bar[XB_TOPGEN]) == tg, bar);
            __builtin_amdgcn_fence(__ATOMIC_ACQUIRE, "agent");
            xb_add(&bar[XB_XGEN(b.x)], 1u);
            asm volatile("s_waitcnt vmcnt(0)" ::: "memory");
        } else {
            XB_SPIN(xb_ld(&bar[XB_XGEN(b.x)]) == gen, bar);
            __builtin_amdgcn_fence(__ATOMIC_ACQUIRE, "agent");
            asm volatile("s_waitcnt vmcnt(0)" ::: "memory");
        }
    }
    __syncthreads();
}
namespace pg8 {
constexpr int BM = 256, BK = 64, HALF = 128, HTB = HALF * BK * 2, STAGE_BYTES = 8 * HTB, NXCD = 8, WGM = 8;
__host__ __device__ __forceinline__ int lds_byte(int r, int c) { const int st = (r >> 4) * 2 + (c >> 5), rr = r & 15, cc = c & 31, ob = rr * 64 + cc * 2; return st * 1024 + (ob ^ (((ob >> 9) & 1) << 5)); }
__host__ __device__ __forceinline__ void stage_rc(int b, int& R, int& C) { const int st = b / 1024, sb = b % 1024, swz = sb ^ (((sb >> 9) & 1) << 5); R = (st >> 1) * 16 + swz / 64; C = (st & 1) * 32 + (swz % 64) / 2; }
__host__ __device__ __forceinline__ int perm32(int rho) { const int n = rho >> 4, i = rho & 15; return 8 * (i >> 2) + 4 * n + (i & 3); }

struct Unit { int pm, pn, ao; };
struct Gemm { const bf16_t* A; const bf16_t* Bt; int lda, ldb, K; };

struct StaticOrder {
    int nM, nN, nwg, G, c, aostep = 0;
    __device__ void init(int M, int N, int G_, int c_) { nM = M / BM; nN = N / BM; nwg = nM * nN; G = G_; c = c_; }
    __device__ bool next(int i, Unit& u) const {
        const long L = (long)i * G + c; if (L >= nwg) return false;
        int wgid = (int)L; { const int q = nwg / NXCD, r = nwg % NXCD, xcd = wgid % NXCD, off = wgid / NXCD; wgid = (xcd < r ? xcd * (q + 1) : r * (q + 1) + (xcd - r) * q) + off; }
        const int nig = WGM * nN, gid = wgid / nig, fm = gid * WGM, gsz = (nM - fm) < WGM ? (nM - fm) : WGM;
        u.pm = fm + ((wgid % nig) % gsz); u.pn = (wgid % nig) / gsz; u.ao = (u.pn >> 2) * aostep; return true;
    }
};
struct ExtraOrder {
    StaticOrder base; int xpm, xpn;
    __device__ bool next(int i, Unit& u) const {
        const int nb = (base.c < base.nwg) ? (base.nwg - base.c + base.G - 1) / base.G : 0;
        if (i < nb) return base.next(i, u);
        if (i == nb && xpm >= 0) { u.pm = xpm; u.pn = xpn; u.ao = 0; return true; }
        return false;
    }
};
struct ComboOrder {
    int ncombo, G, c, aostep, xpm, xpn;
    __device__ bool next(int i, Unit& u) const {
        const int ncb = (c < ncombo) ? (ncombo - c + G - 1) / G : 0;
        if (i < 4 * ncb) { const int combo = c + (i >> 2) * G; const int g = i & 3; u.pm = combo >> 2; u.pn = g * 4 + (combo & 3); u.ao = g * aostep; return true; }
        if (i == 4 * ncb && xpm >= 0) { u.pm = xpm; u.pn = xpn; u.ao = (xpn >> 2) * aostep; return true; }
        return false;
    }
};
struct PanelOrder {
    int nM, G, c;
    __device__ bool next(int i, Unit& u) const { const int p = c + i * G; if (p >= nM) return false; u.pm = p; u.pn = 0; u.ao = 0; return true; }
};

template <class Epi, class Sched>
__device__ __forceinline__ void gemm_phase(LAS unsigned char* lds, const Gemm g, const Sched& S, const Epi& E, const int tid) {
    const int wid = __builtin_amdgcn_readfirstlane(tid >> 6), lane = tid & 63, wr = wid >> 2, wc = wid & 3, fr = lane & 15, fq = lane >> 4;
    const int K = g.K, nt = K / BK;
    unsigned voffA[2], voffB[2];
#pragma unroll
    for (int i = 0; i < 2; ++i) { int R, C; stage_rc(tid * 16 + i * 8192, R, C); const int Rb = Epi::PERM ? ((R & ~31) + perm32(R & 31)) : R;
        voffA[i] = (unsigned)(R * g.lda + C) * 2u; voffB[i] = (unsigned)(Rb * g.ldb + C) * 2u; }
    const size_t kstep = (size_t)(BK * 2);
    const size_t hsA = (size_t)HALF * g.lda * 2, hsB = (size_t)HALF * g.ldb * 2;
    const size_t tsA = 2 * hsA, tsB = 2 * hsB;
    const unsigned ldsw = (unsigned)wid * 1024u;
    const int aoff = lds_byte(wr * 64 + fr, fq * 8), boff = lds_byte(wc * 32 + fr, fq * 8);
#define PG8_SA(b, h) (((b) * 2 + (h)) * HTB)
#define PG8_SB(b, h) ((4 + (b) * 2 + (h)) * HTB)
#define PG8_STAGE(bufoff, gbase, voff) do { _Pragma("unroll") for (int _i = 0; _i < 2; ++_i) \
        __builtin_amdgcn_global_load_lds((const unsigned*)((const char*)(gbase) + (voff)[_i]), (LAS unsigned*)(lds + (bufoff) + ldsw + _i * 8192), 16, 0, 0); } while (0)
#define PG8_LDA(dst, b, h) do { _Pragma("unroll") for (int m = 0; m < 4; ++m) _Pragma("unroll") for (int k = 0; k < 2; ++k) dst[m][k] = *(const LAS bf16x8*)(lds + PG8_SA(b, h) + aoff + m * 2048 + k * 1024); } while (0)
#define PG8_LDB(dst, b, h) do { _Pragma("unroll") for (int n = 0; n < 2; ++n) _Pragma("unroll") for (int k = 0; k < 2; ++k) dst[n][k] = *(const LAS bf16x8*)(lds + PG8_SB(b, h) + boff + n * 2048 + k * 1024); } while (0)
#define PG8_MMA(ai, bj, At, Bt) do { __builtin_amdgcn_s_setprio(1); _Pragma("unroll") for (int m = 0; m < 4; ++m) _Pragma("unroll") for (int n = 0; n < 2; ++n) _Pragma("unroll") for (int k = 0; k < 2; ++k) \
        acc[ai][bj][m][n] = __builtin_amdgcn_mfma_f32_16x16x32_bf16(Bt[n][k], At[m][k], acc[ai][bj][m][n], 0, 0, 0); __builtin_amdgcn_s_setprio(0); } while (0)
#define PG8_WAIT_V(n) asm volatile("s_waitcnt vmcnt(" #n ")" ::: "memory")
#define PG8_WAIT_L(n) asm volatile("s_waitcnt lgkmcnt(" #n ")" ::: "memory")
#define PG8_BAR __builtin_amdgcn_s_barrier()
#define PG8_SCHED __builtin_amdgcn_sched_barrier(0)
    Unit cur, nxt; int ui = 0;
    if (!S.next(0, cur)) return;
    f32x4 acc[2][2][4][2];
#pragma unroll
    for (int a = 0; a < 2; ++a)
#pragma unroll
        for (int b = 0; b < 2; ++b)
#pragma unroll
            for (int m = 0; m < 4; ++m)
#pragma unroll
                for (int n = 0; n < 2; ++n) acc[a][b][m][n] = (f32x4){0.f, 0.f, 0.f, 0.f};
    bf16x8 At[4][2], B0[2][2], B1[2][2];
    const char* cA = (const char*)g.A + (size_t)cur.pm * tsA + (size_t)cur.ao * 2; const char* cB = (const char*)g.Bt + (size_t)cur.pn * tsB;
    PG8_STAGE(PG8_SB(0, 0), cB, voffB); PG8_STAGE(PG8_SB(0, 1), cB + hsB, voffB); PG8_STAGE(PG8_SA(0, 0), cA, voffA); PG8_STAGE(PG8_SA(0, 1), cA + hsA, voffA);
    if (wr == 1) PG8_BAR;
    PG8_WAIT_V(2); PG8_BAR;
    PG8_STAGE(PG8_SB(1, 0), cB + kstep, voffB); PG8_STAGE(PG8_SA(1, 0), cA + kstep, voffA); PG8_STAGE(PG8_SB(1, 1), cB + hsB + kstep, voffB);
    PG8_WAIT_V(6); PG8_BAR;
    for (;;) {
        const bool has_next = S.next(ui + 1, nxt);
        const char* nA = has_next ? (const char*)g.A + (size_t)nxt.pm * tsA + (size_t)nxt.ao * 2 : cA; const char* nB = has_next ? (const char*)g.Bt + (size_t)nxt.pn * tsB : cB;
#pragma unroll 1
        for (int t = 0; t < nt; t += 2) {
            const bool last = (t == nt - 2);
            const char* a1 = cA + (size_t)(t + 1) * kstep;
            const char* a2 = last ? nA : cA + (size_t)(t + 2) * kstep; const char* b2 = last ? nB : cB + (size_t)(t + 2) * kstep;
            const char* a3 = a2 + kstep; const char* b3 = b2 + kstep;
            PG8_LDB(B0, 0, 0); PG8_LDB(B1, 0, 1); PG8_SCHED; PG8_LDA(At, 0, 0); PG8_STAGE(PG8_SA(1, 1), a1 + hsA, voffA);
            PG8_WAIT_V(8); PG8_WAIT_L(0); PG8_BAR; PG8_MMA(0, 0, At, B0); PG8_MMA(0, 1, At, B1); PG8_BAR; PG8_SCHED;
            PG8_LDA(At, 0, 1); PG8_STAGE(PG8_SB(0, 0), b2, voffB); PG8_STAGE(PG8_SB(0, 1), b2 + hsB, voffB); PG8_STAGE(PG8_SA(0, 0), a2, voffA);
            PG8_WAIT_V(8); PG8_WAIT_L(0); PG8_BAR; PG8_MMA(1, 0, At, B0); PG8_MMA(1, 1, At, B1); PG8_BAR; PG8_SCHED;
            PG8_LDB(B0, 1, 0); PG8_LDB(B1, 1, 1); PG8_SCHED; PG8_LDA(At, 1, 0); PG8_STAGE(PG8_SA(0, 1), a2 + hsA, voffA);
            PG8_WAIT_V(8); PG8_WAIT_L(0); PG8_BAR; PG8_MMA(0, 0, At, B0); PG8_MMA(0, 1, At, B1); PG8_BAR; PG8_SCHED;
            PG8_LDA(At, 1, 1); PG8_STAGE(PG8_SB(1, 0), b3, voffB); PG8_STAGE(PG8_SB(1, 1), b3 + hsB, voffB); PG8_STAGE(PG8_SA(1, 0), a3, voffA);
            PG8_WAIT_V(8); PG8_WAIT_L(0); PG8_BAR; PG8_MMA(1, 0, At, B0); PG8_MMA(1, 1, At, B1); PG8_BAR; PG8_SCHED;
        }
        if (wr == 0) PG8_BAR;
        { int fr_ = fr, fq_ = fq; asm volatile("" : "+v"(fr_), "+v"(fq_)); E(acc, cur, wr, wc, fr_, fq_); }
        if (!has_next) break;
#pragma unroll
        for (int a = 0; a < 2; ++a)
#pragma unroll
            for (int b = 0; b < 2; ++b)
#pragma unroll
                for (int m = 0; m < 4; ++m)
#pragma unroll
                    for (int n = 0; n < 2; ++n) acc[a][b][m][n] = (f32x4){0.f, 0.f, 0.f, 0.f};
        cur = nxt; cA = nA; cB = nB; ++ui;
        if (wr == 1) PG8_BAR;
    }
    PG8_WAIT_V(0);
    PG8_BAR;
#undef PG8_SA
#undef PG8_SB
#undef PG8_STAGE
#undef PG8_LDA
#undef PG8_LDB
#undef PG8_MMA
#undef PG8_WAIT_V
#undef PG8_WAIT_L
#undef PG8_BAR
#undef PG8_SCHED
}
}
namespace pg8 {
struct EpiInproj {
    static constexpr bool PERM = true;
    bf16_t* P;
    __device__ __forceinline__ void operator()(const f32x4 (&acc)[2][2][4][2], const Unit& u, int wr, int wc, int fr, int fq) const {
        const int row0 = u.pm * BM + wr * 64 + fr, col0 = u.pn * BM + wc * 32 + 8 * fq;
        const bool rope = (u.pn == 7 || u.pn == 8) && (u.pm < NLAT / BM);
        const float sc = (u.pn == 7) ? QD_SCALE : (u.pn == 1 ? QB_SCALE : 1.0f);
#pragma unroll
        for (int ai = 0; ai < 2; ++ai)
#pragma unroll
            for (int m = 0; m < 4; ++m) {
                const int row = row0 + ai * HALF + m * 16;
                bf16_t* rowp = P + (size_t)row * IN_DIM + col0;
                float cs[8], sn[8];
                if (rope) {
                    const int t = row & (SEQ - 1); const float pos = (float)((fq < 2) ? (t >> 6) : (t & 63));
                    const float sg = (fq & 1) ? 1.0f : -1.0f;
#pragma unroll
                    for (int i = 0; i < 8; ++i) {
                        constexpr float INVREV[8] = {0.15915494309189535f, 0.050329212104487034f, 0.015915494309189534f, 0.0050329212104487035f,
                                                     0.0015915494309189536f, 0.00050329212104487036f, 0.00015915494309189535f, 0.000050329212104487036f};
                        const float rev = pos * INVREV[i]; const float fr_ = rev - __builtin_floorf(rev);
                        cs[i] = __builtin_amdgcn_cosf(fr_); sn[i] = __builtin_amdgcn_sinf(fr_) * sg;
                    }
                }
#pragma unroll
                for (int bj = 0; bj < 2; ++bj) {
                    float v[8];
#pragma unroll
                    for (int i = 0; i < 4; ++i) { v[i] = acc[ai][bj][m][0][i]; v[4 + i] = acc[ai][bj][m][1][i]; }
                    if (rope) {
#pragma unroll
                        for (int i = 0; i < 8; ++i) { const float pr = sx(v[i], 16, fr + 16 * fq); v[i] = v[i] * cs[i] + pr * sn[i]; }
                    }
                    u32x4 w; w.x = pk2a(v[0] * sc, v[1] * sc); w.y = pk2a(v[2] * sc, v[3] * sc); w.z = pk2a(v[4] * sc, v[5] * sc); w.w = pk2a(v[6] * sc, v[7] * sc);
                    *(u32x4*)(rowp + bj * HALF) = w;
                }
            }
    }
};
struct EpiBf16 {
    static constexpr bool PERM = true;
    bf16_t* O; int ldc;
    __device__ __forceinline__ void operator()(const f32x4 (&acc)[2][2][4][2], const Unit& u, int wr, int wc, int fr, int fq) const {
        const int row0 = u.pm * BM + wr * 64 + fr, col0 = u.pn * BM + wc * 32 + 8 * fq;
#pragma unroll
        for (int ai = 0; ai < 2; ++ai)
#pragma unroll
            for (int m = 0; m < 4; ++m) { bf16_t* rowp = O + (size_t)(row0 + ai * HALF + m * 16) * ldc + col0;
#pragma unroll
                for (int bj = 0; bj < 2; ++bj) { const f32x4 v0 = acc[ai][bj][m][0], v1 = acc[ai][bj][m][1];
                    u32x4 w; w.x = pk2a(v0[0], v0[1]); w.y = pk2a(v0[2], v0[3]); w.z = pk2a(v1[0], v1[1]); w.w = pk2a(v1[2], v1[3]);
                    *(u32x4*)(rowp + bj * HALF) = w; } }
    }
};
struct EpiGate {
    static constexpr bool PERM = true;
    const bf16_t* PB; bf16_t* MACC; bf16_t* MRG; float* TC;
    __device__ __forceinline__ void operator()(const f32x4 (&acc)[2][2][4][2], const Unit& u, int wr, int wc, int fr, int fq) const {
        const int gate = u.pn >> 2, ct = u.pn & 3;
        const int row0 = u.pm * BM + wr * 64 + fr, col0 = ct * BM + wc * 32 + 8 * fq;
        const bool ctx = u.pm >= NLAT / BM, rmw = !ctx && gate != 0;
#pragma unroll
        for (int ai = 0; ai < 2; ++ai)
#pragma unroll
            for (int m = 0; m < 4; ++m) {
                const size_t row = (size_t)(row0 + ai * HALF + m * 16);
                u32x4 pw[2], ow[2];
#pragma unroll
                for (int bj = 0; bj < 2; ++bj) { const int col = col0 + bj * HALF;
                    pw[bj] = *(const u32x4*)(PB + row * 4096 + gate * 1024 + col);
                    if (rmw) ow[bj] = *(const u32x4*)(MACC + row * DM + col); }
#pragma unroll
                for (int bj = 0; bj < 2; ++bj) {
                    const int col = col0 + bj * HALF;
                    float t[8];
                    const float pv[8] = {bflo(pw[bj].x), bfhi(pw[bj].x), bflo(pw[bj].y), bfhi(pw[bj].y), bflo(pw[bj].z), bfhi(pw[bj].z), bflo(pw[bj].w), bfhi(pw[bj].w)};
#pragma unroll
                    for (int i = 0; i < 8; ++i) { const float a = (i < 4) ? acc[ai][bj][m][0][i & 3] : acc[ai][bj][m][1][i & 3];
                        t[i] = pv[i] * __builtin_amdgcn_rcpf(1.0f + ex2(-a * LOG2E)); }
                    if (ctx) { float* tp = TC + ((size_t)gate * NCTX + (row - NLAT)) * DM + col;
                        *(f32x4*)tp = (f32x4){t[0], t[1], t[2], t[3]}; *(f32x4*)(tp + 4) = (f32x4){t[4], t[5], t[6], t[7]}; continue; }
                    if (rmw) {
#pragma unroll
                        for (int i = 0; i < 4; ++i) { t[2 * i] += bflo(ow[bj][i]); t[2 * i + 1] += bfhi(ow[bj][i]); } }
                    u32x4 w; w.x = pk2a(t[0], t[1]); w.y = pk2a(t[2], t[3]); w.z = pk2a(t[4], t[5]); w.w = pk2a(t[6], t[7]);
                    *(u32x4*)((gate != 3 ? MACC : MRG) + row * DM + col) = w;
                }
                asm volatile("" ::: "memory");
            }
    }
};
struct EpiGate4 {
    static constexpr bool PERM = true;
    const bf16_t* PB; bf16_t* MRG;
    __device__ __forceinline__ void operator()(const f32x4 (&acc)[2][2][4][2], const Unit& u, int wr, int wc, int fr, int fq) const {
        const int row0 = u.pm * BM + wr * 64 + fr, oc0 = u.pn * 64 + 16 * wc + 4 * fq;
#pragma unroll
        for (int ai = 0; ai < 2; ++ai)
#pragma unroll
            for (int m = 0; m < 4; ++m) {
                const size_t row = (size_t)(row0 + ai * HALF + m * 16);
                u32x2 pw[4];
#pragma unroll
                for (int g = 0; g < 4; ++g) pw[g] = *(const u32x2*)(PB + row * 4096 + g * 1024 + oc0);
                float t[4] = {0.f, 0.f, 0.f, 0.f};
#pragma unroll
                for (int g = 0; g < 4; ++g) { const f32x4 a = acc[ai][g >> 1][m][g & 1]; const float pv[4] = {bflo(pw[g].x), bfhi(pw[g].x), bflo(pw[g].y), bfhi(pw[g].y)};
#pragma unroll
                    for (int i = 0; i < 4; ++i) t[i] += pv[i] * __builtin_amdgcn_rcpf(1.0f + ex2(-a[i] * LOG2E)); }
                u32x2 w; w.x = pk2a(t[0], t[1]); w.y = pk2a(t[2], t[3]);
                *(u32x2*)(MRG + row * DM + oc0) = w;
                if (m & 1) asm volatile("" ::: "memory");
            }
    }
};
struct EpiResid {
    static constexpr bool PERM = false;
    const float* base_lat; const float* base_ctx; float* X; const float* mods;
    __device__ __forceinline__ void operator()(const f32x4 (&acc)[2][2][4][2], const Unit& u, int wr, int wc, int fr, int fq) const {
        const int row0 = u.pm * BM + wr * 64 + fr, col0 = u.pn * BM + wc * 32 + 4 * fq;
        const int vec = u.pm < 32 ? 0 : (u.pm < 64 ? 1 : 2);
        const float* gv = mods + (vec * 6 + 2) * DM;
        f32x4 g4[2][2];
#pragma unroll
        for (int bj = 0; bj < 2; ++bj)
#pragma unroll
            for (int n = 0; n < 2; ++n) g4[bj][n] = *(const f32x4*)(gv + col0 + bj * HALF + n * 16);
#pragma unroll
        for (int ai = 0; ai < 2; ++ai)
#pragma unroll
            for (int m = 0; m < 4; ++m) { const int row = row0 + ai * HALF + m * 16;
                const float* bp = (row < NLAT) ? base_lat + (size_t)row * DM : base_ctx + (size_t)(row - NLAT) * DM;
                float* xp = X + (size_t)row * DM;
#pragma unroll
                for (int bj = 0; bj < 2; ++bj)
#pragma unroll
                    for (int n = 0; n < 2; ++n) { const int c = col0 + bj * HALF + n * 16;
                        const f32x4 b = *(const f32x4*)(bp + c); *(f32x4*)(xp + c) = b + g4[bj][n] * acc[ai][bj][m][n]; }
                asm volatile("" ::: "memory"); }
    }
};
struct EpiSwiGLU {
    static constexpr bool PERM = true;
    bf16_t* ACT;
    __device__ __forceinline__ void operator()(const f32x4 (&acc)[2][2][4][2], const Unit& u, int wr, int wc, int fr, int fq) const {
        const int row0 = u.pm * BM + wr * 64 + fr, col0 = u.pn * 128 + wc * 32 + 8 * fq;
#pragma unroll
        for (int ai = 0; ai < 2; ++ai)
#pragma unroll
            for (int m = 0; m < 4; ++m) {
                float a[8];
#pragma unroll
                for (int i = 0; i < 8; ++i) { const float g = (i < 4) ? acc[ai][0][m][0][i & 3] : acc[ai][0][m][1][i & 3], uu = (i < 4) ? acc[ai][1][m][0][i & 3] : acc[ai][1][m][1][i & 3];
                    a[i] = g * __builtin_amdgcn_rcpf(1.0f + ex2(-g * LOG2E)) * uu; }
                u32x4 w; w.x = pk2a(a[0], a[1]); w.y = pk2a(a[2], a[3]); w.z = pk2a(a[4], a[5]); w.w = pk2a(a[6], a[7]);
                *(u32x4*)(ACT + (size_t)(row0 + ai * HALF + m * 16) * EDIM + col0) = w;
            }
    }
};
struct EpiSlot8 {
    static constexpr bool PERM = true;
    bf16_t* YSP;
    __device__ __forceinline__ void operator()(const f32x4 (&acc)[2][2][4][2], const Unit& u, int wr, int wc, int fr, int fq) const {
        const int row0 = u.pm * BM + wr * 64 + fr, col0 = u.pn * BM + wc * 32 + 8 * fq;
#pragma unroll
        for (int ai = 0; ai < 2; ++ai)
#pragma unroll
            for (int m = 0; m < 4; ++m) { bf16_t* rowp = YSP + ((size_t)(row0 + ai * HALF + m * 16) * NSLOT + 8) * DM + col0;
#pragma unroll
                for (int bj = 0; bj < 2; ++bj) { const f32x4 v0 = acc[ai][bj][m][0], v1 = acc[ai][bj][m][1];
                    u32x4 w; w.x = pk2a(v0[0], v0[1]); w.y = pk2a(v0[2], v0[3]); w.z = pk2a(v1[0], v1[1]); w.w = pk2a(v1[2], v1[3]);
                    *(u32x4*)(rowp + bj * HALF) = w; } }
    }
};
struct OffsetOrder {
    int nM, nN, G, c, off;
    __device__ bool next(int i, Unit& u) const { const int q = ((c + G - off) % G) + i * G; if (q >= nM * nN) return false; u.pm = q / nN; u.pn = q % nN; u.ao = 0; return true; }
};
struct EpiF32 {
    static constexpr bool PERM = false;
    float* C; int ldc;
    __device__ __forceinline__ void operator()(const f32x4 (&acc)[2][2][4][2], const Unit& u, int wr, int wc, int fr, int fq) const {
        const int row0 = u.pm * BM + wr * 64 + fr, col0 = u.pn * BM + wc * 32 + 4 * fq;
#pragma unroll
        for (int ai = 0; ai < 2; ++ai)
#pragma unroll
            for (int m = 0; m < 4; ++m) { float* rowp = C + (size_t)(row0 + ai * HALF + m * 16) * ldc + col0;
#pragma unroll
                for (int bj = 0; bj < 2; ++bj)
#pragma unroll
                    for (int n = 0; n < 2; ++n) *(f32x4*)(rowp + bj * HALF + n * 16) = acc[ai][bj][m][n]; }
    }
};
}
__device__ __forceinline__ void transpose_item(const float* W, int K, int N, bf16_t* WT, LAS float* scr, int item, int lane, int gu = 0) {
    const int nblk = N / 32, kb = item / nblk, nb = item % nblk, k0 = 64 * kb, n0 = 32 * nb;
    const int d0 = (gu == 1 || gu == 2) ? ((n0 >> 7) * 256 + (gu - 1) * 128 + (n0 & 127)) : n0;
    const int gg = (gu >= 3) ? (gu - 3) : -1;
#pragma unroll 8
    for (int i = 0; i < 32; ++i) { const int kk = 2 * i + (lane >> 5); scr[kk * 33 + (lane & 31)] = W[(size_t)(k0 + kk) * N + n0 + (lane & 31)]; }
    LDS_WAIT(); asm volatile("" ::: "memory");
    const int c = lane & 7;
#pragma unroll
    for (int j = 0; j < 4; ++j) { const int n = (lane >> 3) + 8 * j; const LAS float* s = scr + (8 * c) * 33 + n;
        u32x4 o; o.x = pk2(s[0 * 33], s[1 * 33]); o.y = pk2(s[2 * 33], s[3 * 33]); o.z = pk2(s[4 * 33], s[5 * 33]); o.w = pk2(s[6 * 33], s[7 * 33]);
        const int oc = n0 + n; const int drow = (gg >= 0) ? ((oc >> 6) * 256 + 128 * (gg >> 1) + 32 * ((oc >> 4) & 3) + 8 * ((oc >> 2) & 3) + 4 * (gg & 1) + (oc & 3)) : (d0 + n);
        *(u32x4*)(WT + (size_t)drow * K + k0 + 8 * c) = o; }
    LDS_WAIT(); asm volatile("" ::: "memory");
}

__device__ __forceinline__ void norm_mod_row(const f32x4 (&v)[4], const float* g, const float* shift, const float* scale, bf16_t* orow, int lane) {
    float ss = 0.f;
#pragma unroll
    for (int j = 0; j < 4; ++j) ss += (v[j].x * v[j].x + v[j].y * v[j].y) + (v[j].z * v[j].z + v[j].w * v[j].w);
    const float rstd = __builtin_amdgcn_rsqf(wave_sum(ss, lane) * (1.f / DM) + EPS);
#pragma unroll
    for (int j = 0; j < 4; ++j) {
        const int c = 4 * lane + 256 * j;
        const f32x4 gg = *(const f32x4*)(g + c), sh = *(const f32x4*)(shift + c), sc = *(const f32x4*)(scale + c);
        const f32x4 y = v[j] * rstd * gg * (sc + 1.0f) + sh;
        u32x2 w; w.x = pk2(y.x, y.y); w.y = pk2(y.z, y.w);
        *(u32x2*)(orow + c) = w;
    }
}

__device__ __forceinline__ void conv_phase(const bf16_t* P, const float* cw  , bf16_t* YBR, int ntok, int gtid, int gthreads) {
    for (int idx = gtid; idx < ntok * 32; idx += gthreads) {
        const int tok = idx >> 5, p = idx & 31;
        int t, n; if (tok < NLAT) { t = tok & (SEQ - 1); n = SEQ; } else { t = (tok - NLAT) & (LCTX - 1); n = LCTX; }
        const bf16_t* r = P + (size_t)tok * IN_DIM + 8 * p;
        const u32x4 gb = *(const u32x4*)(r + 1024);
        const u32x4 z = {0u, 0u, 0u, 0u};
        const u32x4 c0 = (t > 0) ? *(const u32x4*)(r - IN_DIM + 1280) : z, x0 = (t > 0) ? *(const u32x4*)(r - IN_DIM + 1536) : z;
        const u32x4 c1 = *(const u32x4*)(r + 1280), x1 = *(const u32x4*)(r + 1536);
        const u32x4 c2 = (t < n - 1) ? *(const u32x4*)(r + IN_DIM + 1280) : z, x2 = (t < n - 1) ? *(const u32x4*)(r + IN_DIM + 1536) : z;
        float o[8];
#pragma unroll
        for (int i = 0; i < 4; ++i) {
            const int ch = 8 * p + 2 * i;
            const float w00 = cw[ch], w01 = cw[256 + ch], w02 = cw[512 + ch], w10 = cw[ch + 1], w11 = cw[256 + ch + 1], w12 = cw[512 + ch + 1];
            const float u0l = bflo(c0[i]) * bflo(x0[i]), u0h = bfhi(c0[i]) * bfhi(x0[i]);
            const float u1l = bflo(c1[i]) * bflo(x1[i]), u1h = bfhi(c1[i]) * bfhi(x1[i]);
            const float u2l = bflo(c2[i]) * bflo(x2[i]), u2h = bfhi(c2[i]) * bfhi(x2[i]);
            o[2 * i] = bflo(gb[i]) * (w00 * u0l + w01 * u1l + w02 * u2l);
            o[2 * i + 1] = bfhi(gb[i]) * (w10 * u0h + w11 * u1h + w12 * u2h);
        }
        u32x4 w; w.x = pk2(o[0], o[1]); w.y = pk2(o[2], o[3]); w.z = pk2(o[4], o[5]); w.w = pk2(o[6], o[7]);
        *(u32x4*)(YBR + (size_t)tok * DM + 512 + 8 * p) = w;
    }
}

__device__ __forceinline__ int key_row(int b, int key) { return key < SEQ ? b * SEQ + key : NLAT + b * LCTX + (key - SEQ); }
__device__ __forceinline__ void kvprep_item(const bf16_t* P, bf16_t* VTD, bf16_t* VTB, unsigned* kmax, LAS unsigned char* lds, int b, int kblk, int tid) {
    LAS bf16_t* T = (LAS bf16_t*)lds;
    LAS unsigned* mx = (LAS unsigned*)(lds + 64 * 264 * 2);
    const int key0 = kblk * 64, row0 = key_row(b, key0);
    if (tid < 12) mx[tid] = 0u;
#pragma unroll
    for (int which = 0; which < 2; ++which) {
        const int coff = which ? 768 : 2304; bf16_t* VT = which ? VTB : VTD;
        __syncthreads();
#pragma unroll
        for (int j = 0; j < 4; ++j) { const int pid = tid + 512 * j, kr = pid >> 5, seg = pid & 31;
            *(LAS u32x4*)(T + kr * 264 + seg * 8) = *(const u32x4*)(P + (size_t)(row0 + kr) * IN_DIM + coff + seg * 8); }
        __syncthreads();
#pragma unroll
        for (int j = 0; j < 4; ++j) { const int pid = tid + 512 * j, col = pid >> 3, kp = pid & 7;
            unsigned w[4];
#pragma unroll
            for (int i = 0; i < 4; ++i) w[i] = (unsigned)T[(kp * 8 + 2 * i) * 264 + col] | ((unsigned)T[(kp * 8 + 2 * i + 1) * 264 + col] << 16);
            *(u32x4*)(VT + ((size_t)(b * 4 + (col >> 6)) * 64 + (col & 63)) * NKEY + key0 + kp * 8) = (u32x4){w[0], w[1], w[2], w[3]}; }
    }
    {
        const int kr = tid >> 3, hm = tid & 7;
        const bf16_t* rp = P + (size_t)(row0 + kr) * IN_DIM + hm * 32;
        float sd = 0.f, sb = 0.f;
#pragma unroll
        for (int j = 0; j < 4; ++j) { const u32x4 a = *(const u32x4*)(rp + 2048 + 8 * j), c = *(const u32x4*)(rp + 512 + 8 * j);
#pragma unroll
            for (int i = 0; i < 4; ++i) { sd += bflo(a[i]) * bflo(a[i]) + bfhi(a[i]) * bfhi(a[i]); sb += bflo(c[i]) * bflo(c[i]) + bfhi(c[i]) * bfhi(c[i]); } }
        sb += sx(sb, 1, tid & 63);
        atomicMax((unsigned*)&mx[hm], __float_as_uint(sd));
        if ((hm & 1) == 0) atomicMax((unsigned*)&mx[8 + (hm >> 1)], __float_as_uint(sb));
    }
    __syncthreads();
    if (tid < 8) atomicMax(&kmax[b * 8 + tid], mx[tid]);
    else if (tid < 12) atomicMax(&kmax[16 + b * 4 + (tid - 8)], mx[tid]);
    __syncthreads();
}
#define MFMA_F32(a, b, c) __builtin_amdgcn_mfma_f32_32x32x2f32((a), (b), (c), 0, 0, 0)
#define MFMA_BF(a, b, c) __builtin_amdgcn_mfma_f32_32x32x16_bf16((a), (b), (c), 0, 0, 0)
__device__ __forceinline__ f32x16 zero16() { f32x16 z;
#pragma unroll
    for (int i = 0; i < 16; ++i) z[i] = 0.f; return z; }
__device__ __forceinline__ void f1_unit(const bf16_t* P, float* Z2R, float* Z2I, LAS unsigned char* lds, int b, int c, int g, int tid) {
    LAS float* V = (LAS float*)lds;
    LAS float* tab = (LAS float*)(lds + 128 * 132 * 4);
    const int lane = tid & 63, w = __builtin_amdgcn_readfirstlane(tid >> 6), l32 = lane & 31, hi = lane >> 5;
    if (tid < 64) { const float x = (float)tid * (1.f / 64.f); tab[tid] = __builtin_amdgcn_cosf(x); tab[64 + tid] = __builtin_amdgcn_sinf(x); }
    else if (tid < 192) { const int i = tid - 64; const float x = (float)i * (1.f / 128.f); tab[128 + i] = __builtin_amdgcn_cosf(x); tab[256 + i] = __builtin_amdgcn_sinf(x); }
    __syncthreads();
    {
        const int mt = w >> 1, part = w & 1, r = mt * 32 + l32;
        const bf16_t* up = P + (size_t)(b * SEQ + r * 64 + c) * IN_DIM + g * 64;
        u32x4 uq[8];
#pragma unroll
        for (int i = 0; i < 8; ++i) uq[i] = *(const u32x4*)(up + 8 * i);
        f32x16 a0 = zero16(), a1 = zero16();
        const LAS float* tb = tab + part * 64; const float sgn = part ? -1.f : 1.f;
#pragma unroll
        for (int s = 0; s < 32; ++s) {
            const unsigned wv = uq[s >> 2][s & 3]; const float a = hi ? bfhi(wv) : bflo(wv);
            const int j = 2 * s + hi;
            const float b0 = tb[(j * l32) & 63] * sgn, b1 = tb[(j * (32 + l32)) & 63] * sgn;
            a0 = MFMA_F32(a, b0, a0); a1 = MFMA_F32(a, b1, a1);
        }
#pragma unroll
        for (int q = 0; q < 16; ++q) { const int rr = mt * 32 + crow(q, hi); V[rr * 132 + part * 64 + l32] = a0[q]; V[rr * 132 + part * 64 + 32 + l32] = a1[q]; }
    }
    __syncthreads();
    {
        const int mt = w >> 1, mh = w & 1, ka = mt * 32 + l32;
        f32x16 Tr = zero16(), Ti = zero16();
#pragma unroll 4
        for (int s = 0; s < 64; ++s) {
            const int r = 2 * s + hi, idx = (ka * r) & 127;
            const float aC = tab[128 + idx], aS = tab[256 + idx];
            const float bR = V[r * 132 + mh * 32 + l32], bI = V[r * 132 + 64 + mh * 32 + l32];
            Tr = MFMA_F32(aC, bR, Tr); Tr = MFMA_F32(aS, bI, Tr); Ti = MFMA_F32(aC, bI, Ti); Ti = MFMA_F32(-aS, bR, Ti);
        }
#pragma unroll
        for (int q = 0; q < 16; ++q) {
            const int k = mt * 32 + crow(q, hi); const float x = (float)((k * c) & 8191) * (1.f / 8192.f);
            const float cs = __builtin_amdgcn_cosf(x), sn = __builtin_amdgcn_sinf(x);
            const size_t o = ((((size_t)(b * 128 + k) * 4 + g) * 64 + c) * 64) + mh * 32 + l32;
            Z2R[o] = Tr[q] * cs + Ti[q] * sn; Z2I[o] = Ti[q] * cs - Tr[q] * sn;
        }
    }
    __syncthreads();
}

constexpr int F1_TSTR = 272, F1_TC = 0, F1_TS = 128 * F1_TSTR, F1_TF = 2 * 128 * F1_TSTR, F1_FSTR = 144, F1_VT = F1_TF + 128 * F1_FSTR;
__device__ __forceinline__ void f1b_tables(LAS unsigned char* lds, int tid) {
    for (int i = tid; i < 128 * 128; i += 512) { const int ka = i >> 7, r = i & 127; const float x = (float)((ka * r) & 127) * (1.f / 128.f);
        *(LAS bf16_t*)(lds + F1_TC + ka * F1_TSTR + r * 2) = (bf16_t)(pk2(__builtin_amdgcn_cosf(x), 0.f) & 0xffffu);
        *(LAS bf16_t*)(lds + F1_TS + ka * F1_TSTR + r * 2) = (bf16_t)(pk2(__builtin_amdgcn_sinf(x), 0.f) & 0xffffu); }
    for (int i = tid; i < 128 * 64; i += 512) { const int xx = i >> 6, j = i & 63; const float x = (float)((j * (xx & 63)) & 63) * (1.f / 64.f);
        const float v = (xx < 64) ? __builtin_amdgcn_cosf(x) : -__builtin_amdgcn_sinf(x);
        *(LAS bf16_t*)(lds + F1_TF + xx * F1_FSTR + j * 2) = (bf16_t)(pk2(v, 0.f) & 0xffffu); }
    __syncthreads();
}
__device__ __forceinline__ void f1b_unit(const bf16_t* P, float* Z2R, float* Z2I, LAS unsigned char* lds, int b, int c, int g, int tid) {
    const int lane = tid & 63, w = __builtin_amdgcn_readfirstlane(tid >> 6), l32 = lane & 31, hi = lane >> 5;
    {
        const int mt = w >> 1, xh = w & 1, r = mt * 32 + l32;
        const bf16_t* up = P + (size_t)(b * SEQ + r * 64 + c) * IN_DIM + g * 64;
        f32x16 a0 = zero16(), a1 = zero16();
#pragma unroll
        for (int ks = 0; ks < 4; ++ks) {
            const bf16x8 uf = *(const bf16x8*)(up + ks * 16 + 8 * hi);
            const bf16x8 f0 = *(const LAS bf16x8*)(lds + F1_TF + (xh * 64 + l32) * F1_FSTR + (ks * 16 + 8 * hi) * 2), f1 = *(const LAS bf16x8*)(lds + F1_TF + (xh * 64 + 32 + l32) * F1_FSTR + (ks * 16 + 8 * hi) * 2);
            a0 = MFMA_BF(uf, f0, a0); a1 = MFMA_BF(uf, f1, a1);
        }
#pragma unroll
        for (int rg = 0; rg < 4; ++rg) {
            const int r0 = mt * 32 + 8 * rg + 4 * hi;
            u32x2 v0, v1; v0.x = pk2(a0[4 * rg], a0[4 * rg + 1]); v0.y = pk2(a0[4 * rg + 2], a0[4 * rg + 3]); v1.x = pk2(a1[4 * rg], a1[4 * rg + 1]); v1.y = pk2(a1[4 * rg + 2], a1[4 * rg + 3]);
            *(LAS u32x2*)(lds + F1_VT + (xh * 64 + l32) * F1_TSTR + r0 * 2) = v0; *(LAS u32x2*)(lds + F1_VT + (xh * 64 + 32 + l32) * F1_TSTR + r0 * 2) = v1;
            if (xh == 0) { v0.x ^= 0x80008000u; v0.y ^= 0x80008000u; v1.x ^= 0x80008000u; v1.y ^= 0x80008000u;
                *(LAS u32x2*)(lds + F1_VT + (128 + l32) * F1_TSTR + r0 * 2) = v0; *(LAS u32x2*)(lds + F1_VT + (160 + l32) * F1_TSTR + r0 * 2) = v1; }
        }
    }
    __syncthreads();
    {
        const int mt = w >> 1, mh = w & 1;
        f32x16 Tr = zero16(), Ti = zero16();
#pragma unroll
        for (int ks = 0; ks < 8; ++ks) {
            const int ko = (ks * 16 + 8 * hi) * 2;
            const bf16x8 aC = *(const LAS bf16x8*)(lds + F1_TC + (mt * 32 + l32) * F1_TSTR + ko), aS = *(const LAS bf16x8*)(lds + F1_TS + (mt * 32 + l32) * F1_TSTR + ko);
            const bf16x8 bR = *(const LAS bf16x8*)(lds + F1_VT + (mh * 32 + l32) * F1_TSTR + ko), bI = *(const LAS bf16x8*)(lds + F1_VT + (64 + mh * 32 + l32) * F1_TSTR + ko),
                         bN = *(const LAS bf16x8*)(lds + F1_VT + (128 + mh * 32 + l32) * F1_TSTR + ko);
            Tr = MFMA_BF(aC, bR, Tr); Tr = MFMA_BF(aS, bI, Tr); Ti = MFMA_BF(aC, bI, Ti); Ti = MFMA_BF(aS, bN, Ti);
        }
#pragma unroll
        for (int q = 0; q < 16; ++q) {
            const int k = mt * 32 + crow(q, hi); const float x = (float)((k * c) & 8191) * (1.f / 8192.f);
            const float cs = __builtin_amdgcn_cosf(x), sn = __builtin_amdgcn_sinf(x);
            const size_t o = ((((size_t)(b * 128 + k) * 4 + g) * 64 + c) * 64) + mh * 32 + l32;
            Z2R[o] = Tr[q] * cs + Ti[q] * sn; Z2I[o] = Ti[q] * cs - Tr[q] * sn;
        }
    }
    __syncthreads();
}
__device__ __forceinline__ void f2_unit(const float* Z2R, const float* Z2I, bf16_t* YBR, LAS unsigned char* lds, int b, int ka, int tid) {
    LAS float* tab = (LAS float*)lds;
    const int lane = tid & 63, w = __builtin_amdgcn_readfirstlane(tid >> 6), l32 = lane & 31, hi = lane >> 5;
    if (tid < 64) { const float x = (float)tid * (1.f / 64.f); tab[tid] = __builtin_amdgcn_cosf(x); tab[64 + tid] = __builtin_amdgcn_sinf(x); }
    __syncthreads();
    const int g = w >> 1, kbh = w & 1, kb = kbh * 32 + l32;
    const size_t base = ((size_t)(b * 128 + ka) * 4 + g) * 4096;
    f32x16 Y0 = zero16(), Y1 = zero16();
#pragma unroll 4
    for (int s = 0; s < 32; ++s) {
        const int c = 2 * s + hi, idx = (kb * c) & 63;
        const float aC = tab[idx], aS = tab[64 + idx];
        const float r0 = Z2R[base + c * 64 + l32], r1 = Z2R[base + c * 64 + 32 + l32], i0 = Z2I[base + c * 64 + l32], i1 = Z2I[base + c * 64 + 32 + l32];
        Y0 = MFMA_F32(aC, r0, Y0); Y0 = MFMA_F32(aS, i0, Y0); Y1 = MFMA_F32(aC, r1, Y1); Y1 = MFMA_F32(aS, i1, Y1);
    }
    constexpr float NORM = 0.0013810679320049757f;
#pragma unroll
    for (int q = 0; q < 16; ++q) {
        const int kbo = kbh * 32 + crow(q, hi); bf16_t* op = YBR + (size_t)(b * SEQ + ka + 128 * kbo) * DM + g * 64 + l32;
        op[0] = (bf16_t)(pk2(Y0[q] * NORM, 0.f) & 0xffffu); op[32] = (bf16_t)(pk2(Y1[q] * NORM, 0.f) & 0xffffu);
    }
    __syncthreads();
}

__device__ __forceinline__ void f2b_unit(const float* Z2R, const float* Z2I, bf16_t* YBR, LAS unsigned char* lds, int b, int ka, int tid) {
    const int lane = tid & 63, w = __builtin_amdgcn_readfirstlane(tid >> 6), l32 = lane & 31, hi = lane >> 5;
    for (int i = tid; i < 64 * 64; i += 512) { const int kb = i >> 6, cc = i & 63; const float x = (float)((kb * cc) & 63) * (1.f / 64.f);
        *(LAS bf16_t*)(lds + kb * 144 + cc * 2) = (bf16_t)(pk2(__builtin_amdgcn_cosf(x), 0.f) & 0xffffu);
        *(LAS bf16_t*)(lds + 9216 + kb * 144 + cc * 2) = (bf16_t)(pk2(__builtin_amdgcn_sinf(x), 0.f) & 0xffffu); }
    const int g = w >> 1, nt = w & 1;
    LAS unsigned char* zt = lds + 18432 + w * 9216;
    const size_t base = ((size_t)(b * 128 + ka) * 4 + g) * 4096 + nt * 32;
    {
        const int cp = lane >> 3, m4 = lane & 7;
#pragma unroll
        for (int part = 0; part < 2; ++part) {
            const float* zp = (part ? Z2I : Z2R) + base + 4 * m4;
#pragma unroll
            for (int j = 0; j < 4; ++j) { const int c0 = 2 * cp + 16 * j;
                const f32x4 v0 = *(const f32x4*)(zp + (size_t)c0 * 64), v1 = *(const f32x4*)(zp + (size_t)(c0 + 1) * 64);
#pragma unroll
                for (int q = 0; q < 4; ++q) *(LAS unsigned*)(zt + part * 4608 + (4 * m4 + q) * 144 + c0 * 2) = pk2(v0[q], v1[q]); }
        }
    }
    __syncthreads();
    f32x16 Y0 = zero16(), Y1 = zero16();
#pragma unroll
    for (int ks = 0; ks < 4; ++ks) {
        const int ko = (ks * 16 + 8 * hi) * 2;
        const bf16x8 bR = *(const LAS bf16x8*)(zt + l32 * 144 + ko), bI = *(const LAS bf16x8*)(zt + 4608 + l32 * 144 + ko);
        const bf16x8 c0 = *(const LAS bf16x8*)(lds + l32 * 144 + ko), s0 = *(const LAS bf16x8*)(lds + 9216 + l32 * 144 + ko);
        const bf16x8 c1 = *(const LAS bf16x8*)(lds + (32 + l32) * 144 + ko), s1 = *(const LAS bf16x8*)(lds + 9216 + (32 + l32) * 144 + ko);
        Y0 = MFMA_BF(c0, bR, Y0); Y0 = MFMA_BF(s0, bI, Y0); Y1 = MFMA_BF(c1, bR, Y1); Y1 = MFMA_BF(s1, bI, Y1);
    }
    constexpr float NORM = 0.0013810679320049757f;
#pragma unroll
    for (int q = 0; q < 16; ++q) {
        const int kb0 = crow(q, hi); bf16_t* op = YBR + (size_t)(b * SEQ + ka + 128 * kb0) * DM + g * 64 + nt * 32 + l32;
        op[0] = (bf16_t)(pk2(Y0[q] * NORM, 0.f) & 0xffffu); op[(size_t)128 * 32 * DM] = (bf16_t)(pk2(Y1[q] * NORM, 0.f) & 0xffffu);
    }
    __syncthreads();
}

constexpr int FC_TF = 0, FC_TC = 18432, FC_TS = FC_TC + 32 * 528, FC_VT = FC_TS + 32 * 528;
__device__ __forceinline__ void fctxb_unit(const bf16_t* P, bf16_t* YBR, LAS unsigned char* lds, int b, int g, int kq, int tid) {
    const int lane = tid & 63, w = __builtin_amdgcn_readfirstlane(tid >> 6), l32 = lane & 31, hi = lane >> 5;
    for (int i = tid; i < 128 * 64; i += 512) { const int xx = i >> 6, j = i & 63; const float x = (float)((j * (xx & 63)) & 63) * (1.f / 64.f);
        const float v = (xx < 64) ? __builtin_amdgcn_cosf(x) : -__builtin_amdgcn_sinf(x);
        *(LAS bf16_t*)(lds + FC_TF + xx * 144 + j * 2) = (bf16_t)(pk2(v, 0.f) & 0xffffu); }
    for (int i = tid; i < 32 * 256; i += 512) { const int kk = i >> 8, t = i & 255; const float x = (float)(((kq * 32 + kk) * t) & 255) * (1.f / 256.f);
        *(LAS bf16_t*)(lds + FC_TC + kk * 528 + t * 2) = (bf16_t)(pk2(__builtin_amdgcn_cosf(x), 0.f) & 0xffffu);
        *(LAS bf16_t*)(lds + FC_TS + kk * 528 + t * 2) = (bf16_t)(pk2(__builtin_amdgcn_sinf(x), 0.f) & 0xffffu); }
    __syncthreads();
    {
        const int t = w * 32 + l32;
        const bf16_t* up = P + (size_t)(NLAT + b * LCTX + t) * IN_DIM + g * 64;
        f32x16 a[4] = {zero16(), zero16(), zero16(), zero16()};
#pragma unroll
        for (int ks = 0; ks < 4; ++ks) {
            const bf16x8 uf = *(const bf16x8*)(up + ks * 16 + 8 * hi);
#pragma unroll
            for (int xt = 0; xt < 4; ++xt) { const bf16x8 ff = *(const LAS bf16x8*)(lds + FC_TF + (xt * 32 + l32) * 144 + (ks * 16 + 8 * hi) * 2); a[xt] = MFMA_BF(uf, ff, a[xt]); }
        }
#pragma unroll
        for (int xt = 0; xt < 4; ++xt)
#pragma unroll
            for (int rg = 0; rg < 4; ++rg) { u32x2 v; v.x = pk2(a[xt][4 * rg], a[xt][4 * rg + 1]); v.y = pk2(a[xt][4 * rg + 2], a[xt][4 * rg + 3]);
                *(LAS u32x2*)(lds + FC_VT + (xt * 32 + l32) * 528 + (w * 32 + 8 * rg + 4 * hi) * 2) = v; }
    }
    __syncthreads();
    if (w < 2) {
        f32x16 Y = zero16();
#pragma unroll
        for (int ks = 0; ks < 16; ++ks) {
            const int ko = (ks * 16 + 8 * hi) * 2;
            const bf16x8 aC = *(const LAS bf16x8*)(lds + FC_TC + l32 * 528 + ko), aS = *(const LAS bf16x8*)(lds + FC_TS + l32 * 528 + ko);
            const bf16x8 bR = *(const LAS bf16x8*)(lds + FC_VT + (w * 32 + l32) * 528 + ko), bI = *(const LAS bf16x8*)(lds + FC_VT + (64 + w * 32 + l32) * 528 + ko);
            Y = MFMA_BF(aC, bR, Y); Y = MFMA_BF(aS, bI, Y);
        }
#pragma unroll
        for (int q = 0; q < 16; ++q) { const int ko = kq * 32 + crow(q, hi);
            YBR[(size_t)(NLAT + b * LCTX + ko) * DM + g * 64 + w * 32 + l32] = (bf16_t)(pk2(Y[q] * (1.f / 128.f), 0.f) & 0xffffu); }
    }
    __syncthreads();
}
__device__ __forceinline__ void fctx_unit(const bf16_t* P, bf16_t* YBR, LAS unsigned char* lds, int b, int g, int kq, int tid) {
    LAS float* V = (LAS float*)lds;
    LAS float* tab = (LAS float*)(lds + 256 * 132 * 4);
    const int lane = tid & 63, w = __builtin_amdgcn_readfirstlane(tid >> 6), l32 = lane & 31, hi = lane >> 5;
    if (tid < 64) { const float x = (float)tid * (1.f / 64.f); tab[tid] = __builtin_amdgcn_cosf(x); tab[64 + tid] = __builtin_amdgcn_sinf(x); }
    else if (tid < 320) { const int i = tid - 64; const float x = (float)i * (1.f / 256.f); tab[128 + i] = __builtin_amdgcn_cosf(x); tab[384 + i] = __builtin_amdgcn_sinf(x); }
    __syncthreads();
    {
        const int t = w * 32 + l32;
        const bf16_t* up = P + (size_t)(NLAT + b * LCTX + t) * IN_DIM + g * 64;
        u32x4 uq[8];
#pragma unroll
        for (int i = 0; i < 8; ++i) uq[i] = *(const u32x4*)(up + 8 * i);
        f32x16 a0 = zero16(), a1 = zero16(), a2 = zero16(), a3 = zero16();
#pragma unroll
        for (int s = 0; s < 32; ++s) {
            const unsigned wv = uq[s >> 2][s & 3]; const float a = hi ? bfhi(wv) : bflo(wv);
            const int j = 2 * s + hi, i0 = (j * l32) & 63, i1 = (j * (32 + l32)) & 63;
            a0 = MFMA_F32(a, tab[i0], a0); a1 = MFMA_F32(a, tab[i1], a1); a2 = MFMA_F32(a, -tab[64 + i0], a2); a3 = MFMA_F32(a, -tab[64 + i1], a3);
        }
#pragma unroll
        for (int q = 0; q < 16; ++q) { const int rr = w * 32 + crow(q, hi); LAS float* vp = V + rr * 132 + l32; vp[0] = a0[q]; vp[32] = a1[q]; vp[64] = a2[q]; vp[96] = a3[q]; }
    }
    __syncthreads();
    {
        const int mt = w >> 1, nt = w & 1, k = kq * 128 + mt * 32 + l32;
        f32x16 Y = zero16();
#pragma unroll 4
        for (int s = 0; s < 128; ++s) {
            const int t = 2 * s + hi, idx = (k * t) & 255;
            const float aC = tab[128 + idx], aS = tab[384 + idx];
            const float bR = V[t * 132 + nt * 32 + l32], bI = V[t * 132 + 64 + nt * 32 + l32];
            Y = MFMA_F32(aC, bR, Y); Y = MFMA_F32(aS, bI, Y);
        }
#pragma unroll
        for (int q = 0; q < 16; ++q) { const int ko = kq * 128 + mt * 32 + crow(q, hi);
            YBR[(size_t)(NLAT + b * LCTX + ko) * DM + g * 64 + nt * 32 + l32] = (bf16_t)(pk2(Y[q] * (1.f / 128.f), 0.f) & 0xffffu); }
    }
    __syncthreads();
}
__device__ __forceinline__ bf16x8 mk8(u32x2 lo, u32x2 hi) { u32x4 t = {lo.x, lo.y, hi.x, hi.y}; return __builtin_bit_cast(bf16x8, t); }
__device__ __forceinline__ float ssq8(bf16x8 v) { const u32x4 t = __builtin_bit_cast(u32x4, v); float s = 0.f;
#pragma unroll
    for (int i = 0; i < 4; ++i) s += bflo(t[i]) * bflo(t[i]) + bfhi(t[i]) * bfhi(t[i]);
    return s; }
__device__ __forceinline__ bf16x8 packp(const f32x16& p, int j) { u32x4 t = {pk2(p[8 * j], p[8 * j + 1]), pk2(p[8 * j + 2], p[8 * j + 3]), pk2(p[8 * j + 4], p[8 * j + 5]), pk2(p[8 * j + 6], p[8 * j + 7])}; return __builtin_bit_cast(bf16x8, t); }

constexpr int DA_KSTR = 144, DA_TILE = 64 * DA_KSTR;
__device__ __forceinline__ float sum16(const f32x16& S) {
    float a, b;
    asm("s_nop 0\n\tv_add_f32 %0, %2, %3\n\tv_add_f32 %1, %4, %5\n\tv_add_f32 %0, %0, %6\n\tv_add_f32 %1, %1, %7\n\tv_add_f32 %0, %0, %8\n\tv_add_f32 %1, %1, %9\n\t"
        "v_add_f32 %0, %0, %10\n\tv_add_f32 %1, %1, %11\n\tv_add_f32 %0, %0, %12\n\tv_add_f32 %1, %1, %13\n\tv_add_f32 %0, %0, %14\n\tv_add_f32 %1, %1, %15\n\t"
        "v_add_f32 %0, %0, %16\n\tv_add_f32 %1, %1, %17\n\tv_add_f32 %0, %0, %1"
        : "=&v"(a), "=&v"(b)
        : "v"(S[0]), "v"(S[1]), "v"(S[2]), "v"(S[3]), "v"(S[4]), "v"(S[5]), "v"(S[6]), "v"(S[7]), "v"(S[8]), "v"(S[9]), "v"(S[10]), "v"(S[11]), "v"(S[12]), "v"(S[13]), "v"(S[14]), "v"(S[15]));
    return a;
}
template <bool FAST>
__device__ __forceinline__ void diff_loop(const bf16_t* P, const bf16_t* vsrc, LAS unsigned char* Kl, LAS unsigned char* Vl, const bf16x8 (&qf)[2][2], const float (&nb)[2],
                                          f32x16 (&O)[2][2], float (&ls)[2], int b, int h, int kt0, int kt1, int sr, int sg, int l32, int hi) {
#define DA_PV(Vbuf, koff) do { _Pragma("unroll") for (int t = 0; t < 2; ++t) _Pragma("unroll") for (int j = 0; j < 2; ++j) { \
        const LAS unsigned char* vp = (Vbuf) + (t * 32 + l32) * DA_KSTR + ((koff) + 16 * j + 4 * hi) * 2; \
        const bf16x8 vf = mk8(*(const LAS u32x2*)vp, *(const LAS u32x2*)(vp + 16)); \
        O[0][t] = MFMA_BF(vf, pb[0][j], O[0][t]); O[1][t] = MFMA_BF(vf, pb[1][j], O[1][t]); } } while (0)
    u32x4 kreg, vreg;
    { const int key0 = kt0 * 64; kreg = *(const u32x4*)(P + (size_t)key_row(b, key0 + sr) * IN_DIM + 2048 + h * 64 + sg * 8); vreg = *(const u32x4*)(vsrc + key0); }
    *(LAS u32x4*)(Kl + sr * DA_KSTR + sg * 16) = kreg; *(LAS u32x4*)(Vl + sr * DA_KSTR + sg * 16) = vreg;
    __syncthreads();
    bf16x8 pb[2][2];
    int vc = 0, vp_ = 2 * DA_TILE, vn = DA_TILE;
    for (int kt = kt0; kt < kt1; ++kt) {
        const int buf = (kt - kt0) & 1;
        if (kt + 1 < kt1) { const int key0 = (kt + 1) * 64; kreg = *(const u32x4*)(P + (size_t)key_row(b, key0 + sr) * IN_DIM + 2048 + h * 64 + sg * 8); vreg = *(const u32x4*)(vsrc + key0); }
        const LAS unsigned char* Kb = Kl + buf * DA_TILE;
#pragma unroll
        for (int kb = 0; kb < 2; ++kb) {
            f32x16 S[2];
#pragma unroll
            for (int mp = 0; mp < 2; ++mp) {
                if (FAST) S[mp] = zero16();
                else {
#pragma unroll
                    for (int i = 0; i < 16; ++i) S[mp][i] = nb[mp];
                }
#pragma unroll
                for (int ks = 0; ks < 2; ++ks) { const bf16x8 kf = *(const LAS bf16x8*)(Kb + (kb * 32 + l32) * DA_KSTR + (mp * 32 + ks * 16 + 8 * hi) * 2); S[mp] = MFMA_BF(kf, qf[mp][ks], S[mp]); }
            }
            if (kb == 1) DA_PV(Vl + vc, 0);
            else if (kt != kt0) DA_PV(Vl + vp_, 32);
#pragma unroll
            for (int mp = 0; mp < 2; ++mp) {
#pragma unroll
                for (int i = 0; i < 16; ++i) S[mp][i] = ex2(S[mp][i]);
                ls[mp] += sum16(S[mp]);
            }
#pragma unroll
            for (int mp = 0; mp < 2; ++mp) { pb[mp][0] = packp(S[mp], 0); pb[mp][1] = packp(S[mp], 1); }
        }
        if (kt + 1 < kt1) { *(LAS u32x4*)(Kl + (buf ^ 1) * DA_TILE + sr * DA_KSTR + sg * 16) = kreg; *(LAS u32x4*)(Vl + vn + sr * DA_KSTR + sg * 16) = vreg; }
        { const int t_ = vp_; vp_ = vc; vc = vn; vn = t_; }
        __syncthreads();
    }
    DA_PV(Vl + vp_, 32);
    __syncthreads();
#undef DA_PV
}
template <bool ALLOW_FAST>
__device__ __forceinline__ void diff_unit(const bf16_t* P, const bf16_t* VTD, bf16_t* YBR, const float* subg, float lam, float lam_init, const unsigned* kmax,
                                          LAS unsigned char* lds, int b, int h, int qrow0, int kt0, int kt1, int tid) {
    const int lane = tid & 63, w = __builtin_amdgcn_readfirstlane(tid >> 6), l32 = lane & 31, hi = lane >> 5;
    LAS unsigned char* Kl = lds; LAS unsigned char* Vl = lds + 2 * DA_TILE;
    const int qrow = qrow0 + 32 * w + l32;
    bf16x8 qf[2][2];
#pragma unroll
    for (int mp = 0; mp < 2; ++mp)
#pragma unroll
        for (int ks = 0; ks < 2; ++ks) qf[mp][ks] = *(const bf16x8*)(P + (size_t)qrow * IN_DIM + 1792 + h * 64 + mp * 32 + ks * 16 + 8 * hi);
    float nb[2];
#pragma unroll
    for (int mp = 0; mp < 2; ++mp) { float s = ssq8(qf[mp][0]) + ssq8(qf[mp][1]); s += sx(s, 32, lane);
        nb[mp] = -(__builtin_sqrtf(s * __uint_as_float(kmax[b * 8 + h * 2 + mp])) * 1.0002f + 0.01f); }
    f32x16 O[2][2]; float ls[2] = {0.f, 0.f};
#pragma unroll
    for (int mp = 0; mp < 2; ++mp)
#pragma unroll
        for (int t = 0; t < 2; ++t) O[mp][t] = zero16();
    const int sr = tid >> 3, sg = tid & 7;
    const bf16_t* vsrc = VTD + ((size_t)(b * 4 + h) * 64 + sr) * NKEY + sg * 8;
    if (ALLOW_FAST && __all(nb[0] > -64.f && nb[1] > -64.f)) diff_loop<true>(P, vsrc, Kl, Vl, qf, nb, O, ls, b, h, kt0, kt1, sr, sg, l32, hi);
    else diff_loop<false>(P, vsrc, Kl, Vl, qf, nb, O, ls, b, h, kt0, kt1, sr, sg, l32, hi);
    ls[0] += sx(ls[0], 32, lane); ls[1] += sx(ls[1], 32, lane);
    const float i0 = 1.0f / ls[0], i1 = lam / ls[1];
    float ss = 0.f;
#pragma unroll
    for (int t = 0; t < 2; ++t)
#pragma unroll
        for (int i = 0; i < 16; ++i) { const float o = O[0][t][i] * i0 - O[1][t][i] * i1; O[0][t][i] = o; ss += o * o; }
    ss += sx(ss, 32, lane);
    const float rs = __builtin_amdgcn_rsqf(ss * (1.f / 64.f) + EPS) * (1.0f - lam_init);
    bf16_t* op = YBR + (size_t)qrow * DM + 768 + h * 64;
#pragma unroll
    for (int t = 0; t < 2; ++t)
#pragma unroll
        for (int rg = 0; rg < 4; ++rg) { const int d0 = t * 32 + 8 * rg + 4 * hi; const f32x4 gg = *(const f32x4*)(subg + d0);
            u32x2 wv; wv.x = pk2(O[0][t][4 * rg] * rs * gg.x, O[0][t][4 * rg + 1] * rs * gg.y); wv.y = pk2(O[0][t][4 * rg + 2] * rs * gg.z, O[0][t][4 * rg + 3] * rs * gg.w);
            *(u32x2*)(op + d0) = wv; }
}

constexpr int NA_KSTR = 528, NA_KT = 32 * NA_KSTR, NA_VSTR = 80, NA_VT = 256 * NA_VSTR, NA_BIAS_OFF = 2 * NA_KT + 2 * NA_VT;
__device__ __forceinline__ void na_unit(const bf16_t* P, const bf16_t* VTB, bf16_t* YBR, const float* relb  , const unsigned* kmax,
                                        LAS unsigned char* lds, int b, int r, int qrow0, int nwin, int tid) {
    const int lane = tid & 63, w = __builtin_amdgcn_readfirstlane(tid >> 6), l32 = lane & 31, hi = lane >> 5;
    const int h = w >> 1, qb = w & 1;
    LAS unsigned char* Kl = lds; LAS unsigned char* Vl = lds + 2 * NA_KT; LAS float* bl = (LAS float*)(lds + NA_BIAS_OFF);
    const int R0 = min(max(r - 4, 0), 120);
    for (int i = tid; i < 4 * 15 * 32; i += 512) { const int hd = i >> 5, dc = i & 31; bl[i] = (dc < 31) ? relb[hd * 31 + dc] * LOG2E : -1e30f; }
    const int qrow = qrow0 + 32 * qb + l32, qc = 32 * qb + l32;
    bf16x8 qf[4];
#pragma unroll
    for (int ks = 0; ks < 4; ++ks) qf[ks] = *(const bf16x8*)(P + (size_t)qrow * IN_DIM + 256 + h * 64 + ks * 16 + 8 * hi);
    __syncthreads();
    float mb = 0.f;
    if (nwin) { for (int i = lane; i < 465; i += 64) mb = fmaxf(mb, fabsf(relb[h * 465 + i]) * LOG2E);
#pragma unroll
        for (int o = 1; o < 64; o <<= 1) mb = fmaxf(mb, sx(mb, o, lane)); }
    float nb; { float s = ssq8(qf[0]) + ssq8(qf[1]) + ssq8(qf[2]) + ssq8(qf[3]); s += sx(s, 32, lane);
        nb = -(__builtin_sqrtf(s * __uint_as_float(kmax[16 + b * 4 + h])) * 1.0002f + mb + 0.01f); }
    f32x16 O[2] = {zero16(), zero16()}; float ls = 0.f;
    const int ntile = nwin + 8;
    u32x4 kreg[2], vreg[2];
#define NA_LOAD(tile) do { int krow0, vkey0; if ((tile) < nwin) { const int kr = R0 + ((tile) >> 1); vkey0 = kr * 64 + 32 * ((tile) & 1); krow0 = b * SEQ + vkey0; } \
        else { const int j_ = (tile) - nwin; vkey0 = SEQ + 32 * j_; krow0 = NLAT + b * LCTX + 32 * j_; } \
        _Pragma("unroll") for (int j = 0; j < 2; ++j) { const int pid = tid + 512 * j; \
            kreg[j] = *(const u32x4*)(P + (size_t)(krow0 + (pid >> 5)) * IN_DIM + 512 + (pid & 31) * 8); \
            const int rowhd = pid >> 2; vreg[j] = *(const u32x4*)(VTB + ((size_t)(b * 4 + (rowhd >> 6)) * 64 + (rowhd & 63)) * NKEY + vkey0 + (pid & 3) * 8); } } while (0)
#define NA_STORE(buf) do { _Pragma("unroll") for (int j = 0; j < 2; ++j) { const int pid = tid + 512 * j; \
            *(LAS u32x4*)(Kl + (buf) * NA_KT + (pid >> 5) * NA_KSTR + (pid & 31) * 16) = kreg[j]; \
            *(LAS u32x4*)(Vl + (buf) * NA_VT + (pid >> 2) * NA_VSTR + (pid & 3) * 16) = vreg[j]; } } while (0)
    NA_LOAD(0); NA_STORE(0);
    __syncthreads();
    const int col_lo = min(max(qc - 8, 0), 48);
    int boff[2][16];
#pragma unroll
    for (int hf = 0; hf < 2; ++hf)
#pragma unroll
        for (int i = 0; i < 16; ++i) { const int kc = 32 * hf + crow(i, hi); const bool ok = (kc >= col_lo) && (kc < col_lo + 16); boff[hf][i] = 4 * (ok ? (kc - qc + 15) : 31); }
    for (int tile0 = 0; tile0 < ntile; tile0 += 2) {
#pragma unroll
    for (int tb = 0; tb < 2; ++tb) {
        const int tile = tile0 + tb, buf = tb;
        if (tile + 1 < ntile) NA_LOAD(tile + 1);
        const LAS unsigned char* Kb = Kl + buf * NA_KT; const LAS unsigned char* Vb = Vl + buf * NA_VT;
        f32x16 S;
#pragma unroll
        for (int i = 0; i < 16; ++i) S[i] = nb;
#pragma unroll
        for (int ks = 0; ks < 4; ++ks) { const bf16x8 kf = *(const LAS bf16x8*)(Kb + l32 * NA_KSTR + (h * 64 + ks * 16 + 8 * hi) * 2); S = MFMA_BF(kf, qf[ks], S); }
        float ps = 0.f;
        if (tile < nwin) {
            const int kr = R0 + (tile >> 1);
            const LAS unsigned char* bp = (const LAS unsigned char*)(bl + (h * 15 + (kr - r + 7)) * 32);
#pragma unroll
            for (int i = 0; i < 16; ++i) { const float bv = *(const LAS float*)(bp + boff[tb][i]); S[i] = ex2(S[i] + bv); ps += S[i]; }
        } else {
#pragma unroll
            for (int i = 0; i < 16; ++i) { S[i] = ex2(S[i]); ps += S[i]; }
        }
        ls += ps;
        const bf16x8 p0 = packp(S, 0), p1 = packp(S, 1);
#pragma unroll
        for (int t = 0; t < 2; ++t) {
            const LAS unsigned char* vp = Vb + (h * 64 + t * 32 + l32) * NA_VSTR + (4 * hi) * 2;
            const bf16x8 v0 = mk8(*(const LAS u32x2*)vp, *(const LAS u32x2*)(vp + 16)), v1 = mk8(*(const LAS u32x2*)(vp + 32), *(const LAS u32x2*)(vp + 48));
            O[t] = MFMA_BF(v0, p0, O[t]); O[t] = MFMA_BF(v1, p1, O[t]);
        }
        if (tile + 1 < ntile) NA_STORE(buf ^ 1);
        __syncthreads();
    }
    }
#undef NA_LOAD
#undef NA_STORE
    ls += sx(ls, 32, lane);
    const float il = 1.0f / ls;
    bf16_t* op = YBR + (size_t)qrow * DM + 256 + h * 64;
#pragma unroll
    for (int t = 0; t < 2; ++t)
#pragma unroll
        for (int rg = 0; rg < 4; ++rg) { const int d0 = t * 32 + 8 * rg + 4 * hi;
            u32x2 wv; wv.x = pk2(O[t][4 * rg] * il, O[t][4 * rg + 1] * il); wv.y = pk2(O[t][4 * rg + 2] * il, O[t][4 * rg + 3] * il);
            *(u32x2*)(op + d0) = wv; }
}
constexpr int MO_META = 2048, MO_XSTR = 144, MO_XT = 128 * MO_XSTR, MO_ASTR = 528, MO_WT_OFF = MO_META + 2 * MO_XT, MO_ACT_OFF = MO_WT_OFF + 8 * 4096;
__device__ __forceinline__ void moe_wt_store(LAS unsigned char* wt, const f32x4 (&f)[4], int kq, int n4) {
#pragma unroll
    for (int c = 0; c < 4; ++c) { u32x2 d; d.x = pk2(f[0][c], f[1][c]); d.y = pk2(f[2][c], f[3][c]);
        *(LAS u32x2*)(wt + (4 * n4 + c) * 64 + (((kq >> 1) ^ (n4 & 3)) << 4) + ((kq & 1) << 3)) = d; }
}
__device__ __forceinline__ bf16x8 moe_wt_frag(const LAS unsigned char* wt, int n, int gi) { return *(const LAS bf16x8*)(wt + n * 64 + ((gi ^ ((n >> 2) & 3)) << 4)); }
constexpr int MO_ROWS = 128, MO_D = 1, MO_D2 = 2;
template <int NMT>
__device__ __forceinline__ void moe_unit(const float* __restrict__ Wg, const float* __restrict__ Wu, const float* __restrict__ Wd, const bf16_t* __restrict__ H2, bf16_t* YS,
                                         LAS unsigned char* lds, int nrows, int tid) {
    const int lane = tid & 63, w = __builtin_amdgcn_readfirstlane(tid >> 6), l32 = lane & 31, hi = lane >> 5, kq = lane >> 3, n4 = lane & 7;
    LAS int* rtok = (LAS int*)lds; LAS int* rslot = rtok + 128; LAS float* rw = (LAS float*)(rslot + 128);
    LAS unsigned char* Xl = lds + MO_META; LAS unsigned char* Al = lds + MO_ACT_OFF; LAS unsigned char* wt = lds + MO_WT_OFF + w * 4096;
    VM_WAIT();
    {
        f32x16 ag[NMT], au[NMT];
#pragma unroll
        for (int m = 0; m < NMT; ++m) { ag[m] = zero16(); au[m] = zero16(); }
        const int n0 = 32 * w;
        const unsigned woff = (unsigned)((4 * kq) * EDIM + n0 + 4 * n4);
#define GP4(k, j) (*(const f32x4*)(Wg + (size_t)((k) + (j)) * EDIM + woff))
#define UP4(k, j) (*(const f32x4*)(Wu + (size_t)((k) + (j)) * EDIM + woff))
        const int xr0 = tid >> 3, xr1 = (tid + 512) >> 3, xs = tid & 7;
        const bf16_t* xp0 = H2 + (size_t)max(rtok[xr0], 0) * DM + xs * 8; const bf16_t* xp1 = H2 + (size_t)max(rtok[xr1], 0) * DM + xs * 8;
        u32x4 xa = *(const u32x4*)xp0, xb = xa; if (NMT > 2) xb = *(const u32x4*)xp1;
        *(LAS u32x4*)(Xl + xr0 * MO_XSTR + xs * 16) = xa; if (NMT > 2) *(LAS u32x4*)(Xl + xr1 * MO_XSTR + xs * 16) = xb;
        f32x4 fg[MO_D][4], fu[MO_D][4];
#pragma unroll
        for (int h = 0; h < MO_D; ++h)
#pragma unroll
            for (int j = 0; j < 4; ++j) { fg[h][j] = GP4(h * 32, j); fu[h][j] = UP4(h * 32, j); }
        __syncthreads();
        for (int kc = 0; kc < 16; ++kc) {
            const int buf = kc & 1;
            if (kc + 1 < 16) { xa = *(const u32x4*)(xp0 + (kc + 1) * 64); if (NMT > 2) xb = *(const u32x4*)(xp1 + (kc + 1) * 64); }
#pragma unroll
            for (int hf = 0; hf < 2; ++hf) {
                moe_wt_store(wt, fg[hf % MO_D], kq, n4); moe_wt_store(wt + 2048, fu[hf % MO_D], kq, n4);
                __builtin_amdgcn_sched_barrier(0);
                const int knext = kc * 64 + (hf + MO_D) * 32;
                if (knext < DM) {
#pragma unroll
                    for (int j = 0; j < 4; ++j) { fg[hf % MO_D][j] = GP4(knext, j); fu[hf % MO_D][j] = UP4(knext, j); }
                }
                __builtin_amdgcn_sched_barrier(0);
#pragma unroll
                for (int ks = 0; ks < 2; ++ks) {
                    const bf16x8 wgf = moe_wt_frag(wt, l32, 2 * ks + hi), wuf = moe_wt_frag(wt + 2048, l32, 2 * ks + hi);
#pragma unroll
                    for (int m = 0; m < NMT; ++m) {
                        const bf16x8 xf = *(const LAS bf16x8*)(Xl + buf * MO_XT + (m * 32 + l32) * MO_XSTR + (hf * 32 + ks * 16 + 8 * hi) * 2);
                        ag[m] = MFMA_BF(wgf, xf, ag[m]); au[m] = MFMA_BF(wuf, xf, au[m]);
                    }
                }
                __builtin_amdgcn_sched_barrier(0);
            }
            if (kc + 1 < 16) { *(LAS u32x4*)(Xl + (buf ^ 1) * MO_XT + xr0 * MO_XSTR + xs * 16) = xa; if (NMT > 2) *(LAS u32x4*)(Xl + (buf ^ 1) * MO_XT + xr1 * MO_XSTR + xs * 16) = xb; }
            __syncthreads();
        }
#pragma unroll
        for (int m = 0; m < NMT; ++m) {
#pragma unroll
            for (int rg = 0; rg < 4; ++rg) {
                float a[4];
#pragma unroll
                for (int i = 0; i < 4; ++i) { const float g = ag[m][4 * rg + i]; a[i] = g * __builtin_amdgcn_rcpf(1.0f + ex2(-g * LOG2E)) * au[m][4 * rg + i]; }
                u32x2 wv; wv.x = pk2(a[0], a[1]); wv.y = pk2(a[2], a[3]);
                *(LAS u32x2*)(Al + (m * 32 + l32) * MO_ASTR + (n0 + 8 * rg + 4 * hi) * 2) = wv;
            }
        }
#undef GP4
#undef UP4
    }
    __syncthreads();
#pragma unroll 1
    for (int pass = 0; pass < 2; ++pass) {
        const int c0 = 128 * w + 64 * pass;
        VM_WAIT();
        f32x16 ac[2][NMT];
#pragma unroll
        for (int n = 0; n < 2; ++n)
#pragma unroll
            for (int m = 0; m < NMT; ++m) ac[n][m] = zero16();
        const unsigned doff = (unsigned)((4 * kq) * DM + c0 + 4 * n4);
#define DP4(k, j, n) (*(const f32x4*)(Wd + (size_t)((k) + (j)) * DM + (n) * 32 + doff))
        f32x4 f0[MO_D2][4], f1[MO_D2][4];
#pragma unroll
        for (int h = 0; h < MO_D2; ++h)
#pragma unroll
            for (int j = 0; j < 4; ++j) { f0[h][j] = DP4(h * 32, j, 0); f1[h][j] = DP4(h * 32, j, 1); }
#pragma unroll
        for (int kh = 0; kh < 8; ++kh) {
            moe_wt_store(wt, f0[kh % MO_D2], kq, n4); moe_wt_store(wt + 2048, f1[kh % MO_D2], kq, n4);
            __builtin_amdgcn_sched_barrier(0);
            if (kh + MO_D2 < 8) {
#pragma unroll
                for (int j = 0; j < 4; ++j) { f0[kh % MO_D2][j] = DP4((kh + MO_D2) * 32, j, 0); f1[kh % MO_D2][j] = DP4((kh + MO_D2) * 32, j, 1); }
            }
            __builtin_amdgcn_sched_barrier(0);
#pragma unroll
            for (int ks = 0; ks < 2; ++ks) {
                const bf16x8 w0 = moe_wt_frag(wt, l32, 2 * ks + hi), w1 = moe_wt_frag(wt + 2048, l32, 2 * ks + hi);
#pragma unroll
                for (int m = 0; m < NMT; ++m) {
                    const bf16x8 af = *(const LAS bf16x8*)(Al + (m * 32 + l32) * MO_ASTR + (kh * 32 + ks * 16 + 8 * hi) * 2);
                    ac[0][m] = MFMA_BF(w0, af, ac[0][m]); ac[1][m] = MFMA_BF(w1, af, ac[1][m]);
                }
            }
            __builtin_amdgcn_sched_barrier(0);
        }
#undef DP4
        int ln2 = lane; asm volatile("" : "+v"(ln2));
        const int l32e = ln2 & 31, hie = ln2 >> 5;
#pragma unroll
        for (int m = 0; m < NMT; ++m) {
            const float wt_ = rw[m * 32 + l32e];
#pragma unroll
            for (int n = 0; n < 2; ++n)
#pragma unroll
                for (int rg = 0; rg < 4; ++rg) { u32x2 wv; wv.x = pk2(ac[n][m][4 * rg] * wt_, ac[n][m][4 * rg + 1] * wt_); wv.y = pk2(ac[n][m][4 * rg + 2] * wt_, ac[n][m][4 * rg + 3] * wt_);
                    *(LAS u32x2*)(wt + l32e * 128 + (((n * 4 + rg) ^ (l32e & 7)) << 4) + hie * 8) = wv; }
#pragma unroll
            for (int jj = 0; jj < 4; ++jj) { const int rl = (ln2 >> 3) + 8 * jj, sg_ = ln2 & 7, grow = m * 32 + rl;
                const u32x4 v = *(const LAS u32x4*)(wt + rl * 128 + ((sg_ ^ (rl & 7)) << 4));
                if (grow < nrows) *(u32x4*)(YS + (size_t)rslot[grow] * DM + c0 + sg_ * 8) = v; }
        }
    }
    __syncthreads();
}

__device__ __forceinline__ void route_token(const float* logits, const float* rbias, int tok, unsigned* ecnt, int* lists, float* topw, int lane) {
    const f32x4 lg = *(const f32x4*)(logits + (size_t)tok * NEXP + 4 * lane);
    const f32x4 bs = *(const f32x4*)(rbias + 4 * lane);
    float sc[4], sel[4];
#pragma unroll
    for (int i = 0; i < 4; ++i) { sc[i] = 1.0f / (1.0f + __expf(-lg[i])); sel[i] = sc[i] + bs[i]; }
    float t1 = fmaxf(fmaxf(sel[0], sel[1]), fmaxf(sel[2], sel[3]));
    float t2; { const float a = fmaxf(sel[0], sel[1]), bq = fminf(sel[0], sel[1]), c = fmaxf(sel[2], sel[3]), d = fminf(sel[2], sel[3]); t2 = fmaxf(fminf(a, c), fmaxf(bq, d)); }
#pragma unroll
    for (int o = 1; o < 8; o <<= 1) { const float o1 = sx(t1, o, lane), o2 = sx(t2, o, lane); const float n1 = fmaxf(t1, o1); t2 = fmaxf(fminf(t1, o1), fmaxf(t2, o2)); t1 = n1; }
    const float gs = t1 + t2; const int grp = lane >> 3;
    int rank = 0;
#pragma unroll
    for (int j = 0; j < 8; ++j) { const float oj = shf(gs, 8 * j); rank += (oj > gs || (oj == gs && j < grp)) ? 1 : 0; }
    const bool gsel = rank < 4;
    float cand[4];
#pragma unroll
    for (int i = 0; i < 4; ++i) cand[i] = gsel ? sel[i] : -__builtin_inff();
    float wk[8]; int ek[8]; float wsum = 0.f;
#pragma unroll
    for (int k = 0; k < 8; ++k) {
        float bv = cand[0]; int bi = 0;
#pragma unroll
        for (int i = 1; i < 4; ++i) if (cand[i] > bv) { bv = cand[i]; bi = i; }
        int be = 4 * lane + bi;
#pragma unroll
        for (int o = 1; o < 64; o <<= 1) { const float ov = sx(bv, o, lane); const int oe = sxi(be, o, lane); if (ov > bv || (ov == bv && oe < be)) { bv = ov; be = oe; } }
        float s = 0.f;
#pragma unroll
        for (int i = 0; i < 4; ++i) if ((be & 3) == i) s = sc[i];
        s = shf(s, be >> 2);
        if ((be >> 2) == lane) {
#pragma unroll
            for (int i = 0; i < 4; ++i) if ((be & 3) == i) cand[i] = -__builtin_inff();
        }
        wk[k] = s; ek[k] = be; wsum += s;
    }
    const float inv = 2.5f / wsum;
    if (lane < 8) {
        float wv = 0.f; int e = 0;
#pragma unroll
        for (int k = 0; k < 8; ++k) if (lane == k) { wv = wk[k]; e = ek[k]; }
        const unsigned pos = atomicAdd(&ecnt[e], 1u);
        lists[(size_t)e * NTOK + pos] = tok * 8 + lane;
        topw[tok * 8 + lane] = wv * inv;
    }
}
constexpr int NTHREADS = 512, NWAVES = 8;
constexpr int LDS_BYTES = 147456;
constexpr int LDS_MISC = 147456 - 256;
constexpr int N_PHASES = 24;
struct Args { const float* in[25]; float* out; unsigned char* ws; int ph_lo, ph_hi; };

__global__ void __launch_bounds__(NTHREADS, 2) fwd_kernel(Args args) {
    extern __shared__ __attribute__((aligned(16))) unsigned char lds_raw[];
    LAS unsigned char* lds = (LAS unsigned char*)lds_raw;
    volatile LAS unsigned* MISC = (volatile LAS unsigned*)(lds + LDS_MISC);
    const int wave0 = __builtin_amdgcn_readfirstlane((int)threadIdx.x >> 6);
    const int G = gridDim.x, bx0 = blockIdx.x;
    const int NGW = G * NWAVES, GT = G * NTHREADS;
#define FRESH_TID(t) do { asm volatile("v_mbcnt_lo_u32_b32 %0, -1, 0\n\tv_mbcnt_hi_u32_b32 %0, -1, %0" : "=v"(t)); t += wave0 * 64; } while (0)
#define PHASE_BEGIN() LAUNDER(); int tid; FRESH_TID(tid); int bx = bx0; asm volatile("" : "+s"(bx)); \
    const int lane = tid & 63, wave = __builtin_amdgcn_readfirstlane(tid >> 6); const int gw = bx * NWAVES + wave, gtid = bx * NTHREADS + tid; \
    const int vcu = (G % 8 == 0) ? (bx % 8) * (G / 8) + bx / 8 : bx; (void)lane; (void)gw; (void)gtid; (void)vcu;
    typedef const __attribute__((address_space(1))) float* gfp_t;
    typedef __attribute__((address_space(1))) unsigned char* gws_t;
    typedef gfp_t __attribute__((address_space(4))) const* kargp_t;
    kargp_t kap = (kargp_t)__builtin_amdgcn_kernarg_segment_ptr();
    gws_t ws = (gws_t)kap[26];
    unsigned* ctl = (unsigned*)(ws + WS_CTL);
#define LAUNDER() asm volatile("" : "+s"(kap), "+s"(ws))
#define INP(k) ((const float*)kap[k])
#define in_x INP(0)
#define in_c INP(1)
#define in_ctx INP(2)
#define in_cctx INP(3)
#define ada_w INP(4)
#define ada_b INP(5)
#define norm1_g INP(6)
#define w_in INP(7)
#define conv_w INP(8)
#define na_rel_bias INP(9)
#define diff_lambda INP(10)
#define diff_subln_g INP(11)
#define w_branch_gate INP(12)
#define w_branch INP(13)
#define w_out INP(14)
#define norm2_g INP(15)
#define router_w INP(16)
#define router_bias INP(17)
#define e_wg INP(18)
#define e_wu INP(19)
#define e_wd INP(20)
#define s_wg INP(21)
#define s_wu INP(22)
#define s_wd INP(23)
#define final_g INP(24)
#define OUTP ((float*)kap[25])
#define MODS ((float*)(ws + WS_MODS))
#define LAM ((float*)(ws + WS_MODS + 512 * 1024))
#define Win_t ((bf16_t*)(ws + WS_WIN))
#define Wg_t ((bf16_t*)(ws + WS_WG))
#define Wb_t ((bf16_t*)(ws + WS_WB))
#define Wo_t ((bf16_t*)(ws + WS_WO))
#define Wr_t ((bf16_t*)(ws + WS_WR))
#define Wsgu_t ((bf16_t*)(ws + WS_WSGU))
#define Wsd_t ((bf16_t*)(ws + WS_WSD))
#define X ((float*)(ws + WS_X))
#define H ((bf16_t*)(ws + WS_H))
#define P ((bf16_t*)(ws + WS_P))
#define VTD ((bf16_t*)(ws + WS_VTD))
#define VTB ((bf16_t*)(ws + WS_VTB))
#define Z2R ((float*)(ws + WS_Z2R))
#define Z2I ((float*)(ws + WS_Z2I))
#define YBR ((bf16_t*)(ws + WS_YBR))
#define PB ((bf16_t*)(ws + WS_PB))
#define MACC ((bf16_t*)(ws + WS_MACC))
#define MRG ((bf16_t*)(ws + WS_MRG))
#define LOG ((float*)(ws + WS_LOG))
#define TOPW ((float*)(ws + WS_TOPW))
#define LIST ((int*)(ws + WS_LIST))
#define YS ((bf16_t*)(ws + WS_YS))
#define TCB ((float*)(ws + WS_TC))
    if (threadIdx.x < 64) MISC[threadIdx.x] = 0u;
    __syncthreads();
    const int lo = args.ph_lo, hi_ph = args.ph_hi;
    const bool multi = (hi_ph - lo) > 1;
    XcdBarrier bar; bar.bar = ctl + CW_BAR; bar.x = 0; bar.st = nullptr;
    if (multi) bar = xcd_barrier_post(ctl + CW_BAR, MISC + 8);
    if (multi && threadIdx.x == 0) MISC[16] = __hip_atomic_fetch_add(ctl + CW_RANK + 16 * bar.x, 1u, __ATOMIC_RELAXED, __HIP_MEMORY_SCOPE_AGENT);
    __syncthreads();
#ifndef PHMASK
#define PHMASK 0xFFFF
#endif
#define KIND(k) (((PHMASK) >> (k)) & 1)
#ifndef REPKIND
#define REPKIND -1
#endif
#ifndef REPN
#define REPN 1
#endif
#define NREP(k) (((k) == REPKIND) ? (1 + REPN) : 1)
#define IN(k) (lo <= (k) && (k) < hi_ph)
#define SEAM(k) do { if (IN(k) && IN((k) + 1)) xcd_barrier(bar); } while (0)

    for (int rep_ = 0; rep_ < NREP(0); ++rep_) if (KIND(0) && IN(0)) { if (rep_) { VM_WAIT(); __syncthreads(); } PHASE_BEGIN();
        LAS float* scr = (LAS float*)(lds + wave * 16384);
        for (int it = gw; it < 2 * 4864; it += NGW) {
            const int L = it / 4864; int r = it % 4864;
            if (r < 1280) { transpose_item(w_in + (size_t)L * DM * IN_DIM, DM, IN_DIM, Win_t + (size_t)L * IN_DIM * DM, scr, r, lane); continue; } r -= 1280;
            if (r < 2048) { const int i = r >> 9; transpose_item(w_branch_gate + (size_t)(L * 4 + i) * DM * DM, DM, DM, Wg_t + (size_t)L * 4096 * DM, scr, r & 511, lane, 3 + i); continue; } r -= 2048;
            if (r < 512) { const int i = r >> 7; transpose_item(w_branch + (size_t)(L * 4 + i) * 256 * DM, 256, DM, Wb_t + (size_t)(L * 4 + i) * DM * 256, scr, r & 127, lane); continue; } r -= 512;
            if (r < 512) { transpose_item(w_out + (size_t)L * DM * DM, DM, DM, Wo_t + (size_t)L * DM * DM, scr, r, lane); continue; } r -= 512;
            if (r < 128) { transpose_item(router_w + (size_t)L * DM * NEXP, DM, NEXP, Wr_t + (size_t)L * NEXP * DM, scr, r, lane); continue; } r -= 128;
            if (r < 128) { transpose_item(s_wg + (size_t)L * DM * EDIM, DM, EDIM, Wsgu_t + (size_t)L * 512 * DM, scr, r, lane, 1); continue; } r -= 128;
            if (r < 128) { transpose_item(s_wu + (size_t)L * DM * EDIM, DM, EDIM, Wsgu_t + (size_t)L * 512 * DM, scr, r, lane, 2); continue; } r -= 128;
            transpose_item(s_wd + (size_t)L * EDIM * DM, EDIM, DM, Wsd_t + (size_t)L * DM * EDIM, scr, r, lane);
        }
        __syncthreads();
        {
            LAS float* sv = (LAS float*)lds;
            LAS float* part = sv + 3 * DM;
            for (int i = tid; i < 3 * DM; i += NTHREADS) { const int v = i >> 10, k = i & 1023; const float c = (v < 2) ? in_c[v * DM + k] : in_cctx[k]; sv[i] = c / (1.0f + __expf(-c)); }
            __syncthreads();
            for (int item = bx; item < 2 * 96; item += G) {
                const int L = item / 96, col = (item % 96) * 64 + lane;
                const float* wp = ada_w + (size_t)L * DM * 6 * DM + col;
                float a0 = 0.f, a1 = 0.f, a2 = 0.f;
#pragma unroll 32
                for (int k = wave * 128; k < wave * 128 + 128; ++k) { const float wv = wp[(size_t)k * 6 * DM]; a0 += sv[k] * wv; a1 += sv[DM + k] * wv; a2 += sv[2 * DM + k] * wv; }
                part[(wave * 3 + 0) * 64 + lane] = a0; part[(wave * 3 + 1) * 64 + lane] = a1; part[(wave * 3 + 2) * 64 + lane] = a2;
                __syncthreads();
                if (tid < 192) { const int v = tid >> 6, l = tid & 63; float s = ada_b[(size_t)L * 6 * DM + (item % 96) * 64 + l];
#pragma unroll
                    for (int q = 0; q < 8; ++q) s += part[(q * 3 + v) * 64 + l];
                    MODS[((size_t)L * 3 + v) * 6 * DM + (item % 96) * 64 + l] = s; }
                __syncthreads();
            }
        }
        if (bx == 0 && tid < 2) {
            const float* lp = diff_lambda + tid * 128; float s0 = 0.f, s1 = 0.f;
            for (int i = 0; i < 32; ++i) { s0 += lp[i] * lp[32 + i]; s1 += lp[64 + i] * lp[96 + i]; }
            const float li = tid ? 0.35550906759f : 0.2f;
            LAM[tid] = __expf(s0) - __expf(s1) + li;
        }
    }
    SEAM(0);

    for (int L = 0; L < 2; ++L) {
        const int pb = 1 + 10 * L - (L ? 1 : 0);
        const int P_NORM1 = 1, P_INPROJ = L ? 13 : 2, P_MIX1 = P_INPROJ + 1, P_MIX2 = P_INPROJ + 2, P_MERGE = P_INPROJ + 3, P_GATE = P_INPROJ + 4, P_WOUT = P_INPROJ + 5,
                  P_NORM2 = P_WOUT + 1, P_ROUTE = P_WOUT + 2, P_TOPK = P_WOUT + 3, P_MOE = P_WOUT + 4, P_COMB = P_WOUT + 5;
        (void)pb;
#define mods (MODS + (size_t)L * 3 * 6 * DM)
        const int ntok = L ? NLAT : NTOK;
        const float lam_init = L ? 0.35550906759f : 0.2f;
#define kmax (ctl + CW_KMAX + 32 * L)
#define ecnt (ctl + CW_ECNT + 256 * L)

        if (KIND(1) && L == 0 && IN(P_NORM1)) { PHASE_BEGIN();
            for (int row = gw; row < NTOK; row += NGW) {
                const float* xr = row < NLAT ? in_x + (size_t)row * DM : in_ctx + (size_t)(row - NLAT) * DM;
                const int vec = row < SEQ ? 0 : (row < NLAT ? 1 : 2);
                f32x4 v[4];
#pragma unroll
                for (int j = 0; j < 4; ++j) v[j] = *(const f32x4*)(xr + 4 * lane + 256 * j);
                norm_mod_row(v, norm1_g, mods + (vec * 6 + 0) * DM, mods + (vec * 6 + 1) * DM, H + (size_t)row * DM, lane);
            }
        }
        if (L == 0) SEAM(P_NORM1);

        for (int rep_ = 0; rep_ < NREP(2); ++rep_) if (KIND(2) && IN(P_INPROJ)) { if (rep_) { VM_WAIT(); __syncthreads(); } PHASE_BEGIN();
            pg8::Gemm g{H, Win_t + (size_t)L * IN_DIM * DM, DM, DM, DM}; pg8::StaticOrder S; S.init(NTOK, IN_DIM, G, bx);
            pg8::EpiInproj E{P};
            pg8::gemm_phase(lds, g, S, E, tid);
        }
        SEAM(P_INPROJ);

        for (int rep_ = 0; rep_ < NREP(3); ++rep_) if (KIND(3) && IN(P_MIX1)) { if (rep_) { VM_WAIT(); __syncthreads(); } PHASE_BEGIN();
            f1b_tables(lds, tid);
            for (int u = bx; u < 512; u += G) { const int b = u >> 8, c = (u >> 2) & 63, g = u & 3; f1b_unit(P, Z2R, Z2I, lds, b, c, g, tid); }
            FRESH_TID(tid);
            for (int u = bx; u < 2 * 132; u += G) kvprep_item(P, VTD, VTB, kmax, lds, u / 132, u % 132, tid);
            FRESH_TID(tid);
            if (L == 0) for (int u = G - 1 - bx; u < 64; u += G) fctxb_unit(P, YBR, lds, u >> 5, (u >> 3) & 3, u & 7, tid);
            conv_phase(P, conv_w + (size_t)L * 3 * 256, YBR, ntok, gtid, GT);
        }
        SEAM(P_MIX1);

        for (int rep_ = 0; rep_ < NREP(4); ++rep_) if (KIND(4) && IN(P_MIX2)) { if (rep_) { VM_WAIT(); __syncthreads(); } PHASE_BEGIN();
            const float lam = LAM[L];
            for (int u = bx; u < 256; u += G) diff_unit<true>(P, VTD, YBR, diff_subln_g + L * 64, lam, lam_init, kmax, lds, u >> 7, (u >> 5) & 3, (u >> 7) * SEQ + (u & 31) * 256, 0, 132, tid);
            FRESH_TID(tid);
            for (int u = bx; u < 256; u += G) { const int b = u >> 7, r = u & 127; na_unit(P, VTB, YBR, na_rel_bias + (size_t)L * 1860, kmax, lds, b, r, b * SEQ + r * 64, 16, tid); }
            FRESH_TID(tid);
            for (int u = bx; u < 256; u += G) f2b_unit(Z2R, Z2I, YBR, lds, u >> 7, u & 127, tid);
            if (L == 0) {
                FRESH_TID(tid);
                for (int u = G - 1 - bx; u < 8; u += G) diff_unit<false>(P, VTD, YBR, diff_subln_g, lam, lam_init, kmax, lds, u >> 2, u & 3, NLAT + (u >> 2) * LCTX, 128, 132, tid);
                FRESH_TID(tid);
                for (int u = G - 9 - bx; u >= 0 && u < 8; u += G) { const int b = u >> 2, cq = u & 3; na_unit(P, VTB, YBR, na_rel_bias, kmax, lds, b, 0, NLAT + b * LCTX + cq * 64, 0, tid); }
            }
        }
        SEAM(P_MIX2);

        if (KIND(5) && IN(P_MERGE)) { PHASE_BEGIN();
            pg8::Gemm g{YBR, Wb_t + (size_t)L * 4 * DM * 256, DM, 256, 256}; pg8::StaticOrder S; S.init(ntok, 4096, G, bx); S.aostep = 256; pg8::EpiBf16 E{PB, 4096};
            pg8::gemm_phase(lds, g, S, E, tid);
        }
        SEAM(P_MERGE);

        for (int rep_ = 0; rep_ < NREP(5); ++rep_) if (KIND(5) && IN(P_GATE)) { if (rep_) { VM_WAIT(); __syncthreads(); } PHASE_BEGIN();
            const int xj = G - 1 - bx;
            pg8::ExtraOrder S; S.base.init(NLAT, 4096, G, bx); S.xpm = (L == 0 && xj < 32) ? 64 + (xj >> 4) : -1; S.xpn = xj & 15;
            pg8::Gemm g{H, Wg_t + (size_t)L * 4096 * DM, DM, DM, DM}; pg8::EpiGate4 E{PB, MRG};
            pg8::gemm_phase(lds, g, S, E, tid);
        }
        SEAM(P_GATE);

        if (KIND(6) && IN(P_WOUT)) { PHASE_BEGIN();
            pg8::Gemm g{MRG, Wo_t + (size_t)L * DM * DM, DM, DM, DM}; pg8::StaticOrder S; S.init(ntok, DM, G, bx);
            pg8::EpiResid E{L ? X : in_x, L ? X + (size_t)NLAT * DM : in_ctx, X, mods};
            pg8::gemm_phase(lds, g, S, E, tid);
        }
        SEAM(P_WOUT);

        for (int rep_ = 0; rep_ < NREP(7); ++rep_) if (KIND(7) && IN(P_NORM2)) { if (rep_) { VM_WAIT(); __syncthreads(); } PHASE_BEGIN();
            for (int row = gw; row < ntok; row += NGW) {
                const int vec = row < SEQ ? 0 : (row < NLAT ? 1 : 2);
                f32x4 v[4];
#pragma unroll
                for (int j = 0; j < 4; ++j) v[j] = *(const f32x4*)(X + (size_t)row * DM + 4 * lane + 256 * j);
                norm_mod_row(v, norm2_g + L * DM, mods + (vec * 6 + 3) * DM, mods + (vec * 6 + 4) * DM, H + (size_t)row * DM, lane);
            }
        }
        SEAM(P_NORM2);

        if (KIND(8) && IN(P_ROUTE)) { PHASE_BEGIN();
            const int nM = ntok / 256;
            { pg8::Gemm g{H, Wr_t + (size_t)L * NEXP * DM, DM, DM, DM}; pg8::PanelOrder S{nM, G, bx}; pg8::EpiF32 E{LOG, NEXP};
              pg8::gemm_phase(lds, g, S, E, tid); }
            __syncthreads();
            FRESH_TID(tid);
            { pg8::Gemm g{H, Wsgu_t + (size_t)L * 512 * DM, DM, DM, DM}; pg8::OffsetOrder S{nM, 2, G, bx, nM % G}; pg8::EpiSwiGLU E{MRG};
              pg8::gemm_phase(lds, g, S, E, tid); }
        }
        SEAM(P_ROUTE);

        if (KIND(8) && IN(P_TOPK)) { PHASE_BEGIN();
            for (int t = gw; t < ntok; t += NGW) route_token(LOG, router_bias + L * NEXP, t, ecnt, LIST, TOPW, lane);
            __syncthreads();
            FRESH_TID(tid);
            { pg8::Gemm g{MRG, Wsd_t + (size_t)L * DM * EDIM, EDIM, EDIM, EDIM}; pg8::StaticOrder S; S.init(ntok, DM, G, bx); pg8::EpiSlot8 E{YS};
              pg8::gemm_phase(lds, g, S, E, tid); }
        }
        SEAM(P_TOPK);

        for (int rep_ = 0; rep_ < NREP(9); ++rep_) if (KIND(9) && IN(P_MOE)) { if (rep_) { VM_WAIT(); __syncthreads(); } PHASE_BEGIN();
            LAS int* pref = (LAS int*)(lds + LDS_MISC - 2048);
            __syncthreads();
            if (tid < 256) pref[1 + tid] = (int)((__hip_atomic_load(&ecnt[tid], __ATOMIC_RELAXED, __HIP_MEMORY_SCOPE_AGENT) + (unsigned)(MO_ROWS - 1)) / (unsigned)MO_ROWS);
            if (tid == 0) pref[0] = 0;
            __syncthreads();
            if (tid == 0) { int s = 0; for (int e = 0; e < 256; ++e) { s += pref[1 + e]; pref[1 + e] = s; } }
            __syncthreads();
            const int total = pref[256];
            int xcu = vcu;
            if (multi) {
                int base = 0, tot = 0;
                for (int j = 0; j < 16; ++j) { const int cj = (int)xb_ld(ctl + CW_BAR + XB_XCNT(j)); base += (j < (int)bar.x) ? cj : 0; tot += cj; }
                if (tot == G) xcu = base + (int)MISC[16];
            }
            xcu = __builtin_amdgcn_readfirstlane(xcu);
            for (int uid = xcu; uid < total; uid += G) {
                int e = 0; { int a = 0, bq = 256; while (bq - a > 1) { const int m = (a + bq) >> 1; if (pref[m] <= uid) a = m; else bq = m; } e = a; }
                const int t = uid - pref[e], cnt = (int)__hip_atomic_load(&ecnt[e], __ATOMIC_RELAXED, __HIP_MEMORY_SCOPE_AGENT), r0 = t * MO_ROWS, nrows = min(MO_ROWS, cnt - r0);
                __syncthreads();
                if (tid < 128) { LAS int* rtok = (LAS int*)lds; int ent = (tid < nrows) ? LIST[(size_t)e * NTOK + r0 + tid] : -8;
                    rtok[tid] = ent >> 3; rtok[128 + tid] = (ent >> 3) * NSLOT + (ent & 7); ((LAS float*)lds)[256 + tid] = (tid < nrows) ? TOPW[ent] : 0.f; }
                __syncthreads();
                const size_t eo = (size_t)(L * NEXP + e);
                const int nm = __builtin_amdgcn_readfirstlane((nrows + 31) >> 5);
                if (nm == 4)      { int t4; FRESH_TID(t4); moe_unit<4>(e_wg + eo * DM * EDIM, e_wu + eo * DM * EDIM, e_wd + eo * EDIM * DM, H, YS, lds, nrows, t4); }
                else if (nm == 3) { int t3; FRESH_TID(t3); moe_unit<3>(e_wg + eo * DM * EDIM, e_wu + eo * DM * EDIM, e_wd + eo * EDIM * DM, H, YS, lds, nrows, t3); }
                else if (nm == 2) { int t2; FRESH_TID(t2); moe_unit<2>(e_wg + eo * DM * EDIM, e_wu + eo * DM * EDIM, e_wd + eo * EDIM * DM, H, YS, lds, nrows, t2); }
                else              { int t1; FRESH_TID(t1); moe_unit<1>(e_wg + eo * DM * EDIM, e_wu + eo * DM * EDIM, e_wd + eo * EDIM * DM, H, YS, lds, nrows, t1); }
            }
        }
        SEAM(P_MOE);

        if (KIND(10) && IN(P_COMB)) { PHASE_BEGIN();
            const float* mods1 = MODS + (size_t)3 * 6 * DM;
            for (int row = gw; row < ntok; row += NGW) {
                const int vec = row < SEQ ? 0 : (row < NLAT ? 1 : 2);
                float v[2][8];
#pragma unroll
                for (int j = 0; j < 2; ++j) {
                    const int c = 8 * lane + 512 * j;
                    float a[8] = {0.f, 0.f, 0.f, 0.f, 0.f, 0.f, 0.f, 0.f};
#pragma unroll
                    for (int k = 0; k < NSLOT; ++k) { const u32x4 y = __builtin_nontemporal_load((const u32x4*)(YS + ((size_t)row * NSLOT + k) * DM + c));
#pragma unroll
                        for (int i = 0; i < 4; ++i) { a[2 * i] += bflo(y[i]); a[2 * i + 1] += bfhi(y[i]); } }
                    const f32x4 g0 = *(const f32x4*)(mods + (vec * 6 + 5) * DM + c), g1 = *(const f32x4*)(mods + (vec * 6 + 5) * DM + c + 4);
                    const f32x4 x0 = *(const f32x4*)(X + (size_t)row * DM + c), x1 = *(const f32x4*)(X + (size_t)row * DM + c + 4);
#pragma unroll
                    for (int i = 0; i < 4; ++i) { v[j][i] = x0[i] + g0[i] * a[i]; v[j][4 + i] = x1[i] + g1[i] * a[4 + i]; }
                }
                float ss = 0.f;
#pragma unroll
                for (int j = 0; j < 2; ++j)
#pragma unroll
                    for (int i = 0; i < 8; ++i) ss += v[j][i] * v[j][i];
                const float rstd = __builtin_amdgcn_rsqf(wave_sum(ss, lane) * (1.f / DM) + EPS);
#pragma unroll
                for (int j = 0; j < 2; ++j) {
                    const int c = 8 * lane + 512 * j;
                    if (L == 0) {
                        *(f32x4*)(X + (size_t)row * DM + c) = (f32x4){v[j][0], v[j][1], v[j][2], v[j][3]}; *(f32x4*)(X + (size_t)row * DM + c + 4) = (f32x4){v[j][4], v[j][5], v[j][6], v[j][7]};
                        const float* gp = norm1_g + DM + c; const float* shp = mods1 + (vec * 6 + 0) * DM + c; const float* scp = mods1 + (vec * 6 + 1) * DM + c;
                        float y[8];
#pragma unroll
                        for (int i = 0; i < 8; ++i) y[i] = v[j][i] * rstd * gp[i] * (scp[i] + 1.0f) + shp[i];
                        u32x4 w; w.x = pk2(y[0], y[1]); w.y = pk2(y[2], y[3]); w.z = pk2(y[4], y[5]); w.w = pk2(y[6], y[7]);
                        *(u32x4*)(H + (size_t)row * DM + c) = w;
                    } else {
                        const float* gp = final_g + c;
                        f32x4 o0, o1;
#pragma unroll
                        for (int i = 0; i < 4; ++i) { o0[i] = v[j][i] * rstd * gp[i]; o1[i] = v[j][4 + i] * rstd * gp[4 + i]; }
                        *(f32x4*)(OUTP + (size_t)row * DM + c) = o0; *(f32x4*)(OUTP + (size_t)row * DM + c + 4) = o1;
                    }
                }
            }
        }
        if (L == 0) SEAM(P_COMB);
    }
#undef IN
#undef SEAM
#undef KIND
}

extern "C" void kernel_launch(void* const* d_in, const int* in_sizes, int n_in, void* d_out, int out_size, void* d_ws, size_t ws_size, hipStream_t stream) {
    static int grid = 0;
    if (grid == 0) {
        if (n_in != 25 || in_sizes[0] != NLAT * DM || out_size != NLAT * DM || ws_size < WS_END) { fprintf(stderr, "kernel_launch: unexpected shapes (n_in %d, ws %zu)\n", n_in, ws_size); grid = -1; return; }
        int dev = 0, cus = 0, per_cu = 0;
        if (hipGetDevice(&dev) != hipSuccess || hipDeviceGetAttribute(&cus, hipDeviceAttributeMultiprocessorCount, dev) != hipSuccess) { grid = -1; return; }
        if (hipFuncSetAttribute((const void*)fwd_kernel, hipFuncAttributeMaxDynamicSharedMemorySize, LDS_BYTES) != hipSuccess) { fprintf(stderr, "kernel_launch: hipFuncSetAttribute failed\n"); grid = -1; return; }
        if (hipOccupancyMaxActiveBlocksPerMultiprocessor(&per_cu, (const void*)fwd_kernel, NTHREADS, LDS_BYTES) != hipSuccess || per_cu < 1) fprintf(stderr, "kernel_launch: occupancy query says %d\n", per_cu);
        (void)hipGetLastError();
        grid = cus;
    }
    if (grid < 0) return;
    (void)hipMemsetAsync((char*)d_ws + WS_CTL, 0, CTL_ZERO_BYTES, stream);
    Args a{};
    for (int i = 0; i < 25; ++i) a.in[i] = (const float*)d_in[i];
    a.out = (float*)d_out; a.ws = (unsigned char*)d_ws;
#ifndef MK_LAUNCHES
#define MK_LAUNCHES 1
#endif
    if (MK_LAUNCHES == 1) { a.ph_lo = 0; a.ph_hi = N_PHASES; hipLaunchKernelGGL(fwd_kernel, dim3(grid), dim3(NTHREADS), LDS_BYTES, stream, a); }
    else for (int p = 0; p < N_PHASES; ++p) { a.ph_lo = p; a.ph_hi = p + 1; hipLaunchKernelGGL(fwd_kernel, dim3(grid), dim3(NTHREADS), LDS_BYTES, stream, a); }
}
```

```cpp
#include <hip/hip_runtime.h>
#include <cstdio>
#include <cstdint>

#define GAS __attribute__((address_space(1)))
#define LAS __attribute__((address_space(3)))
typedef unsigned short bf16_t;
typedef short bf16x8 __attribute__((ext_vector_type(8)));
typedef float f32x4 __attribute__((ext_vector_type(4)));
typedef float f32x2 __attribute__((ext_vector_type(2)));
typedef float f32x16 __attribute__((ext_vector_type(16)));
typedef unsigned u32x4 __attribute__((ext_vector_type(4)));
typedef unsigned u32x2 __attribute__((ext_vector_type(2)));

constexpr int DM = 1024, NBATCH = 2, SEQ = 8192, NLAT = NBATCH * SEQ, LCTX = 256, NCTX = NBATCH * LCTX, NTOK = NLAT + NCTX;
constexpr int IN_DIM = 2560, NEXP = 256, TOPK = 8, EDIM = 256, NKEY = SEQ + LCTX, NSLOT = 9;
constexpr float EPS = 1e-6f, LOG2E = 1.4426950408889634f;
constexpr float QD_SCALE = 0.17677669529663687f * LOG2E;
constexpr float QB_SCALE = 0.125f * LOG2E;

constexpr size_t MiB = 1u << 20;
constexpr size_t WS_CTL = 0, CTL_ZERO_BYTES = 1 * MiB;
constexpr size_t WS_MODS = 1 * MiB;
constexpr size_t WS_WIN = 2 * MiB, WS_WG = 12 * MiB, WS_WB = 28 * MiB, WS_WO = 32 * MiB, WS_WR = 36 * MiB, WS_WSGU = 37 * MiB  , WS_WSD = 39 * MiB  ;
constexpr size_t WS_X = 40 * MiB, WS_H = 106 * MiB, WS_P = 140 * MiB, WS_VTD = 224 * MiB, WS_VTB = 233 * MiB;
constexpr size_t WS_Z2R = 242 * MiB, WS_Z2I = 258 * MiB, WS_YBR = 274 * MiB, WS_PB = 308 * MiB, WS_MACC = 440 * MiB, WS_MRG = 506 * MiB;
constexpr size_t WS_LOG = 540 * MiB, WS_TOPW = 558 * MiB, WS_LIST = 560 * MiB, WS_YS = 580 * MiB, WS_TC = 880 * MiB  , WS_END = 888 * MiB;
constexpr int CW_TMO = 0, CW_BAR = 4096, CW_KMAX = 8192  , CW_ECNT = 12288  , CW_GS = 16384, CW_PROG = 49152  , CW_RANK = 32768  , CW_MOEQ = 65792  ;

typedef __bf16 bf16x2_t __attribute__((ext_vector_type(2)));
__device__ __forceinline__ unsigned pk2a(float lo, float hi) { unsigned r; asm("v_cvt_pk_bf16_f32 %0, %1, %2" : "=v"(r) : "v"(lo), "v"(hi)); return r; }
__device__ __forceinline__ unsigned pk2(float lo, float hi) { const f32x2 v = {lo, hi}; const bf16x2_t b = __builtin_convertvector(v, bf16x2_t); return __builtin_bit_cast(unsigned, b); }
__device__ __forceinline__ float bflo(unsigned w) { return __uint_as_float(w << 16); }
__device__ __forceinline__ float bfhi(unsigned w) { return __uint_as_float(w & 0xffff0000u); }
__device__ __forceinline__ float bf1(bf16_t b) { return __uint_as_float(((unsigned)b) << 16); }
__device__ __forceinline__ float ex2(float x) { return __builtin_amdgcn_exp2f(x); }
__device__ __forceinline__ int crow(int r, int hi) { return (r & 3) + 8 * (r >> 2) + 4 * hi; }
__device__ __forceinline__ float sx(float v, int o, int lane) { return __int_as_float(__builtin_amdgcn_ds_bpermute((lane ^ o) << 2, __float_as_int(v))); }
__device__ __forceinline__ int sxi(int v, int o, int lane) { return __builtin_amdgcn_ds_bpermute((lane ^ o) << 2, v); }
__device__ __forceinline__ float shf(float v, int src) { return __int_as_float(__builtin_amdgcn_ds_bpermute(src << 2, __float_as_int(v))); }
__device__ __forceinline__ float wave_sum(float v, int lane) {
#pragma unroll
    for (int o = 1; o < 64; o <<= 1) v += sx(v, o, lane);
    return v;
}
#define LDS_WAIT() asm volatile("s_waitcnt lgkmcnt(0)" ::: "memory")
#define VM_WAIT() asm volatile("s_waitcnt vmcnt(0)" ::: "memory")

#define XB_TMO      128
#define XB_XCNT(j)  (256  + 64 * (j))
#define XB_XSUB(j)  (1280 + 64 * (j))
#define XB_XGEN(j)  (2304 + 64 * (j))
#define XB_TOP      3328
#define XB_TOPGEN   3392
#define XCD_BAR_WORDS 3456
#define XB_SPIN_CAP (1u << 22)
__device__ __forceinline__ unsigned xb_ld(unsigned* p)              { return __hip_atomic_load(p, __ATOMIC_RELAXED, __HIP_MEMORY_SCOPE_AGENT); }
__device__ __forceinline__ unsigned xb_add(unsigned* p, unsigned v) { return __hip_atomic_fetch_add(p, v, __ATOMIC_RELAXED, __HIP_MEMORY_SCOPE_AGENT); }
__device__ __forceinline__ unsigned xb_xcc_id() { return (unsigned)__builtin_amdgcn_s_getreg((3 << 11) | 20) & 0xFu; }
#define XB_SPIN(cond, bar) do { unsigned _sp = 0; while (cond) { __builtin_amdgcn_s_sleep(1); \
    if ((++_sp & 255u) == 0u) { if (xb_ld(&(bar)[XB_TMO])) break; if (_sp > XB_SPIN_CAP) { atomicAdd(&(bar)[XB_TMO], 1u); break; } } } } while (0)
struct XcdBarrier { unsigned* bar; unsigned x; volatile LAS unsigned* st; };
__device__ __forceinline__ XcdBarrier xcd_barrier_post(unsigned* bar, volatile LAS unsigned* st) {
    XcdBarrier b; b.bar = bar; b.x = xb_xcc_id(); b.st = st;
    if (threadIdx.x == 0) (void)xb_add(&bar[XB_XCNT(b.x)], 1u);
    return b;
}
__device__ __forceinline__ void xcd_barrier_complete(unsigned* bar, unsigned x, unsigned& nloc, unsigned& nx) {
    const unsigned G = gridDim.x * gridDim.y * gridDim.z;
    unsigned sum, cnt, mine, sp = 0u;
    for (;;) {
        sum = 0u; cnt = 0u; mine = 0u;
#pragma unroll
        for (unsigned j = 0; j < 16; ++j) { const unsigned c = xb_ld(&bar[XB_XCNT(j)]); sum += c; cnt += (c > 0u) ? 1u : 0u; mine = (j == x) ? c : mine; }
        if (sum == G) break;
        __builtin_amdgcn_s_sleep(1);
        if ((++sp & 255u) == 0u) { if (xb_ld(&bar[XB_TMO])) break; if (sp > XB_SPIN_CAP) { atomicAdd(&bar[XB_TMO], 1u); break; } }
    }
    nloc = mine > 0u ? mine : 1u; nx = cnt > 0u ? cnt : 1u;
}
__device__ __forceinline__ void xcd_barrier(const XcdBarrier& b) {
    asm volatile("s_waitcnt vmcnt(0)" ::: "memory");
    __syncthreads();
    if (threadIdx.x == 0) {
        unsigned* bar = b.bar;
        __builtin_amdgcn_s_waitcnt(0);
        unsigned nloc = b.st[0], nx = b.st[1];
        if (nloc == 0u) { xcd_barrier_complete(bar, b.x, nloc, nx); b.st[0] = nloc; b.st[1] = nx; }
        const unsigned old = xb_add(&bar[XB_XSUB(b.x)], 1u);
        const unsigned gen = old / nloc;
        if (old + 1u == (gen + 1u) * nloc) {
            __builtin_amdgcn_fence(__ATOMIC_RELEASE, "agent");
            asm volatile("s_waitcnt vmcnt(0)" ::: "memory");
            const unsigned og = xb_add(&bar[XB_TOP], 1u);
            const unsigned tg = og / nx;
            if (og + 1u == (tg + 1u) * nx) xb_add(&bar[XB_TOPGEN], 1u);
            else XB_SPIN(xb_ld(&bar[XB_TOPGEN]) == tg, bar);
            __builtin_amdgcn_fence(__ATOMIC_ACQUIRE, "agent");
            xb_add(&bar[XB_XGEN(b.x)], 1u);
            asm volatile("s_waitcnt vmcnt(0)" ::: "memory");
        } else {
            XB_SPIN(xb_ld(&bar[XB_XGEN(b.x)]) == gen, bar);
            __builtin_amdgcn_fence(__ATOMIC_ACQUIRE, "agent");
            asm volatile("s_waitcnt vmcnt(0)" ::: "memory");
        }
    }
    __syncthreads();
}
namespace pg8 {
constexpr int BM = 256, BK = 64, HALF = 128, HTB = HALF * BK * 2, STAGE_BYTES = 8 * HTB, NXCD = 8, WGM = 8;
__host__ __device__ __forceinline__ int lds_byte(int r, int c) { const int st = (r >> 4) * 2 + (c >> 5), rr = r & 15, cc = c & 31, ob = rr * 64 + cc * 2; return st * 1024 + (ob ^ (((ob >> 9) & 1) << 5)); }
__host__ __device__ __forceinline__ void stage_rc(int b, int& R, int& C) { const int st = b / 1024, sb = b % 1024, swz = sb ^ (((sb >> 9) & 1) << 5); R = (st >> 1) * 16 + swz / 64; C = (st & 1) * 32 + (swz % 64) / 2; }
__host__ __device__ __forceinline__ int perm32(int rho) { const int n = rho >> 4, i = rho & 15; return 8 * (i >> 2) + 4 * n + (i & 3); }

struct Unit { int pm, pn, ao; };
struct Gemm { const bf16_t* A; const bf16_t* Bt; int lda, ldb, K; };

struct StaticOrder {
    int nM, nN, nwg, G, c, aostep = 0;
    __device__ void init(int M, int N, int G_, int c_) { nM = M / BM; nN = N / BM; nwg = nM * nN; G = G_; c = c_; }
    __device__ bool next(int i, Unit& u) const {
        const long L = (long)i * G + c; if (L >= nwg) return false;
        int wgid = (int)L; { const int q = nwg / NXCD, r = nwg % NXCD, xcd = wgid % NXCD, off = wgid / NXCD; wgid = (xcd < r ? xcd * (q + 1) : r * (q + 1) + (xcd - r) * q) + off; }
        const int nig = WGM * nN, gid = wgid / nig, fm = gid * WGM, gsz = (nM - fm) < WGM ? (nM - fm) : WGM;
        u.pm = fm + ((wgid % nig) % gsz); u.pn = (wgid % nig) / gsz; u.ao = (u.pn >> 2) * aostep; return true;
    }
};
struct ExtraOrder {
    StaticOrder base; int xpm, xpn;
    __device__ bool next(int i, Unit& u) const {
        const int nb = (base.c < base.nwg) ? (base.nwg - base.c + base.G - 1) / base.G : 0;
        if (i < nb) return base.next(i, u);
        if (i == nb && xpm >= 0) { u.pm = xpm; u.pn = xpn; u.ao = 0; return true; }
        return false;
    }
};
struct ComboOrder {
    int ncombo, G, c, aostep, xpm, xpn;
    __device__ bool next(int i, Unit& u) const {
        const int ncb = (c < ncombo) ? (ncombo - c + G - 1) / G : 0;
        if (i < 4 * ncb) { const int combo = c + (i >> 2) * G; const int g = i & 3; u.pm = combo >> 2; u.pn = g * 4 + (combo & 3); u.ao = g * aostep; return true; }
        if (i == 4 * ncb && xpm >= 0) { u.pm = xpm; u.pn = xpn; u.ao = (xpn >> 2) * aostep; return true; }
        return false;
    }
};
struct PanelOrder {
    int nM, G, c;
    __device__ bool next(int i, Unit& u) const { const int p = c + i * G; if (p >= nM) return false; u.pm = p; u.pn = 0; u.ao = 0; return true; }
};

template <class Epi, class Sched>
__device__ __forceinline__ void gemm_phase(LAS unsigned char* lds, const Gemm g, const Sched& S, const Epi& E, const int tid) {
    const int wid = __builtin_amdgcn_readfirstlane(tid >> 6), lane = tid & 63, wr = wid >> 2, wc = wid & 3, fr = lane & 15, fq = lane >> 4;
    const int K = g.K, nt = K / BK;
    unsigned voffA[2], voffB[2];
#pragma unroll
    for (int i = 0; i < 2; ++i) { int R, C; stage_rc(tid * 16 + i * 8192, R, C); const int Rb = Epi::PERM ? ((R & ~31) + perm32(R & 31)) : R;
        voffA[i] = (unsigned)(R * g.lda + C) * 2u; voffB[i] = (unsigned)(Rb * g.ldb + C) * 2u; }
    const size_t kstep = (size_t)(BK * 2);
    const size_t hsA = (size_t)HALF * g.lda * 2, hsB = (size_t)HALF * g.ldb * 2;
    const size_t tsA = 2 * hsA, tsB = 2 * hsB;
    const unsigned ldsw = (unsigned)wid * 1024u;
    const int aoff = lds_byte(wr * 64 + fr, fq * 8), boff = lds_byte(wc * 32 + fr, fq * 8);
#define PG8_SA(b, h) (((b) * 2 + (h)) * HTB)
#define PG8_SB(b, h) ((4 + (b) * 2 + (h)) * HTB)
#define PG8_STAGE(bufoff, gbase, voff) do { _Pragma("unroll") for (int _i = 0; _i < 2; ++_i) \
        __builtin_amdgcn_global_load_lds((const unsigned*)((const char*)(gbase) + (voff)[_i]), (LAS unsigned*)(lds + (bufoff) + ldsw + _i * 8192), 16, 0, 0); } while (0)
#define PG8_LDA(dst, b, h) do { _Pragma("unroll") for (int m = 0; m < 4; ++m) _Pragma("unroll") for (int k = 0; k < 2; ++k) dst[m][k] = *(const LAS bf16x8*)(lds + PG8_SA(b, h) + aoff + m * 2048 + k * 1024); } while (0)
#define PG8_LDB(dst, b, h) do { _Pragma("unroll") for (int n = 0; n < 2; ++n) _Pragma("unroll") for (int k = 0; k < 2; ++k) dst[n][k] = *(const LAS bf16x8*)(lds + PG8_SB(b, h) + boff + n * 2048 + k * 1024); } while (0)
#define PG8_MMA(ai, bj, At, Bt) do { __builtin_amdgcn_s_setprio(1); _Pragma("unroll") for (int m = 0; m < 4; ++m) _Pragma("unroll") for (int n = 0; n < 2; ++n) _Pragma("unroll") for (int k = 0; k < 2; ++k) \
        acc[ai][bj][m][n] = __builtin_amdgcn_mfma_f32_16x16x32_bf16(Bt[n][k], At[m][k], acc[ai][bj][m][n], 0, 0, 0); __builtin_amdgcn_s_setprio(0); } while (0)
#define PG8_WAIT_V(n) asm volatile("s_waitcnt vmcnt(" #n ")" ::: "memory")
#define PG8_WAIT_L(n) asm volatile("s_waitcnt lgkmcnt(" #n ")" ::: "memory")
#define PG8_BAR __builtin_amdgcn_s_barrier()
#define PG8_SCHED __builtin_amdgcn_sched_barrier(0)
    Unit cur, nxt; int ui = 0;
    if (!S.next(0, cur)) return;
    f32x4 acc[2][2][4][2];
#pragma unroll
    for (int a = 0; a < 2; ++a)
#pragma unroll
        for (int b = 0; b < 2; ++b)
#pragma unroll
            for (int m = 0; m < 4; ++m)
#pragma unroll
                for (int n = 0; n < 2; ++n) acc[a][b][m][n] = (f32x4){0.f, 0.f, 0.f, 0.f};
    bf16x8 At[4][2], B0[2][2], B1[2][2];
    const char* cA = (const char*)g.A + (size_t)cur.pm * tsA + (size_t)cur.ao * 2; const char* cB = (const char*)g.Bt + (size_t)cur.pn * tsB;
    PG8_STAGE(PG8_SB(0, 0), cB, voffB); PG8_STAGE(PG8_SB(0, 1), cB + hsB, voffB); PG8_STAGE(PG8_SA(0, 0), cA, voffA); PG8_STAGE(PG8_SA(0, 1), cA + hsA, voffA);
    if (wr == 1) PG8_BAR;
    PG8_WAIT_V(2); PG8_BAR;
    PG8_STAGE(PG8_SB(1, 0), cB + kstep, voffB); PG8_STAGE(PG8_SA(1, 0), cA + kstep, voffA); PG8_STAGE(PG8_SB(1, 1), cB + hsB + kstep, voffB);
    PG8_WAIT_V(6); PG8_BAR;
    for (;;) {
        const bool has_next = S.next(ui + 1, nxt);
        const char* nA = has_next ? (const char*)g.A + (size_t)nxt.pm * tsA + (size_t)nxt.ao * 2 : cA; const char* nB = has_next ? (const char*)g.Bt + (size_t)nxt.pn * tsB : cB;
#pragma unroll 1
        for (int t = 0; t < nt; t += 2) {
            const bool last = (t == nt - 2);
            const char* a1 = cA + (size_t)(t + 1) * kstep;
            const char* a2 = last ? nA : cA + (size_t)(t + 2) * kstep; const char* b2 = last ? nB : cB + (size_t)(t + 2) * kstep;
            const char* a3 = a2 + kstep; const char* b3 = b2 + kstep;
            PG8_LDB(B0, 0, 0); PG8_LDB(B1, 0, 1); PG8_SCHED; PG8_LDA(At, 0, 0); PG8_STAGE(PG8_SA(1, 1), a1 + hsA, voffA);
            PG8_WAIT_V(8); PG8_WAIT_L(0); PG8_BAR; PG8_MMA(0, 0, At, B0); PG8_MMA(0, 1, At, B1); PG8_BAR; PG8_SCHED;
            PG8_LDA(At, 0, 1); PG8_STAGE(PG8_SB(0, 0), b2, voffB); PG8_STAGE(PG8_SB(0, 1), b2 + hsB, voffB); PG8_STAGE(PG8_SA(0, 0), a2, voffA);
            PG8_WAIT_V(8); PG8_WAIT_L(0); PG8_BAR; PG8_MMA(1, 0, At, B0); PG8_MMA(1, 1, At, B1); PG8_BAR; PG8_SCHED;
            PG8_LDB(B0, 1, 0); PG8_LDB(B1, 1, 1); PG8_SCHED; PG8_LDA(At, 1, 0); PG8_STAGE(PG8_SA(0, 1), a2 + hsA, voffA);
            PG8_WAIT_V(8); PG8_WAIT_L(0); PG8_BAR; PG8_MMA(0, 0, At, B0); PG8_MMA(0, 1, At, B1); PG8_BAR; PG8_SCHED;
            PG8_LDA(At, 1, 1); PG8_STAGE(PG8_SB(1, 0), b3, voffB); PG8_STAGE(PG8_SB(1, 1), b3 + hsB, voffB); PG8_STAGE(PG8_SA(1, 0), a3, voffA);
            PG8_WAIT_V(8); PG8_WAIT_L(0); PG8_BAR; PG8_MMA(1, 0, At, B0); PG8_MMA(1, 1, At, B1); PG8_BAR; PG8_SCHED;
        }
        if (wr == 0) PG8_BAR;
        { int fr_ = fr, fq_ = fq; asm volatile("" : "+v"(fr_), "+v"(fq_)); E(acc, cur, wr, wc, fr_, fq_); }
        if (!has_next) break;
#pragma unroll
        for (int a = 0; a < 2; ++a)
#pragma unroll
            for (int b = 0; b < 2; ++b)
#pragma unroll
                for (int m = 0; m < 4; ++m)
#pragma unroll
                    for (int n = 0; n < 2; ++n) acc[a][b][m][n] = (f32x4){0.f, 0.f, 0.f, 0.f};
        cur = nxt; cA = nA; cB = nB; ++ui;
        if (wr == 1) PG8_BAR;
    }
    PG8_WAIT_V(0);
    PG8_BAR;
#undef PG8_SA
#undef PG8_SB
#undef PG8_STAGE
#undef PG8_LDA
#undef PG8_LDB
#undef PG8_MMA
#undef PG8_WAIT_V
#undef PG8_WAIT_L
#undef PG8_BAR
#undef PG8_SCHED
}
}
namespace pg8 {
struct EpiInproj {
    static constexpr bool PERM = true;
    bf16_t* P;
    __device__ __forceinline__ void operator()(const f32x4 (&acc)[2][2][4][2], const Unit& u, int wr, int wc, int fr, int fq) const {
        const int row0 = u.pm * BM + wr * 64 + fr, col0 = u.pn * BM + wc * 32 + 8 * fq;
        const bool rope = (u.pn == 7 || u.pn == 8) && (u.pm < NLAT / BM);
        const float sc = (u.pn == 7) ? QD_SCALE : (u.pn == 1 ? QB_SCALE : 1.0f);
#pragma unroll
        for (int ai = 0; ai < 2; ++ai)
#pragma unroll
            for (int m = 0; m < 4; ++m) {
                const int row = row0 + ai * HALF + m * 16;
                bf16_t* rowp = P + (size_t)row * IN_DIM + col0;
                float cs[8], sn[8];
                if (rope) {
                    const int t = row & (SEQ - 1); const float pos = (float)((fq < 2) ? (t >> 6) : (t & 63));
                    const float sg = (fq & 1) ? 1.0f : -1.0f;
#pragma unroll
                    for (int i = 0; i < 8; ++i) {
                        constexpr float INVREV[8] = {0.15915494309189535f, 0.050329212104487034f, 0.015915494309189534f, 0.0050329212104487035f,
                                                     0.0015915494309189536f, 0.00050329212104487036f, 0.00015915494309189535f, 0.000050329212104487036f};
                        const float rev = pos * INVREV[i]; const float fr_ = rev - __builtin_floorf(rev);
                        cs[i] = __builtin_amdgcn_cosf(fr_); sn[i] = __builtin_amdgcn_sinf(fr_) * sg;
                    }
                }
#pragma unroll
                for (int bj = 0; bj < 2; ++bj) {
                    float v[8];
#pragma unroll
                    for (int i = 0; i < 4; ++i) { v[i] = acc[ai][bj][m][0][i]; v[4 + i] = acc[ai][bj][m][1][i]; }
                    if (rope) {
#pragma unroll
                        for (int i = 0; i < 8; ++i) { const float pr = sx(v[i], 16, fr + 16 * fq); v[i] = v[i] * cs[i] + pr * sn[i]; }
                    }
                    u32x4 w; w.x = pk2a(v[0] * sc, v[1] * sc); w.y = pk2a(v[2] * sc, v[3] * sc); w.z = pk2a(v[4] * sc, v[5] * sc); w.w = pk2a(v[6] * sc, v[7] * sc);
                    *(u32x4*)(rowp + bj * HALF) = w;
                }
            }
    }
};
struct EpiBf16 {
    static constexpr bool PERM = true;
    bf16_t* O; int ldc;
    __device__ __forceinline__ void operator()(const f32x4 (&acc)[2][2][4][2], const Unit& u, int wr, int wc, int fr, int fq) const {
        const int row0 = u.pm * BM + wr * 64 + fr, col0 = u.pn * BM + wc * 32 + 8 * fq;
#pragma unroll
        for (int ai = 0; ai < 2; ++ai)
#pragma unroll
            for (int m = 0; m < 4; ++m) { bf16_t* rowp = O + (size_t)(row0 + ai * HALF + m * 16) * ldc + col0;
#pragma unroll
                for (int bj = 0; bj < 2; ++bj) { const f32x4 v0 = acc[ai][bj][m][0], v1 = acc[ai][bj][m][1];
                    u32x4 w; w.x = pk2a(v0[0], v0[1]); w.y = pk2a(v0[2], v0[3]); w.z = pk2a(v1[0], v1[1]); w.w = pk2a(v1[2], v1[3]);
                    *(u32x4*)(rowp + bj * HALF) = w; } }
    }
};
struct EpiGate {
    static constexpr bool PERM = true;
    const bf16_t* PB; bf16_t* MACC; bf16_t* MRG; float* TC;
    __device__ __forceinline__ void operator()(const f32x4 (&acc)[2][2][4][2], const Unit& u, int wr, int wc, int fr, int fq) const {
        const int gate = u.pn >> 2, ct = u.pn & 3;
        const int row0 = u.pm * BM + wr * 64 + fr, col0 = ct * BM + wc * 32 + 8 * fq;
        const bool ctx = u.pm >= NLAT / BM, rmw = !ctx && gate != 0;
#pragma unroll
        for (int ai = 0; ai < 2; ++ai)
#pragma unroll
            for (int m = 0; m < 4; ++m) {
                const size_t row = (size_t)(row0 + ai * HALF + m * 16);
                u32x4 pw[2], ow[2];
#pragma unroll
                for (int bj = 0; bj < 2; ++bj) { const int col = col0 + bj * HALF;
                    pw[bj] = *(const u32x4*)(PB + row * 4096 + gate * 1024 + col);
                    if (rmw) ow[bj] = *(const u32x4*)(MACC + row * DM + col); }
#pragma unroll
                for (int bj = 0; bj < 2; ++bj) {
                    const int col = col0 + bj * HALF;
                    float t[8];
                    const float pv[8] = {bflo(pw[bj].x), bfhi(pw[bj].x), bflo(pw[bj].y), bfhi(pw[bj].y), bflo(pw[bj].z), bfhi(pw[bj].z), bflo(pw[bj].w), bfhi(pw[bj].w)};
#pragma unroll
                    for (int i = 0; i < 8; ++i) { const float a = (i < 4) ? acc[ai][bj][m][0][i & 3] : acc[ai][bj][m][1][i & 3];
                        t[i] = pv[i] * __builtin_amdgcn_rcpf(1.0f + ex2(-a * LOG2E)); }
                    if (ctx) { float* tp = TC + ((size_t)gate * NCTX + (row - NLAT)) * DM + col;
                        *(f32x4*)tp = (f32x4){t[0], t[1], t[2], t[3]}; *(f32x4*)(tp + 4) = (f32x4){t[4], t[5], t[6], t[7]}; continue; }
                    if (rmw) {
#pragma unroll
                        for (int i = 0; i < 4; ++i) { t[2 * i] += bflo(ow[bj][i]); t[2 * i + 1] += bfhi(ow[bj][i]); } }
                    u32x4 w; w.x = pk2a(t[0], t[1]); w.y = pk2a(t[2], t[3]); w.z = pk2a(t[4], t[5]); w.w = pk2a(t[6], t[7]);
                    *(u32x4*)((gate != 3 ? MACC : MRG) + row * DM + col) = w;
                }
                asm volatile("" ::: "memory");
            }
    }
};
struct EpiGate4 {
    static constexpr bool PERM = true;
    const bf16_t* PB; bf16_t* MRG;
    __device__ __forceinline__ void operator()(const f32x4 (&acc)[2][2][4][2], const Unit& u, int wr, int wc, int fr, int fq) const {
        const int row0 = u.pm * BM + wr * 64 + fr, oc0 = u.pn * 64 + 16 * wc + 4 * fq;
#pragma unroll
        for (int ai = 0; ai < 2; ++ai)
#pragma unroll
            for (int m = 0; m < 4; ++m) {
                const size_t row = (size_t)(row0 + ai * HALF + m * 16);
                u32x2 pw[4];
#pragma unroll
                for (int g = 0; g < 4; ++g) pw[g] = *(const u32x2*)(PB + row * 4096 + g * 1024 + oc0);
                float t[4] = {0.f, 0.f, 0.f, 0.f};
#pragma unroll
                for (int g = 0; g < 4; ++g) { const f32x4 a = acc[ai][g >> 1][m][g & 1]; const float pv[4] = {bflo(pw[g].x), bfhi(pw[g].x), bflo(pw[g].y), bfhi(pw[g].y)};
#pragma unroll
                    for (int i = 0; i < 4; ++i) t[i] += pv[i] * __builtin_amdgcn_rcpf(1.0f + ex2(-a[i] * LOG2E)); }
                u32x2 w; w.x = pk2a(t[0], t[1]); w.y = pk2a(t[2], t[3]);
                *(u32x2*)(MRG + row * DM + oc0) = w;
                if (m & 1) asm volatile("" ::: "memory");
            }
    }
};
struct EpiResid {
    static constexpr bool PERM = false;
    const float* base_lat; const float* base_ctx; float* X; const float* mods;
    __device__ __forceinline__ void operator()(const f32x4 (&acc)[2][2][4][2], const Unit& u, int wr, int wc, int fr, int fq) const {
        const int row0 = u.pm * BM + wr * 64 + fr, col0 = u.pn * BM + wc * 32 + 4 * fq;
        const int vec = u.pm < 32 ? 0 : (u.pm < 64 ? 1 : 2);
        const float* gv = mods + (vec * 6 + 2) * DM;
        f32x4 g4[2][2];
#pragma unroll
        for (int bj = 0; bj < 2; ++bj)
#pragma unroll
            for (int n = 0; n < 2; ++n) g4[bj][n] = *(const f32x4*)(gv + col0 + bj * HALF + n * 16);
#pragma unroll
        for (int ai = 0; ai < 2; ++ai)
#pragma unroll
            for (int m = 0; m < 4; ++m) { const int row = row0 + ai * HALF + m * 16;
                const float* bp = (row < NLAT) ? base_lat + (size_t)row * DM : base_ctx + (size_t)(row - NLAT) * DM;
                float* xp = X + (size_t)row * DM;
#pragma unroll
                for (int bj = 0; bj < 2; ++bj)
#pragma unroll
                    for (int n = 0; n < 2; ++n) { const int c = col0 + bj * HALF + n * 16;
                        const f32x4 b = *(const f32x4*)(bp + c); *(f32x4*)(xp + c) = b + g4[bj][n] * acc[ai][bj][m][n]; }
                asm volatile("" ::: "memory"); }
    }
};
struct EpiSwiGLU {
    static constexpr bool PERM = true;
    bf16_t* ACT;
    __device__ __forceinline__ void operator()(const f32x4 (&acc)[2][2][4][2], const Unit& u, int wr, int wc, int fr, int fq) const {
        const int row0 = u.pm * BM + wr * 64 + fr, col0 = u.pn * 128 + wc * 32 + 8 * fq;
#pragma unroll
        for (int ai = 0; ai < 2; ++ai)
#pragma unroll
            for (int m = 0; m < 4; ++m) {
                float a[8];
#pragma unroll
                for (int i = 0; i < 8; ++i) { const float g = (i < 4) ? acc[ai][0][m][0][i & 3] : acc[ai][0][m][1][i & 3], uu = (i < 4) ? acc[ai][1][m][0][i & 3] : acc[ai][1][m][1][i & 3];
                    a[i] = g * __builtin_amdgcn_rcpf(1.0f + ex2(-g * LOG2E)) * uu; }
                u32x4 w; w.x = pk2a(a[0], a[1]); w.y = pk2a(a[2], a[3]); w.z = pk2a(a[4], a[5]); w.w = pk2a(a[6], a[7]);
                *(u32x4*)(ACT + (size_t)(row0 + ai * HALF + m * 16) * EDIM + col0) = w;
            }
    }
};
struct EpiSlot8 {
    static constexpr bool PERM = true;
    bf16_t* YSP;
    __device__ __forceinline__ void operator()(const f32x4 (&acc)[2][2][4][2], const Unit& u, int wr, int wc, int fr, int fq) const {
        const int row0 = u.pm * BM + wr * 64 + fr, col0 = u.pn * BM + wc * 32 + 8 * fq;
#pragma unroll
        for (int ai = 0; ai < 2; ++ai)
#pragma unroll
            for (int m = 0; m < 4; ++m) { bf16_t* rowp = YSP + ((size_t)(row0 + ai * HALF + m * 16) * NSLOT + 8) * DM + col0;
#pragma unroll
                for (int bj = 0; bj < 2; ++bj) { const f32x4 v0 = acc[ai][bj][m][0], v1 = acc[ai][bj][m][1];
                    u32x4 w; w.x = pk2a(v0[0], v0[1]); w.y = pk2a(v0[2], v0[3]); w.z = pk2a(v1[0], v1[1]); w.w = pk2a(v1[2], v1[3]);
                    *(u32x4*)(rowp + bj * HALF) = w; } }
    }
};
struct OffsetOrder {
    int nM, nN, G, c, off;
    __device__ bool next(int i, Unit& u) const { const int q = ((c + G - off) % G) + i * G; if (q >= nM * nN) return false; u.pm = q / nN; u.pn = q % nN; u.ao = 0; return true; }
};
struct EpiF32 {
    static constexpr bool PERM = false;
    float* C; int ldc;
    __device__ __forceinline__ void operator()(const f32x4 (&acc)[2][2][4][2], const Unit& u, int wr, int wc, int fr, int fq) const {
        const int row0 = u.pm * BM + wr * 64 + fr, col0 = u.pn * BM + wc * 32 + 4 * fq;
#pragma unroll
        for (int ai = 0; ai < 2; ++ai)
#pragma unroll
            for (int m = 0; m < 4; ++m) { float* rowp = C + (size_t)(row0 + ai * HALF + m * 16) * ldc + col0;
#pragma unroll
                for (int bj = 0; bj < 2; ++bj)
#pragma unroll
                    for (int n = 0; n < 2; ++n) *(f32x4*)(rowp + bj * HALF + n * 16) = acc[ai][bj][m][n]; }
    }
};
}
__device__ __forceinline__ void transpose_item(const float* W, int K, int N, bf16_t* WT, LAS float* scr, int item, int lane, int gu = 0) {
    const int nblk = N / 32, kb = item / nblk, nb = item % nblk, k0 = 64 * kb, n0 = 32 * nb;
    const int d0 = (gu == 1 || gu == 2) ? ((n0 >> 7) * 256 + (gu - 1) * 128 + (n0 & 127)) : n0;
    const int gg = (gu >= 3) ? (gu - 3) : -1;
#pragma unroll 8
    for (int i = 0; i < 32; ++i) { const int kk = 2 * i + (lane >> 5); scr[kk * 33 + (lane & 31)] = W[(size_t)(k0 + kk) * N + n0 + (lane & 31)]; }
    LDS_WAIT(); asm volatile("" ::: "memory");
    const int c = lane & 7;
#pragma unroll
    for (int j = 0; j < 4; ++j) { const int n = (lane >> 3) + 8 * j; const LAS float* s = scr + (8 * c) * 33 + n;
        u32x4 o; o.x = pk2(s[0 * 33], s[1 * 33]); o.y = pk2(s[2 * 33], s[3 * 33]); o.z = pk2(s[4 * 33], s[5 * 33]); o.w = pk2(s[6 * 33], s[7 * 33]);
        const int oc = n0 + n; const int drow = (gg >= 0) ? ((oc >> 6) * 256 + 128 * (gg >> 1) + 32 * ((oc >> 4) & 3) + 8 * ((oc >> 2) & 3) + 4 * (gg & 1) + (oc & 3)) : (d0 + n);
        *(u32x4*)(WT + (size_t)drow * K + k0 + 8 * c) = o; }
    LDS_WAIT(); asm volatile("" ::: "memory");
}

__device__ __forceinline__ void norm_mod_row(const f32x4 (&v)[4], const float* g, const float* shift, const float* scale, bf16_t* orow, int lane) {
    float ss = 0.f;
#pragma unroll
    for (int j = 0; j < 4; ++j) ss += (v[j].x * v[j].x + v[j].y * v[j].y) + (v[j].z * v[j].z + v[j].w * v[j].w);
    const float rstd = __builtin_amdgcn_rsqf(wave_sum(ss, lane) * (1.f / DM) + EPS);
#pragma unroll
    for (int j = 0; j < 4; ++j) {
        const int c = 4 * lane + 256 * j;
        const f32x4 gg = *(const f32x4*)(g + c), sh = *(const f32x4*)(shift + c), sc = *(const f32x4*)(scale + c);
        const f32x4 y = v[j] * rstd * gg * (sc + 1.0f) + sh;
        u32x2 w; w.x = pk2(y.x, y.y); w.y = pk2(y.z, y.w);
        *(u32x2*)(orow + c) = w;
    }
}

__device__ __forceinline__ void conv_phase(const bf16_t* P, const float* cw  , bf16_t* YBR, int ntok, int gtid, int gthreads) {
    for (int idx = gtid; idx < ntok * 32; idx += gthreads) {
        const int tok = idx >> 5, p = idx & 31;
        int t, n; if (tok < NLAT) { t = tok & (SEQ - 1); n = SEQ; } else { t = (tok - NLAT) & (LCTX - 1); n = LCTX; }
        const bf16_t* r = P + (size_t)tok * IN_DIM + 8 * p;
        const u32x4 gb = *(const u32x4*)(r + 1024);
        const u32x4 z = {0u, 0u, 0u, 0u};
        const u32x4 c0 = (t > 0) ? *(const u32x4*)(r - IN_DIM + 1280) : z, x0 = (t > 0) ? *(const u32x4*)(r - IN_DIM + 1536) : z;
        const u32x4 c1 = *(const u32x4*)(r + 1280), x1 = *(const u32x4*)(r + 1536);
        const u32x4 c2 = (t < n - 1) ? *(const u32x4*)(r + IN_DIM + 1280) : z, x2 = (t < n - 1) ? *(const u32x4*)(r + IN_DIM + 1536) : z;
        float o[8];
#pragma unroll
        for (int i = 0; i < 4; ++i) {
            const int ch = 8 * p + 2 * i;
            const float w00 = cw[ch], w01 = cw[256 + ch], w02 = cw[512 + ch], w10 = cw[ch + 1], w11 = cw[256 + ch + 1], w12 = cw[512 + ch + 1];
            const float u0l = bflo(c0[i]) * bflo(x0[i]), u0h = bfhi(c0[i]) * bfhi(x0[i]);
            const float u1l = bflo(c1[i]) * bflo(x1[i]), u1h = bfhi(c1[i]) * bfhi(x1[i]);
            const float u2l = bflo(c2[i]) * bflo(x2[i]), u2h = bfhi(c2[i]) * bfhi(x2[i]);
            o[2 * i] = bflo(gb[i]) * (w00 * u0l + w01 * u1l + w02 * u2l);
            o[2 * i + 1] = bfhi(gb[i]) * (w10 * u0h + w11 * u1h + w12 * u2h);
        }
        u32x4 w; w.x = pk2(o[0], o[1]); w.y = pk2(o[2], o[3]); w.z = pk2(o[4], o[5]); w.w = pk2(o[6], o[7]);
        *(u32x4*)(YBR + (size_t)tok * DM + 512 + 8 * p) = w;
    }
}

__device__ __forceinline__ int key_row(int b, int key) { return key < SEQ ? b * SEQ + key : NLAT + b * LCTX + (key - SEQ); }
__device__ __forceinline__ void kvprep_item(const bf16_t* P, bf16_t* VTD, bf16_t* VTB, unsigned* kmax, LAS unsigned char* lds, int b, int kblk, int tid) {
    LAS bf16_t* T = (LAS bf16_t*)lds;
    LAS unsigned* mx = (LAS unsigned*)(lds + 64 * 264 * 2);
    const int key0 = kblk * 64, row0 = key_row(b, key0);
    if (tid < 12) mx[tid] = 0u;
#pragma unroll
    for (int which = 0; which < 2; ++which) {
        const int coff = which ? 768 : 2304; bf16_t* VT = which ? VTB : VTD;
        __syncthreads();
#pragma unroll
        for (int j = 0; j < 4; ++j) { const int pid = tid + 512 * j, kr = pid >> 5, seg = pid & 31;
            *(LAS u32x4*)(T + kr * 264 + seg * 8) = *(const u32x4*)(P + (size_t)(row0 + kr) * IN_DIM + coff + seg * 8); }
        __syncthreads();
#pragma unroll
        for (int j = 0; j < 4; ++j) { const int pid = tid + 512 * j, col = pid >> 3, kp = pid & 7;
            unsigned w[4];
#pragma unroll
            for (int i = 0; i < 4; ++i) w[i] = (unsigned)T[(kp * 8 + 2 * i) * 264 + col] | ((unsigned)T[(kp * 8 + 2 * i + 1) * 264 + col] << 16);
            *(u32x4*)(VT + ((size_t)(b * 4 + (col >> 6)) * 64 + (col & 63)) * NKEY + key0 + kp * 8) = (u32x4){w[0], w[1], w[2], w[3]}; }
    }
    {
        const int kr = tid >> 3, hm = tid & 7;
        const bf16_t* rp = P + (size_t)(row0 + kr) * IN_DIM + hm * 32;
        float sd = 0.f, sb = 0.f;
#pragma unroll
        for (int j = 0; j < 4; ++j) { const u32x4 a = *(const u32x4*)(rp + 2048 + 8 * j), c = *(const u32x4*)(rp + 512 + 8 * j);
#pragma unroll
            for (int i = 0; i < 4; ++i) { sd += bflo(a[i]) * bflo(a[i]) + bfhi(a[i]) * bfhi(a[i]); sb += bflo(c[i]) * bflo(c[i]) + bfhi(c[i]) * bfhi(c[i]); } }
        sb += sx(sb, 1, tid & 63);
        atomicMax((unsigned*)&mx[hm], __float_as_uint(sd));
        if ((hm & 1) == 0) atomicMax((unsigned*)&mx[8 + (hm >> 1)], __float_as_uint(sb));
    }
    __syncthreads();
    if (tid < 8) atomicMax(&kmax[b * 8 + tid], mx[tid]);
    else if (tid < 12) atomicMax(&kmax[16 + b * 4 + (tid - 8)], mx[tid]);
    __syncthreads();
}
#define MFMA_F32(a, b, c) __builtin_amdgcn_mfma_f32_32x32x2f32((a), (b), (c), 0, 0, 0)
#define MFMA_BF(a, b, c) __builtin_amdgcn_mfma_f32_32x32x16_bf16((a), (b), (c), 0, 0, 0)
__device__ __forceinline__ f32x16 zero16() { f32x16 z;
#pragma unroll
    for (int i = 0; i < 16; ++i) z[i] = 0.f; return z; }
__device__ __forceinline__ void f1_unit(const bf16_t* P, float* Z2R, float* Z2I, LAS unsigned char* lds, int b, int c, int g, int tid) {
    LAS float* V = (LAS float*)lds;
    LAS float* tab = (LAS float*)(lds + 128 * 132 * 4);
    const int lane = tid & 63, w = __builtin_amdgcn_readfirstlane(tid >> 6), l32 = lane & 31, hi = lane >> 5;
    if (tid < 64) { const float x = (float)tid * (1.f / 64.f); tab[tid] = __builtin_amdgcn_cosf(x); tab[64 + tid] = __builtin_amdgcn_sinf(x); }
    else if (tid < 192) { const int i = tid - 64; const float x = (float)i * (1.f / 128.f); tab[128 + i] = __builtin_amdgcn_cosf(x); tab[256 + i] = __builtin_amdgcn_sinf(x); }
    __syncthreads();
    {
        const int mt = w >> 1, part = w & 1, r = mt * 32 + l32;
        const bf16_t* up = P + (size_t)(b * SEQ + r * 64 + c) * IN_DIM + g * 64;
        u32x4 uq[8];
#pragma unroll
        for (int i = 0; i < 8; ++i) uq[i] = *(const u32x4*)(up + 8 * i);
        f32x16 a0 = zero16(), a1 = zero16();
        const LAS float* tb = tab + part * 64; const float sgn = part ? -1.f : 1.f;
#pragma unroll
        for (int s = 0; s < 32; ++s) {
            const unsigned wv = uq[s >> 2][s & 3]; const float a = hi ? bfhi(wv) : bflo(wv);
            const int j = 2 * s + hi;
            const float b0 = tb[(j * l32) & 63] * sgn, b1 = tb[(j * (32 + l32)) & 63] * sgn;
            a0 = MFMA_F32(a, b0, a0); a1 = MFMA_F32(a, b1, a1);
        }
#pragma unroll
        for (int q = 0; q < 16; ++q) { const int rr = mt * 32 + crow(q, hi); V[rr * 132 + part * 64 + l32] = a0[q]; V[rr * 132 + part * 64 + 32 + l32] = a1[q]; }
    }
    __syncthreads();
    {
        const int mt = w >> 1, mh = w & 1, ka = mt * 32 + l32;
        f32x16 Tr = zero16(), Ti = zero16();
#pragma unroll 4
        for (int s = 0; s < 64; ++s) {
            const int r = 2 * s + hi, idx = (ka * r) & 127;
            const float aC = tab[128 + idx], aS = tab[256 + idx];
            const float bR = V[r * 132 + mh * 32 + l32], bI = V[r * 132 + 64 + mh * 32 + l32];
            Tr = MFMA_F32(aC, bR, Tr); Tr = MFMA_F32(aS, bI, Tr); Ti = MFMA_F32(aC, bI, Ti); Ti = MFMA_F32(-aS, bR, Ti);
        }
#pragma unroll
        for (int q = 0; q < 16; ++q) {
            const int k = mt * 32 + crow(q, hi); const float x = (float)((k * c) & 8191) * (1.f / 8192.f);
            const float cs = __builtin_amdgcn_cosf(x), sn = __builtin_amdgcn_sinf(x);
            const size_t o = ((((size_t)(b * 128 + k) * 4 + g) * 64 + c) * 64) + mh * 32 + l32;
            Z2R[o] = Tr[q] * cs + Ti[q] * sn; Z2I[o] = Ti[q] * cs - Tr[q] * sn;
        }
    }
    __syncthreads();
}

constexpr int F1_TSTR = 272, F1_TC = 0, F1_TS = 128 * F1_TSTR, F1_TF = 2 * 128 * F1_TSTR, F1_FSTR = 144, F1_VT = F1_TF + 128 * F1_FSTR;
__device__ __forceinline__ void f1b_tables(LAS unsigned char* lds, int tid) {
    for (int i = tid; i < 128 * 128; i += 512) { const int ka = i >> 7, r = i & 127; const float x = (float)((ka * r) & 127) * (1.f / 128.f);
        *(LAS bf16_t*)(lds + F1_TC + ka * F1_TSTR + r * 2) = (bf16_t)(pk2(__builtin_amdgcn_cosf(x), 0.f) & 0xffffu);
        *(LAS bf16_t*)(lds + F1_TS + ka * F1_TSTR + r * 2) = (bf16_t)(pk2(__builtin_amdgcn_sinf(x), 0.f) & 0xffffu); }
    for (int i = tid; i < 128 * 64; i += 512) { const int xx = i >> 6, j = i & 63; const float x = (float)((j * (xx & 63)) & 63) * (1.f / 64.f);
        const float v = (xx < 64) ? __builtin_amdgcn_cosf(x) : -__builtin_amdgcn_sinf(x);
        *(LAS bf16_t*)(lds + F1_TF + xx * F1_FSTR + j * 2) = (bf16_t)(pk2(v, 0.f) & 0xffffu); }
    __syncthreads();
}
__device__ __forceinline__ void f1b_unit(const bf16_t* P, float* Z2R, float* Z2I, LAS unsigned char* lds, int b, int c, int g, int tid) {
    const int lane = tid & 63, w = __builtin_amdgcn_readfirstlane(tid >> 6), l32 = lane & 31, hi = lane >> 5;
    {
        const int mt = w >> 1, xh = w & 1, r = mt * 32 + l32;
        const bf16_t* up = P + (size_t)(b * SEQ + r * 64 + c) * IN_DIM + g * 64;
        f32x16 a0 = zero16(), a1 = zero16();
#pragma unroll
        for (int ks = 0; ks < 4; ++ks) {
            const bf16x8 uf = *(const bf16x8*)(up + ks * 16 + 8 * hi);
            const bf16x8 f0 = *(const LAS bf16x8*)(lds + F1_TF + (xh * 64 + l32) * F1_FSTR + (ks * 16 + 8 * hi) * 2), f1 = *(const LAS bf16x8*)(lds + F1_TF + (xh * 64 + 32 + l32) * F1_FSTR + (ks * 16 + 8 * hi) * 2);
            a0 = MFMA_BF(uf, f0, a0); a1 = MFMA_BF(uf, f1, a1);
        }
#pragma unroll
        for (int rg = 0; rg < 4; ++rg) {
            const int r0 = mt * 32 + 8 * rg + 4 * hi;
            u32x2 v0, v1; v0.x = pk2(a0[4 * rg], a0[4 * rg + 1]); v0.y = pk2(a0[4 * rg + 2], a0[4 * rg + 3]); v1.x = pk2(a1[4 * rg], a1[4 * rg + 1]); v1.y = pk2(a1[4 * rg + 2], a1[4 * rg + 3]);
            *(LAS u32x2*)(lds + F1_VT + (xh * 64 + l32) * F1_TSTR + r0 * 2) = v0; *(LAS u32x2*)(lds + F1_VT + (xh * 64 + 32 + l32) * F1_TSTR + r0 * 2) = v1;
            if (xh == 0) { v0.x ^= 0x80008000u; v0.y ^= 0x80008000u; v1.x ^= 0x80008000u; v1.y ^= 0x80008000u;
                *(LAS u32x2*)(lds + F1_VT + (128 + l32) * F1_TSTR + r0 * 2) = v0; *(LAS u32x2*)(lds + F1_VT + (160 + l32) * F1_TSTR + r0 * 2) = v1; }
        }
    }
    __syncthreads();
    {
        const int mt = w >> 1, mh = w & 1;
        f32x16 Tr = zero16(), Ti = zero16();
#pragma unroll
        for (int ks = 0; ks < 8; ++ks) {
            const int ko = (ks * 16 + 8 * hi) * 2;
            const bf16x8 aC = *(const LAS bf16x8*)(lds + F1_TC + (mt * 32 + l32) * F1_TSTR + ko), aS = *(const LAS bf16x8*)(lds + F1_TS + (mt * 32 + l32) * F1_TSTR + ko);
            const bf16x8 bR = *(const LAS bf16x8*)(lds + F1_VT + (mh * 32 + l32) * F1_TSTR + ko), bI = *(const LAS bf16x8*)(lds + F1_VT + (64 + mh * 32 + l32) * F1_TSTR + ko),
                         bN = *(const LAS bf16x8*)(lds + F1_VT + (128 + mh * 32 + l32) * F1_TSTR + ko);
            Tr = MFMA_BF(aC, bR, Tr); Tr = MFMA_BF(aS, bI, Tr); Ti = MFMA_BF(aC, bI, Ti); Ti = MFMA_BF(aS, bN, Ti);
        }
#pragma unroll
        for (int q = 0; q < 16; ++q) {
            const int k = mt * 32 + crow(q, hi); const float x = (float)((k * c) & 8191) * (1.f / 8192.f);
            const float cs = __builtin_amdgcn_cosf(x), sn = __builtin_amdgcn_sinf(x);
            const size_t o = ((((size_t)(b * 128 + k) * 4 + g) * 64 + c) * 64) + mh * 32 + l32;
            Z2R[o] = Tr[q] * cs + Ti[q] * sn; Z2I[o] = Ti[q] * cs - Tr[q] * sn;
        }
    }
    __syncthreads();
}
__device__ __forceinline__ void f2_unit(const float* Z2R, const float* Z2I, bf16_t* YBR, LAS unsigned char* lds, int b, int ka, int tid) {
    LAS float* tab = (LAS float*)lds;
    const int lane = tid & 63, w = __builtin_amdgcn_readfirstlane(tid >> 6), l32 = lane & 31, hi = lane >> 5;
    if (tid < 64) { const float x = (float)tid * (1.f / 64.f); tab[tid] = __builtin_amdgcn_cosf(x); tab[64 + tid] = __builtin_amdgcn_sinf(x); }
    __syncthreads();
    const int g = w >> 1, kbh = w & 1, kb = kbh * 32 + l32;
    const size_t base = ((size_t)(b * 128 + ka) * 4 + g) * 4096;
    f32x16 Y0 = zero16(), Y1 = zero16();
#pragma unroll 4
    for (int s = 0; s < 32; ++s) {
        const int c = 2 * s + hi, idx = (kb * c) & 63;
        const float aC = tab[idx], aS = tab[64 + idx];
        const float r0 = Z2R[base + c * 64 + l32], r1 = Z2R[base + c * 64 + 32 + l32], i0 = Z2I[base + c * 64 + l32], i1 = Z2I[base + c * 64 + 32 + l32];
        Y0 = MFMA_F32(aC, r0, Y0); Y0 = MFMA_F32(aS, i0, Y0); Y1 = MFMA_F32(aC, r1, Y1); Y1 = MFMA_F32(aS, i1, Y1);
    }
    constexpr float NORM = 0.0013810679320049757f;
#pragma unroll
    for (int q = 0; q < 16; ++q) {
        const int kbo = kbh * 32 + crow(q, hi); bf16_t* op = YBR + (size_t)(b * SEQ + ka + 128 * kbo) * DM + g * 64 + l32;
        op[0] = (bf16_t)(pk2(Y0[q] * NORM, 0.f) & 0xffffu); op[32] = (bf16_t)(pk2(Y1[q] * NORM, 0.f) & 0xffffu);
    }
    __syncthreads();
}

__device__ __forceinline__ void f2b_unit(const float* Z2R, const float* Z2I, bf16_t* YBR, LAS unsigned char* lds, int b, int ka, int tid) {
    const int lane = tid & 63, w = __builtin_amdgcn_readfirstlane(tid >> 6), l32 = lane & 31, hi = lane >> 5;
    for (int i = tid; i < 64 * 64; i += 512) { const int kb = i >> 6, cc = i & 63; const float x = (float)((kb * cc) & 63) * (1.f / 64.f);
        *(LAS bf16_t*)(lds + kb * 144 + cc * 2) = (bf16_t)(pk2(__builtin_amdgcn_cosf(x), 0.f) & 0xffffu);
        *(LAS bf16_t*)(lds + 9216 + kb * 144 + cc * 2) = (bf16_t)(pk2(__builtin_amdgcn_sinf(x), 0.f) & 0xffffu); }
    const int g = w >> 1, nt = w & 1;
    LAS unsigned char* zt = lds + 18432 + w * 9216;
    const size_t base = ((size_t)(b * 128 + ka) * 4 + g) * 4096 + nt * 32;
    {
        const int cp = lane >> 3, m4 = lane & 7;
#pragma unroll
        for (int part = 0; part < 2; ++part) {
            const float* zp = (part ? Z2I : Z2R) + base + 4 * m4;
#pragma unroll
            for (int j = 0; j < 4; ++j) { const int c0 = 2 * cp + 16 * j;
                const f32x4 v0 = *(const f32x4*)(zp + (size_t)c0 * 64), v1 = *(const f32x4*)(zp + (size_t)(c0 + 1) * 64);
#pragma unroll
                for (int q = 0; q < 4; ++q) *(LAS unsigned*)(zt + part * 4608 + (4 * m4 + q) * 144 + c0 * 2) = pk2(v0[q], v1[q]); }
        }
    }
    __syncthreads();
    f32x16 Y0 = zero16(), Y1 = zero16();
#pragma unroll
    for (int ks = 0; ks < 4; ++ks) {
        const int ko = (ks * 16 + 8 * hi) * 2;
        const bf16x8 bR = *(const LAS bf16x8*)(zt + l32 * 144 + ko), bI = *(const LAS bf16x8*)(zt + 4608 + l32 * 144 + ko);
        const bf16x8 c0 = *(const LAS bf16x8*)(lds + l32 * 144 + ko), s0 = *(const LAS bf16x8*)(lds + 9216 + l32 * 144 + ko);
        const bf16x8 c1 = *(const LAS bf16x8*)(lds + (32 + l32) * 144 + ko), s1 = *(const LAS bf16x8*)(lds + 9216 + (32 + l32) * 144 + ko);
        Y0 = MFMA_BF(c0, bR, Y0); Y0 = MFMA_BF(s0, bI, Y0); Y1 = MFMA_BF(c1, bR, Y1); Y1 = MFMA_BF(s1, bI, Y1);
    }
    constexpr float NORM = 0.0013810679320049757f;
#pragma unroll
    for (int q = 0; q < 16; ++q) {
        const int kb0 = crow(q, hi); bf16_t* op = YBR + (size_t)(b * SEQ + ka + 128 * kb0) * DM + g * 64 + nt * 32 + l32;
        op[0] = (bf16_t)(pk2(Y0[q] * NORM, 0.f) & 0xffffu); op[(size_t)128 * 32 * DM] = (bf16_t)(pk2(Y1[q] * NORM, 0.f) & 0xffffu);
    }
    __syncthreads();
}

constexpr int FC_TF = 0, FC_TC = 18432, FC_TS = FC_TC + 32 * 528, FC_VT = FC_TS + 32 * 528;
__device__ __forceinline__ void fctxb_unit(const bf16_t* P, bf16_t* YBR, LAS unsigned char* lds, int b, int g, int kq, int tid) {
    const int lane = tid & 63, w = __builtin_amdgcn_readfirstlane(tid >> 6), l32 = lane & 31, hi = lane >> 5;
    for (int i = tid; i < 128 * 64; i += 512) { const int xx = i >> 6, j = i & 63; const float x = (float)((j * (xx & 63)) & 63) * (1.f / 64.f);
        const float v = (xx < 64) ? __builtin_amdgcn_cosf(x) : -__builtin_amdgcn_sinf(x);
        *(LAS bf16_t*)(lds + FC_TF + xx * 144 + j * 2) = (bf16_t)(pk2(v, 0.f) & 0xffffu); }
    for (int i = tid; i < 32 * 256; i += 512) { const int kk = i >> 8, t = i & 255; const float x = (float)(((kq * 32 + kk) * t) & 255) * (1.f / 256.f);
        *(LAS bf16_t*)(lds + FC_TC + kk * 528 + t * 2) = (bf16_t)(pk2(__builtin_amdgcn_cosf(x), 0.f) & 0xffffu);
        *(LAS bf16_t*)(lds + FC_TS + kk * 528 + t * 2) = (bf16_t)(pk2(__builtin_amdgcn_sinf(x), 0.f) & 0xffffu); }
    __syncthreads();
    {
        const int t = w * 32 + l32;
        const bf16_t* up = P + (size_t)(NLAT + b * LCTX + t) * IN_DIM + g * 64;
        f32x16 a[4] = {zero16(), zero16(), zero16(), zero16()};
#pragma unroll
        for (int ks = 0; ks < 4; ++ks) {
            const bf16x8 uf = *(const bf16x8*)(up + ks * 16 + 8 * hi);
#pragma unroll
            for (int xt = 0; xt < 4; ++xt) { const bf16x8 ff = *(const LAS bf16x8*)(lds + FC_TF + (xt * 32 + l32) * 144 + (ks * 16 + 8 * hi) * 2); a[xt] = MFMA_BF(uf, ff, a[xt]); }
        }
#pragma unroll
        for (int xt = 0; xt < 4; ++xt)
#pragma unroll
            for (int rg = 0; rg < 4; ++rg) { u32x2 v; v.x = pk2(a[xt][4 * rg], a[xt][4 * rg + 1]); v.y = pk2(a[xt][4 * rg + 2], a[xt][4 * rg + 3]);
                *(LAS u32x2*)(lds + FC_VT + (xt * 32 + l32) * 528 + (w * 32 + 8 * rg + 4 * hi) * 2) = v; }
    }
    __syncthreads();
    if (w < 2) {
        f32x16 Y = zero16();
#pragma unroll
        for (int ks = 0; ks < 16; ++ks) {
            const int ko = (ks * 16 + 8 * hi) * 2;
            const bf16x8 aC = *(const LAS bf16x8*)(lds + FC_TC + l32 * 528 + ko), aS = *(const LAS bf16x8*)(lds + FC_TS + l32 * 528 + ko);
            const bf16x8 bR = *(const LAS bf16x8*)(lds + FC_VT + (w * 32 + l32) * 528 + ko), bI = *(const LAS bf16x8*)(lds + FC_VT + (64 + w * 32 + l32) * 528 + ko);
            Y = MFMA_BF(aC, bR, Y); Y = MFMA_BF(aS, bI, Y);
        }
#pragma unroll
        for (int q = 0; q < 16; ++q) { const int ko = kq * 32 + crow(q, hi);
            YBR[(size_t)(NLAT + b * LCTX + ko) * DM + g * 64 + w * 32 + l32] = (bf16_t)(pk2(Y[q] * (1.f / 128.f), 0.f) & 0xffffu); }
    }
    __syncthreads();
}
__device__ __forceinline__ void fctx_unit(const bf16_t* P, bf16_t* YBR, LAS unsigned char* lds, int b, int g, int kq, int tid) {
    LAS float* V = (LAS float*)lds;
    LAS float* tab = (LAS float*)(lds + 256 * 132 * 4);
    const int lane = tid & 63, w = __builtin_amdgcn_readfirstlane(tid >> 6), l32 = lane & 31, hi = lane >> 5;
    if (tid < 64) { const float x = (float)tid * (1.f / 64.f); tab[tid] = __builtin_amdgcn_cosf(x); tab[64 + tid] = __builtin_amdgcn_sinf(x); }
    else if (tid < 320) { const int i = tid - 64; const float x = (float)i * (1.f / 256.f); tab[128 + i] = __builtin_amdgcn_cosf(x); tab[384 + i] = __builtin_amdgcn_sinf(x); }
    __syncthreads();
    {
        const int t = w * 32 + l32;
        const bf16_t* up = P + (size_t)(NLAT + b * LCTX + t) * IN_DIM + g * 64;
        u32x4 uq[8];
#pragma unroll
        for (int i = 0; i < 8; ++i) uq[i] = *(const u32x4*)(up + 8 * i);
        f32x16 a0 = zero16(), a1 = zero16(), a2 = zero16(), a3 = zero16();
#pragma unroll
        for (int s = 0; s < 32; ++s) {
            const unsigned wv = uq[s >> 2][s & 3]; const float a = hi ? bfhi(wv) : bflo(wv);
            const int j = 2 * s + hi, i0 = (j * l32) & 63, i1 = (j * (32 + l32)) & 63;
            a0 = MFMA_F32(a, tab[i0], a0); a1 = MFMA_F32(a, tab[i1], a1); a2 = MFMA_F32(a, -tab[64 + i0], a2); a3 = MFMA_F32(a, -tab[64 + i1], a3);
        }
#pragma unroll
        for (int q = 0; q < 16; ++q) { const int rr = w * 32 + crow(q, hi); LAS float* vp = V + rr * 132 + l32; vp[0] = a0[q]; vp[32] = a1[q]; vp[64] = a2[q]; vp[96] = a3[q]; }
    }
    __syncthreads();
    {
        const int mt = w >> 1, nt = w & 1, k = kq * 128 + mt * 32 + l32;
        f32x16 Y = zero16();
#pragma unroll 4
        for (int s = 0; s < 128; ++s) {
            const int t = 2 * s + hi, idx = (k * t) & 255;
            const float aC = tab[128 + idx], aS = tab[384 + idx];
            const float bR = V[t * 132 + nt * 32 + l32], bI = V[t * 132 + 64 + nt * 32 + l32];
            Y = MFMA_F32(aC, bR, Y); Y = MFMA_F32(aS, bI, Y);
        }
#pragma unroll
        for (int q = 0; q < 16; ++q) { const int ko = kq * 128 + mt * 32 + crow(q, hi);
            YBR[(size_t)(NLAT + b * LCTX + ko) * DM + g * 64 + nt * 32 + l32] = (bf16_t)(pk2(Y[q] * (1.f / 128.f), 0.f) & 0xffffu); }
    }
    __syncthreads();
}
__device__ __forceinline__ bf16x8 mk8(u32x2 lo, u32x2 hi) { u32x4 t = {lo.x, lo.y, hi.x, hi.y}; return __builtin_bit_cast(bf16x8, t); }
__device__ __forceinline__ float ssq8(bf16x8 v) { const u32x4 t = __builtin_bit_cast(u32x4, v); float s = 0.f;
#pragma unroll
    for (int i = 0; i < 4; ++i) s += bflo(t[i]) * bflo(t[i]) + bfhi(t[i]) * bfhi(t[i]);
    return s; }
__device__ __forceinline__ bf16x8 packp(const f32x16& p, int j) { u32x4 t = {pk2(p[8 * j], p[8 * j + 1]), pk2(p[8 * j + 2], p[8 * j + 3]), pk2(p[8 * j + 4], p[8 * j + 5]), pk2(p[8 * j + 6], p[8 * j + 7])}; return __builtin_bit_cast(bf16x8, t); }

constexpr int DA_KSTR = 144, DA_TILE = 64 * DA_KSTR;
__device__ __forceinline__ float sum16(const f32x16& S) {
    float a, b;
    asm("s_nop 0\n\tv_add_f32 %0, %2, %3\n\tv_add_f32 %1, %4, %5\n\tv_add_f32 %0, %0, %6\n\tv_add_f32 %1, %1, %7\n\tv_add_f32 %0, %0, %8\n\tv_add_f32 %1, %1, %9\n\t"
        "v_add_f32 %0, %0, %10\n\tv_add_f32 %1, %1, %11\n\tv_add_f32 %0, %0, %12\n\tv_add_f32 %1, %1, %13\n\tv_add_f32 %0, %0, %14\n\tv_add_f32 %1, %1, %15\n\t"
        "v_add_f32 %0, %0, %16\n\tv_add_f32 %1, %1, %17\n\tv_add_f32 %0, %0, %1"
        : "=&v"(a), "=&v"(b)
        : "v"(S[0]), "v"(S[1]), "v"(S[2]), "v"(S[3]), "v"(S[4]), "v"(S[5]), "v"(S[6]), "v"(S[7]), "v"(S[8]), "v"(S[9]), "v"(S[10]), "v"(S[11]), "v"(S[12]), "v"(S[13]), "v"(S[14]), "v"(S[15]));
    return a;
}
constexpr int DA_KT = 128 * DA_KSTR, DA_VSTR = 272, DA_VT = 64 * DA_VSTR;
template <bool FAST>
__device__ __forceinline__ void diff_loop(const bf16_t* P, const bf16_t* vsrc, LAS unsigned char* Kl, LAS unsigned char* Vl, const bf16x8 (&qf)[2][2], const float (&nb)[2],
                                          f32x16 (&O)[2][2], float (&ls)[2], int b, int h, int kt0, int kt1, int sr, int sg, int l32, int hi) {
#define DA_PV(Vbuf, koff) do { _Pragma("unroll") for (int t = 0; t < 2; ++t) _Pragma("unroll") for (int j = 0; j < 2; ++j) { \
        const LAS unsigned char* vp = (Vbuf) + (t * 32 + l32) * DA_VSTR + ((koff) + 16 * j + 4 * hi) * 2; \
        const bf16x8 vf = mk8(*(const LAS u32x2*)vp, *(const LAS u32x2*)(vp + 16)); \
        O[0][t] = MFMA_BF(vf, pb[0][j], O[0][t]); O[1][t] = MFMA_BF(vf, pb[1][j], O[1][t]); } } while (0)
#define DA_LOADK(T) do { const int key0 = (T) * 128; \
        st[0] = *(const u32x4*)(P + (size_t)key_row(b, key0 + sr) * IN_DIM + 2048 + h * 64 + sg * 8); st[1] = *(const u32x4*)(P + (size_t)key_row(b, key0 + 64 + sr) * IN_DIM + 2048 + h * 64 + sg * 8); } while (0)
#define DA_LOADV(T) do { const int key0 = (T) * 128; st[0] = *(const u32x4*)(vsrc + key0); st[1] = *(const u32x4*)(vsrc + key0 + 64); } while (0)
#define DA_STOREK(Kdst) do { *(LAS u32x4*)((Kdst) + sr * DA_KSTR + sg * 16) = st[0]; *(LAS u32x4*)((Kdst) + (64 + sr) * DA_KSTR + sg * 16) = st[1]; } while (0)
#define DA_STOREV(Vdst) do { *(LAS u32x4*)((Vdst) + sr * DA_VSTR + sg * 16) = st[0]; *(LAS u32x4*)((Vdst) + sr * DA_VSTR + 128 + sg * 16) = st[1]; } while (0)
    const int T0 = kt0 >> 1, T1 = kt1 >> 1;
    u32x4 st[2];
    DA_LOADK(T0); DA_STOREK(Kl); DA_LOADV(T0); DA_STOREV(Vl);
    __syncthreads();
    bf16x8 pb[2][2];
    int vc = 0, vp_ = 2 * DA_VT, vn = DA_VT;
    for (int T = T0; T < T1; ++T) {
        const int buf = (T - T0) & 1;
        if (T + 1 < T1) DA_LOADK(T + 1);
        const LAS unsigned char* Kb = Kl + buf * DA_KT;
#pragma unroll
        for (int kb = 0; kb < 4; ++kb) {
            f32x16 S[2];
#pragma unroll
            for (int mp = 0; mp < 2; ++mp) {
                if (FAST) S[mp] = zero16();
                else {
#pragma unroll
                    for (int i = 0; i < 16; ++i) S[mp][i] = nb[mp];
                }
#pragma unroll
                for (int ks = 0; ks < 2; ++ks) { const bf16x8 kf = *(const LAS bf16x8*)(Kb + (kb * 32 + l32) * DA_KSTR + (mp * 32 + ks * 16 + 8 * hi) * 2); S[mp] = MFMA_BF(kf, qf[mp][ks], S[mp]); }
            }
            if (kb > 0) DA_PV(Vl + vc, (kb - 1) * 32);
            else if (T != T0) DA_PV(Vl + vp_, 96);
#pragma unroll
            for (int mp = 0; mp < 2; ++mp) {
#pragma unroll
                for (int i = 0; i < 16; ++i) S[mp][i] = ex2(S[mp][i]);
                ls[mp] += sum16(S[mp]);
            }
#pragma unroll
            for (int mp = 0; mp < 2; ++mp) { pb[mp][0] = packp(S[mp], 0); pb[mp][1] = packp(S[mp], 1); }
            if (kb == 1 && T + 1 < T1) { DA_STOREK(Kl + (buf ^ 1) * DA_KT); DA_LOADV(T + 1); }
        }
        if (T + 1 < T1) DA_STOREV(Vl + vn);
        { const int t_ = vp_; vp_ = vc; vc = vn; vn = t_; }
        __syncthreads();
    }
    DA_PV(Vl + vp_, 96);
    __syncthreads();
#undef DA_PV
#undef DA_LOADK
#undef DA_LOADV
#undef DA_STOREK
#undef DA_STOREV
}
template <bool ALLOW_FAST>
__device__ __forceinline__ void diff_unit(const bf16_t* P, const bf16_t* VTD, bf16_t* YBR, const float* subg, float lam, float lam_init, const unsigned* kmax,
                                          LAS unsigned char* lds, int b, int h, int qrow0, int kt0, int kt1, int tid) {
    const int lane = tid & 63, w = __builtin_amdgcn_readfirstlane(tid >> 6), l32 = lane & 31, hi = lane >> 5;
    LAS unsigned char* Kl = lds; LAS unsigned char* Vl = lds + 2 * DA_KT;
    const int qrow = qrow0 + 32 * w + l32;
    bf16x8 qf[2][2];
#pragma unroll
    for (int mp = 0; mp < 2; ++mp)
#pragma unroll
        for (int ks = 0; ks < 2; ++ks) qf[mp][ks] = *(const bf16x8*)(P + (size_t)qrow * IN_DIM + 1792 + h * 64 + mp * 32 + ks * 16 + 8 * hi);
    float nb[2];
#pragma unroll
    for (int mp = 0; mp < 2; ++mp) { float s = ssq8(qf[mp][0]) + ssq8(qf[mp][1]); s += sx(s, 32, lane);
        nb[mp] = -(__builtin_sqrtf(s * __uint_as_float(kmax[b * 8 + h * 2 + mp])) * 1.0002f + 0.01f); }
    f32x16 O[2][2]; float ls[2] = {0.f, 0.f};
#pragma unroll
    for (int mp = 0; mp < 2; ++mp)
#pragma unroll
        for (int t = 0; t < 2; ++t) O[mp][t] = zero16();
    const int sr = tid >> 3, sg = tid & 7;
    const bf16_t* vsrc = VTD + ((size_t)(b * 4 + h) * 64 + sr) * NKEY + sg * 8;
    if (ALLOW_FAST && __all(nb[0] > -64.f && nb[1] > -64.f)) diff_loop<true>(P, vsrc, Kl, Vl, qf, nb, O, ls, b, h, kt0, kt1, sr, sg, l32, hi);
    else diff_loop<false>(P, vsrc, Kl, Vl, qf, nb, O, ls, b, h, kt0, kt1, sr, sg, l32, hi);
    ls[0] += sx(ls[0], 32, lane); ls[1] += sx(ls[1], 32, lane);
    const float i0 = 1.0f / ls[0], i1 = lam / ls[1];
    float ss = 0.f;
#pragma unroll
    for (int t = 0; t < 2; ++t)
#pragma unroll
        for (int i = 0; i < 16; ++i) { const float o = O[0][t][i] * i0 - O[1][t][i] * i1; O[0][t][i] = o; ss += o * o; }
    ss += sx(ss, 32, lane);
    const float rs = __builtin_amdgcn_rsqf(ss * (1.f / 64.f) + EPS) * (1.0f - lam_init);
    bf16_t* op = YBR + (size_t)qrow * DM + 768 + h * 64;
#pragma unroll
    for (int t = 0; t < 2; ++t)
#pragma unroll
        for (int rg = 0; rg < 4; ++rg) { const int d0 = t * 32 + 8 * rg + 4 * hi; const f32x4 gg = *(const f32x4*)(subg + d0);
            u32x2 wv; wv.x = pk2(O[0][t][4 * rg] * rs * gg.x, O[0][t][4 * rg + 1] * rs * gg.y); wv.y = pk2(O[0][t][4 * rg + 2] * rs * gg.z, O[0][t][4 * rg + 3] * rs * gg.w);
            *(u32x2*)(op + d0) = wv; }
}

constexpr int NA_KSTR = 528, NA_KT = 32 * NA_KSTR, NA_VSTR = 80, NA_VT = 256 * NA_VSTR, NA_BIAS_OFF = 2 * NA_KT + 2 * NA_VT;
__device__ __forceinline__ void na_unit(const bf16_t* P, const bf16_t* VTB, bf16_t* YBR, const float* relb  , const unsigned* kmax,
                                        LAS unsigned char* lds, int b, int r, int qrow0, int nwin, int tid) {
    const int lane = tid & 63, w = __builtin_amdgcn_readfirstlane(tid >> 6), l32 = lane & 31, hi = lane >> 5;
    const int h = w >> 1, qb = w & 1;
    LAS unsigned char* Kl = lds; LAS unsigned char* Vl = lds + 2 * NA_KT; LAS float* bl = (LAS float*)(lds + NA_BIAS_OFF);
    const int R0 = min(max(r - 4, 0), 120);
    for (int i = tid; i < 4 * 15 * 32; i += 512) { const int hd = i >> 5, dc = i & 31; bl[i] = (dc < 31) ? relb[hd * 31 + dc] * LOG2E : -1e30f; }
    const int qrow = qrow0 + 32 * qb + l32, qc = 32 * qb + l32;
    bf16x8 qf[4];
#pragma unroll
    for (int ks = 0; ks < 4; ++ks) qf[ks] = *(const bf16x8*)(P + (size_t)qrow * IN_DIM + 256 + h * 64 + ks * 16 + 8 * hi);
    __syncthreads();
    float mb = 0.f;
    if (nwin) { for (int i = lane; i < 465; i += 64) mb = fmaxf(mb, fabsf(relb[h * 465 + i]) * LOG2E);
#pragma unroll
        for (int o = 1; o < 64; o <<= 1) mb = fmaxf(mb, sx(mb, o, lane)); }
    float nb; { float s = ssq8(qf[0]) + ssq8(qf[1]) + ssq8(qf[2]) + ssq8(qf[3]); s += sx(s, 32, lane);
        nb = -(__builtin_sqrtf(s * __uint_as_float(kmax[16 + b * 4 + h])) * 1.0002f + mb + 0.01f); }
    f32x16 O[2] = {zero16(), zero16()}; float ls = 0.f;
    const int ntile = nwin + 8;
    u32x4 kreg[2], vreg[2];
#define NA_LOAD(tile) do { int krow0, vkey0; if ((tile) < nwin) { const int kr = R0 + ((tile) >> 1); vkey0 = kr * 64 + 32 * ((tile) & 1); krow0 = b * SEQ + vkey0; } \
        else { const int j_ = (tile) - nwin; vkey0 = SEQ + 32 * j_; krow0 = NLAT + b * LCTX + 32 * j_; } \
        _Pragma("unroll") for (int j = 0; j < 2; ++j) { const int pid = tid + 512 * j; \
            kreg[j] = *(const u32x4*)(P + (size_t)(krow0 + (pid >> 5)) * IN_DIM + 512 + (pid & 31) * 8); \
            const int rowhd = pid >> 2; vreg[j] = *(const u32x4*)(VTB + ((size_t)(b * 4 + (rowhd >> 6)) * 64 + (rowhd & 63)) * NKEY + vkey0 + (pid & 3) * 8); } } while (0)
#define NA_STORE(buf) do { _Pragma("unroll") for (int j = 0; j < 2; ++j) { const int pid = tid + 512 * j; \
            *(LAS u32x4*)(Kl + (buf) * NA_KT + (pid >> 5) * NA_KSTR + (pid & 31) * 16) = kreg[j]; \
            *(LAS u32x4*)(Vl + (buf) * NA_VT + (pid >> 2) * NA_VSTR + (pid & 3) * 16) = vreg[j]; } } while (0)
    NA_LOAD(0); NA_STORE(0);
    __syncthreads();
    const int col_lo = min(max(qc - 8, 0), 48);
    int boff[2][16];
#pragma unroll
    for (int hf = 0; hf < 2; ++hf)
#pragma unroll
        for (int i = 0; i < 16; ++i) { const int kc = 32 * hf + crow(i, hi); const bool ok = (kc >= col_lo) && (kc < col_lo + 16); boff[hf][i] = 4 * (ok ? (kc - qc + 15) : 31); }
    for (int tile0 = 0; tile0 < ntile; tile0 += 2) {
#pragma unroll
    for (int tb = 0; tb < 2; ++tb) {
        const int tile = tile0 + tb, buf = tb;
        if (tile + 1 < ntile) NA_LOAD(tile + 1);
        const LAS unsigned char* Kb = Kl + buf * NA_KT; const LAS unsigned char* Vb = Vl + buf * NA_VT;
        f32x16 S;
#pragma unroll
        for (int i = 0; i < 16; ++i) S[i] = nb;
#pragma unroll
        for (int ks = 0; ks < 4; ++ks) { const bf16x8 kf = *(const LAS bf16x8*)(Kb + l32 * NA_KSTR + (h * 64 + ks * 16 + 8 * hi) * 2); S = MFMA_BF(kf, qf[ks], S); }
        float ps = 0.f;
        if (tile < nwin) {
            const int kr = R0 + (tile >> 1);
            const LAS unsigned char* bp = (const LAS unsigned char*)(bl + (h * 15 + (kr - r + 7)) * 32);
#pragma unroll
            for (int i = 0; i < 16; ++i) { const float bv = *(const LAS float*)(bp + boff[tb][i]); S[i] = ex2(S[i] + bv); ps += S[i]; }
        } else {
#pragma unroll
            for (int i = 0; i < 16; ++i) { S[i] = ex2(S[i]); ps += S[i]; }
        }
        ls += ps;
        const bf16x8 p0 = packp(S, 0), p1 = packp(S, 1);
#pragma unroll
        for (int t = 0; t < 2; ++t) {
            const LAS unsigned char* vp = Vb + (h * 64 + t * 32 + l32) * NA_VSTR + (4 * hi) * 2;
            const bf16x8 v0 = mk8(*(const LAS u32x2*)vp, *(const LAS u32x2*)(vp + 16)), v1 = mk8(*(const LAS u32x2*)(vp + 32), *(const LAS u32x2*)(vp + 48));
            O[t] = MFMA_BF(v0, p0, O[t]); O[t] = MFMA_BF(v1, p1, O[t]);
        }
        if (tile + 1 < ntile) NA_STORE(buf ^ 1);
        __syncthreads();
    }
    }
#undef NA_LOAD
#undef NA_STORE
    ls += sx(ls, 32, lane);
    const float il = 1.0f / ls;
    bf16_t* op = YBR + (size_t)qrow * DM + 256 + h * 64;
#pragma unroll
    for (int t = 0; t < 2; ++t)
#pragma unroll
        for (int rg = 0; rg < 4; ++rg) { const int d0 = t * 32 + 8 * rg + 4 * hi;
            u32x2 wv; wv.x = pk2(O[t][4 * rg] * il, O[t][4 * rg + 1] * il); wv.y = pk2(O[t][4 * rg + 2] * il, O[t][4 * rg + 3] * il);
            *(u32x2*)(op + d0) = wv; }
}
constexpr int MO_META = 2048, MO_XSTR = 144, MO_XT = 128 * MO_XSTR, MO_ASTR = 528, MO_WT_OFF = MO_META + 2 * MO_XT, MO_ACT_OFF = MO_WT_OFF + 8 * 4096;
__device__ __forceinline__ void moe_wt_store(LAS unsigned char* wt, const f32x4 (&f)[4], int kq, int n4) {
#pragma unroll
    for (int c = 0; c < 4; ++c) { u32x2 d; d.x = pk2(f[0][c], f[1][c]); d.y = pk2(f[2][c], f[3][c]);
        *(LAS u32x2*)(wt + (4 * n4 + c) * 64 + (((kq >> 1) ^ (n4 & 3)) << 4) + ((kq & 1) << 3)) = d; }
}
__device__ __forceinline__ bf16x8 moe_wt_frag(const LAS unsigned char* wt, int n, int gi) { return *(const LAS bf16x8*)(wt + n * 64 + ((gi ^ ((n >> 2) & 3)) << 4)); }
constexpr int MO_ROWS = 128, MO_D = 1, MO_D2 = 2;
template <int NMT>
__device__ __forceinline__ void moe_unit(const float* __restrict__ Wg, const float* __restrict__ Wu, const float* __restrict__ Wd, const bf16_t* __restrict__ H2, bf16_t* YS,
                                         LAS unsigned char* lds, int nrows, int tid) {
    const int lane = tid & 63, w = __builtin_amdgcn_readfirstlane(tid >> 6), l32 = lane & 31, hi = lane >> 5, kq = lane >> 3, n4 = lane & 7;
    LAS int* rtok = (LAS int*)lds; LAS int* rslot = rtok + 128; LAS float* rw = (LAS float*)(rslot + 128);
    LAS unsigned char* Xl = lds + MO_META; LAS unsigned char* Al = lds + MO_ACT_OFF; LAS unsigned char* wt = lds + MO_WT_OFF + w * 4096;
    VM_WAIT();
    {
        f32x16 ag[NMT], au[NMT];
#pragma unroll
        for (int m = 0; m < NMT; ++m) { ag[m] = zero16(); au[m] = zero16(); }
        const int n0 = 32 * w;
        const unsigned woff = (unsigned)((4 * kq) * EDIM + n0 + 4 * n4);
#define GP4(k, j) (*(const f32x4*)(Wg + (size_t)((k) + (j)) * EDIM + woff))
#define UP4(k, j) (*(const f32x4*)(Wu + (size_t)((k) + (j)) * EDIM + woff))
        const int xr0 = tid >> 3, xr1 = (tid + 512) >> 3, xs = tid & 7;
        const bf16_t* xp0 = H2 + (size_t)max(rtok[xr0], 0) * DM + xs * 8; const bf16_t* xp1 = H2 + (size_t)max(rtok[xr1], 0) * DM + xs * 8;
        u32x4 xa = *(const u32x4*)xp0, xb = xa; if (NMT > 2) xb = *(const u32x4*)xp1;
        *(LAS u32x4*)(Xl + xr0 * MO_XSTR + xs * 16) = xa; if (NMT > 2) *(LAS u32x4*)(Xl + xr1 * MO_XSTR + xs * 16) = xb;
        f32x4 fg[MO_D][4], fu[MO_D][4];
#pragma unroll
        for (int h = 0; h < MO_D; ++h)
#pragma unroll
            for (int j = 0; j < 4; ++j) { fg[h][j] = GP4(h * 32, j); fu[h][j] = UP4(h * 32, j); }
        __syncthreads();
        for (int kc = 0; kc < 16; ++kc) {
            const int buf = kc & 1;
            if (kc + 1 < 16) { xa = *(const u32x4*)(xp0 + (kc + 1) * 64); if (NMT > 2) xb = *(const u32x4*)(xp1 + (kc + 1) * 64); }
#pragma unroll
            for (int hf = 0; hf < 2; ++hf) {
                moe_wt_store(wt, fg[hf % MO_D], kq, n4); moe_wt_store(wt + 2048, fu[hf % MO_D], kq, n4);
                __builtin_amdgcn_sched_barrier(0);
                const int knext = kc * 64 + (hf + MO_D) * 32;
                if (knext < DM) {
#pragma unroll
                    for (int j = 0; j < 4; ++j) { fg[hf % MO_D][j] = GP4(knext, j); fu[hf % MO_D][j] = UP4(knext, j); }
                }
                __builtin_amdgcn_sched_barrier(0);
#pragma unroll
                for (int ks = 0; ks < 2; ++ks) {
                    const bf16x8 wgf = moe_wt_frag(wt, l32, 2 * ks + hi), wuf = moe_wt_frag(wt + 2048, l32, 2 * ks + hi);
#pragma unroll
                    for (int m = 0; m < NMT; ++m) {
                        const bf16x8 xf = *(const LAS bf16x8*)(Xl + buf * MO_XT + (m * 32 + l32) * MO_XSTR + (hf * 32 + ks * 16 + 8 * hi) * 2);
                        ag[m] = MFMA_BF(wgf, xf, ag[m]); au[m] = MFMA_BF(wuf, xf, au[m]);
                    }
                }
                __builtin_amdgcn_sched_barrier(0);
            }
            if (kc + 1 < 16) { *(LAS u32x4*)(Xl + (buf ^ 1) * MO_XT + xr0 * MO_XSTR + xs * 16) = xa; if (NMT > 2) *(LAS u32x4*)(Xl + (buf ^ 1) * MO_XT + xr1 * MO_XSTR + xs * 16) = xb; }
            __syncthreads();
        }
#pragma unroll
        for (int m = 0; m < NMT; ++m) {
#pragma unroll
            for (int rg = 0; rg < 4; ++rg) {
                float a[4];
#pragma unroll
                for (int i = 0; i < 4; ++i) { const float g = ag[m][4 * rg + i]; a[i] = g * __builtin_amdgcn_rcpf(1.0f + ex2(-g * LOG2E)) * au[m][4 * rg + i]; }
                u32x2 wv; wv.x = pk2(a[0], a[1]); wv.y = pk2(a[2], a[3]);
                *(LAS u32x2*)(Al + (m * 32 + l32) * MO_ASTR + (n0 + 8 * rg + 4 * hi) * 2) = wv;
            }
        }
#undef GP4
#undef UP4
    }
    __syncthreads();
#pragma unroll 1
    for (int pass = 0; pass < 2; ++pass) {
        const int c0 = 128 * w + 64 * pass;
        VM_WAIT();
        f32x16 ac[2][NMT];
#pragma unroll
        for (int n = 0; n < 2; ++n)
#pragma unroll
            for (int m = 0; m < NMT; ++m) ac[n][m] = zero16();
        const unsigned doff = (unsigned)((4 * kq) * DM + c0 + 4 * n4);
#define DP4(k, j, n) (*(const f32x4*)(Wd + (size_t)((k) + (j)) * DM + (n) * 32 + doff))
        f32x4 f0[MO_D2][4], f1[MO_D2][4];
#pragma unroll
        for (int h = 0; h < MO_D2; ++h)
#pragma unroll
            for (int j = 0; j < 4; ++j) { f0[h][j] = DP4(h * 32, j, 0); f1[h][j] = DP4(h * 32, j, 1); }
#pragma unroll
        for (int kh = 0; kh < 8; ++kh) {
            moe_wt_store(wt, f0[kh % MO_D2], kq, n4); moe_wt_store(wt + 2048, f1[kh % MO_D2], kq, n4);
            __builtin_amdgcn_sched_barrier(0);
            if (kh + MO_D2 < 8) {
#pragma unroll
                for (int j = 0; j < 4; ++j) { f0[kh % MO_D2][j] = DP4((kh + MO_D2) * 32, j, 0); f1[kh % MO_D2][j] = DP4((kh + MO_D2) * 32, j, 1); }
            }
            __builtin_amdgcn_sched_barrier(0);
#pragma unroll
            for (int ks = 0; ks < 2; ++ks) {
                const bf16x8 w0 = moe_wt_frag(wt, l32, 2 * ks + hi), w1 = moe_wt_frag(wt + 2048, l32, 2 * ks + hi);
#pragma unroll
                for (int m = 0; m < NMT; ++m) {
                    const bf16x8 af = *(const LAS bf16x8*)(Al + (m * 32 + l32) * MO_ASTR + (kh * 32 + ks * 16 + 8 * hi) * 2);
                    ac[0][m] = MFMA_BF(w0, af, ac[0][m]); ac[1][m] = MFMA_BF(w1, af, ac[1][m]);
                }
            }
            __builtin_amdgcn_sched_barrier(0);
        }
#undef DP4
        int ln2 = lane; asm volatile("" : "+v"(ln2));
        const int l32e = ln2 & 31, hie = ln2 >> 5;
#pragma unroll
        for (int m = 0; m < NMT; ++m) {
            const float wt_ = rw[m * 32 + l32e];
#pragma unroll
            for (int n = 0; n < 2; ++n)
#pragma unroll
                for (int rg = 0; rg < 4; ++rg) { u32x2 wv; wv.x = pk2(ac[n][m][4 * rg] * wt_, ac[n][m][4 * rg + 1] * wt_); wv.y = pk2(ac[n][m][4 * rg + 2] * wt_, ac[n][m][4 * rg + 3] * wt_);
                    *(LAS u32x2*)(wt + l32e * 128 + (((n * 4 + rg) ^ (l32e & 7)) << 4) + hie * 8) = wv; }
#pragma unroll
            for (int jj = 0; jj < 4; ++jj) { const int rl = (ln2 >> 3) + 8 * jj, sg_ = ln2 & 7, grow = m * 32 + rl;
                const u32x4 v = *(const LAS u32x4*)(wt + rl * 128 + ((sg_ ^ (rl & 7)) << 4));
                if (grow < nrows) *(u32x4*)(YS + (size_t)rslot[grow] * DM + c0 + sg_ * 8) = v; }
        }
    }
    __syncthreads();
}

__device__ __forceinline__ void route_token(const float* logits, const float* rbias, int tok, unsigned* ecnt, int* lists, float* topw, int lane) {
    const f32x4 lg = *(const f32x4*)(logits + (size_t)tok * NEXP + 4 * lane);
    const f32x4 bs = *(const f32x4*)(rbias + 4 * lane);
    float sc[4], sel[4];
#pragma unroll
    for (int i = 0; i < 4; ++i) { sc[i] = 1.0f / (1.0f + __expf(-lg[i])); sel[i] = sc[i] + bs[i]; }
    float t1 = fmaxf(fmaxf(sel[0], sel[1]), fmaxf(sel[2], sel[3]));
    float t2; { const float a = fmaxf(sel[0], sel[1]), bq = fminf(sel[0], sel[1]), c = fmaxf(sel[2], sel[3]), d = fminf(sel[2], sel[3]); t2 = fmaxf(fminf(a, c), fmaxf(bq, d)); }
#pragma unroll
    for (int o = 1; o < 8; o <<= 1) { const float o1 = sx(t1, o, lane), o2 = sx(t2, o, lane); const float n1 = fmaxf(t1, o1); t2 = fmaxf(fminf(t1, o1), fmaxf(t2, o2)); t1 = n1; }
    const float gs = t1 + t2; const int grp = lane >> 3;
    int rank = 0;
#pragma unroll
    for (int j = 0; j < 8; ++j) { const float oj = shf(gs, 8 * j); rank += (oj > gs || (oj == gs && j < grp)) ? 1 : 0; }
    const bool gsel = rank < 4;
    float cand[4];
#pragma unroll
    for (int i = 0; i < 4; ++i) cand[i] = gsel ? sel[i] : -__builtin_inff();
    float wk[8]; int ek[8]; float wsum = 0.f;
#pragma unroll
    for (int k = 0; k < 8; ++k) {
        float bv = cand[0]; int bi = 0;
#pragma unroll
        for (int i = 1; i < 4; ++i) if (cand[i] > bv) { bv = cand[i]; bi = i; }
        int be = 4 * lane + bi;
#pragma unroll
        for (int o = 1; o < 64; o <<= 1) { const float ov = sx(bv, o, lane); const int oe = sxi(be, o, lane); if (ov > bv || (ov == bv && oe < be)) { bv = ov; be = oe; } }
        float s = 0.f;
#pragma unroll
        for (int i = 0; i < 4; ++i) if ((be & 3) == i) s = sc[i];
        s = shf(s, be >> 2);
        if ((be >> 2) == lane) {
#pragma unroll
            for (int i = 0; i < 4; ++i) if ((be & 3) == i) cand[i] = -__builtin_inff();
        }
        wk[k] = s; ek[k] = be; wsum += s;
    }
    const float inv = 2.5f / wsum;
    if (lane < 8) {
        float wv = 0.f; int e = 0;
#pragma unroll
        for (int k = 0; k < 8; ++k) if (lane == k) { wv = wk[k]; e = ek[k]; }
        const unsigned pos = atomicAdd(&ecnt[e], 1u);
        lists[(size_t)e * NTOK + pos] = tok * 8 + lane;
        topw[tok * 8 + lane] = wv * inv;
    }
}
constexpr int NTHREADS = 512, NWAVES = 8;
constexpr int LDS_BYTES = 147456;
constexpr int LDS_MISC = 147456 - 256;
constexpr int N_PHASES = 24;
struct Args { const float* in[25]; float* out; unsigned char* ws; int ph_lo, ph_hi; };

__global__ void __launch_bounds__(NTHREADS, 2) fwd_kernel(Args args) {
    extern __shared__ __attribute__((aligned(16))) unsigned char lds_raw[];
    LAS unsigned char* lds = (LAS unsigned char*)lds_raw;
    volatile LAS unsigned* MISC = (volatile LAS unsigned*)(lds + LDS_MISC);
    const int wave0 = __builtin_amdgcn_readfirstlane((int)threadIdx.x >> 6);
    const int G = gridDim.x, bx0 = blockIdx.x;
    const int NGW = G * NWAVES, GT = G * NTHREADS;
#define FRESH_TID(t) do { asm volatile("v_mbcnt_lo_u32_b32 %0, -1, 0\n\tv_mbcnt_hi_u32_b32 %0, -1, %0" : "=v"(t)); t += wave0 * 64; } while (0)
#define PHASE_BEGIN() LAUNDER(); int tid; FRESH_TID(tid); int bx = bx0; asm volatile("" : "+s"(bx)); \
    const int lane = tid & 63, wave = __builtin_amdgcn_readfirstlane(tid >> 6); const int gw = bx * NWAVES + wave, gtid = bx * NTHREADS + tid; \
    const int vcu = (G % 8 == 0) ? (bx % 8) * (G / 8) + bx / 8 : bx; (void)lane; (void)gw; (void)gtid; (void)vcu;
    typedef const __attribute__((address_space(1))) float* gfp_t;
    typedef __attribute__((address_space(1))) unsigned char* gws_t;
    typedef gfp_t __attribute__((address_space(4))) const* kargp_t;
    kargp_t kap = (kargp_t)__builtin_amdgcn_kernarg_segment_ptr();
    gws_t ws = (gws_t)kap[26];
    unsigned* ctl = (unsigned*)(ws + WS_CTL);
#define LAUNDER() asm volatile("" : "+s"(kap), "+s"(ws))
#define INP(k) ((const float*)kap[k])
#define in_x INP(0)
#define in_c INP(1)
#define in_ctx INP(2)
#define in_cctx INP(3)
#define ada_w INP(4)
#define ada_b INP(5)
#define norm1_g INP(6)
#define w_in INP(7)
#define conv_w INP(8)
#define na_rel_bias INP(9)
#define diff_lambda INP(10)
#define diff_subln_g INP(11)
#define w_branch_gate INP(12)
#define w_branch INP(13)
#define w_out INP(14)
#define norm2_g INP(15)
#define router_w INP(16)
#define router_bias INP(17)
#define e_wg INP(18)
#define e_wu INP(19)
#define e_wd INP(20)
#define s_wg INP(21)
#define s_wu INP(22)
#define s_wd INP(23)
#define final_g INP(24)
#define OUTP ((float*)kap[25])
#define MODS ((float*)(ws + WS_MODS))
#define LAM ((float*)(ws + WS_MODS + 512 * 1024))
#define Win_t ((bf16_t*)(ws + WS_WIN))
#define Wg_t ((bf16_t*)(ws + WS_WG))
#define Wb_t ((bf16_t*)(ws + WS_WB))
#define Wo_t ((bf16_t*)(ws + WS_WO))
#define Wr_t ((bf16_t*)(ws + WS_WR))
#define Wsgu_t ((bf16_t*)(ws + WS_WSGU))
#define Wsd_t ((bf16_t*)(ws + WS_WSD))
#define X ((float*)(ws + WS_X))
#define H ((bf16_t*)(ws + WS_H))
#define P ((bf16_t*)(ws + WS_P))
#define VTD ((bf16_t*)(ws + WS_VTD))
#define VTB ((bf16_t*)(ws + WS_VTB))
#define Z2R ((float*)(ws + WS_Z2R))
#define Z2I ((float*)(ws + WS_Z2I))
#define YBR ((bf16_t*)(ws + WS_YBR))
#define PB ((bf16_t*)(ws + WS_PB))
#define MACC ((bf16_t*)(ws + WS_MACC))
#define MRG ((bf16_t*)(ws + WS_MRG))
#define LOG ((float*)(ws + WS_LOG))
#define TOPW ((float*)(ws + WS_TOPW))
#define LIST ((int*)(ws + WS_LIST))
#define YS ((bf16_t*)(ws + WS_YS))
#define TCB ((float*)(ws + WS_TC))
    if (threadIdx.x < 64) MISC[threadIdx.x] = 0u;
    __syncthreads();
    const int lo = args.ph_lo, hi_ph = args.ph_hi;
    const bool multi = (hi_ph - lo) > 1;
    XcdBarrier bar; bar.bar = ctl + CW_BAR; bar.x = 0; bar.st = nullptr;
    if (multi) bar = xcd_barrier_post(ctl + CW_BAR, MISC + 8);
    if (multi && threadIdx.x == 0) MISC[16] = __hip_atomic_fetch_add(ctl + CW_RANK + 16 * bar.x, 1u, __ATOMIC_RELAXED, __HIP_MEMORY_SCOPE_AGENT);
    __syncthreads();
#ifndef PHMASK
#define PHMASK 0xFFFF
#endif
#define KIND(k) (((PHMASK) >> (k)) & 1)
#ifndef REPKIND
#define REPKIND -1
#endif
#ifndef REPN
#define REPN 1
#endif
#define NREP(k) (((k) == REPKIND) ? (1 + REPN) : 1)
#define IN(k) (lo <= (k) && (k) < hi_ph)
#define SEAM(k) do { if (IN(k) && IN((k) + 1)) xcd_barrier(bar); } while (0)

    for (int rep_ = 0; rep_ < NREP(0); ++rep_) if (KIND(0) && IN(0)) { if (rep_) { VM_WAIT(); __syncthreads(); } PHASE_BEGIN();
        LAS float* scr = (LAS float*)(lds + wave * 16384);
        for (int it = gw; it < 2 * 4864; it += NGW) {
            const int L = it / 4864; int r = it % 4864;
            if (r < 1280) { transpose_item(w_in + (size_t)L * DM * IN_DIM, DM, IN_DIM, Win_t + (size_t)L * IN_DIM * DM, scr, r, lane); continue; } r -= 1280;
            if (r < 2048) { const int i = r >> 9; transpose_item(w_branch_gate + (size_t)(L * 4 + i) * DM * DM, DM, DM, Wg_t + (size_t)L * 4096 * DM, scr, r & 511, lane, 3 + i); continue; } r -= 2048;
            if (r < 512) { const int i = r >> 7; transpose_item(w_branch + (size_t)(L * 4 + i) * 256 * DM, 256, DM, Wb_t + (size_t)(L * 4 + i) * DM * 256, scr, r & 127, lane); continue; } r -= 512;
            if (r < 512) { transpose_item(w_out + (size_t)L * DM * DM, DM, DM, Wo_t + (size_t)L * DM * DM, scr, r, lane); continue; } r -= 512;
            if (r < 128) { transpose_item(router_w + (size_t)L * DM * NEXP, DM, NEXP, Wr_t + (size_t)L * NEXP * DM, scr, r, lane); continue; } r -= 128;
            if (r < 128) { transpose_item(s_wg + (size_t)L * DM * EDIM, DM, EDIM, Wsgu_t + (size_t)L * 512 * DM, scr, r, lane, 1); continue; } r -= 128;
            if (r < 128) { transpose_item(s_wu + (size_t)L * DM * EDIM, DM, EDIM, Wsgu_t + (size_t)L * 512 * DM, scr, r, lane, 2); continue; } r -= 128;
            transpose_item(s_wd + (size_t)L * EDIM * DM, EDIM, DM, Wsd_t + (size_t)L * DM * EDIM, scr, r, lane);
        }
        __syncthreads();
        {
            LAS float* sv = (LAS float*)lds;
            LAS float* part = sv + 3 * DM;
            for (int i = tid; i < 3 * DM; i += NTHREADS) { const int v = i >> 10, k = i & 1023; const float c = (v < 2) ? in_c[v * DM + k] : in_cctx[k]; sv[i] = c / (1.0f + __expf(-c)); }
            __syncthreads();
            for (int item = bx; item < 2 * 96; item += G) {
                const int L = item / 96, col = (item % 96) * 64 + lane;
                const float* wp = ada_w + (size_t)L * DM * 6 * DM + col;
                float a0 = 0.f, a1 = 0.f, a2 = 0.f;
#pragma unroll 32
                for (int k = wave * 128; k < wave * 128 + 128; ++k) { const float wv = wp[(size_t)k * 6 * DM]; a0 += sv[k] * wv; a1 += sv[DM + k] * wv; a2 += sv[2 * DM + k] * wv; }
                part[(wave * 3 + 0) * 64 + lane] = a0; part[(wave * 3 + 1) * 64 + lane] = a1; part[(wave * 3 + 2) * 64 + lane] = a2;
                __syncthreads();
                if (tid < 192) { const int v = tid >> 6, l = tid & 63; float s = ada_b[(size_t)L * 6 * DM + (item % 96) * 64 + l];
#pragma unroll
                    for (int q = 0; q < 8; ++q) s += part[(q * 3 + v) * 64 + l];
                    MODS[((size_t)L * 3 + v) * 6 * DM + (item % 96) * 64 + l] = s; }
                __syncthreads();
            }
        }
        if (bx == 0 && tid < 2) {
            const float* lp = diff_lambda + tid * 128; float s0 = 0.f, s1 = 0.f;
            for (int i = 0; i < 32; ++i) { s0 += lp[i] * lp[32 + i]; s1 += lp[64 + i] * lp[96 + i]; }
            const float li = tid ? 0.35550906759f : 0.2f;
            LAM[tid] = __expf(s0) - __expf(s1) + li;
        }
    }
    SEAM(0);

    for (int L = 0; L < 2; ++L) {
        const int pb = 1 + 10 * L - (L ? 1 : 0);
        const int P_NORM1 = 1, P_INPROJ = L ? 13 : 2, P_MIX1 = P_INPROJ + 1, P_MIX2 = P_INPROJ + 2, P_MERGE = P_INPROJ + 3, P_GATE = P_INPROJ + 4, P_WOUT = P_INPROJ + 5,
                  P_NORM2 = P_WOUT + 1, P_ROUTE = P_WOUT + 2, P_TOPK = P_WOUT + 3, P_MOE = P_WOUT + 4, P_COMB = P_WOUT + 5;
        (void)pb;
#define mods (MODS + (size_t)L * 3 * 6 * DM)
        const int ntok = L ? NLAT : NTOK;
        const float lam_init = L ? 0.35550906759f : 0.2f;
#define kmax (ctl + CW_KMAX + 32 * L)
#define ecnt (ctl + CW_ECNT + 256 * L)

        if (KIND(1) && L == 0 && IN(P_NORM1)) { PHASE_BEGIN();
            for (int row = gw; row < NTOK; row += NGW) {
                const float* xr = row < NLAT ? in_x + (size_t)row * DM : in_ctx + (size_t)(row - NLAT) * DM;
                const int vec = row < SEQ ? 0 : (row < NLAT ? 1 : 2);
                f32x4 v[4];
#pragma unroll
                for (int j = 0; j < 4; ++j) v[j] = *(const f32x4*)(xr + 4 * lane + 256 * j);
                norm_mod_row(v, norm1_g, mods + (vec * 6 + 0) * DM, mods + (vec * 6 + 1) * DM, H + (size_t)row * DM, lane);
            }
        }
        if (L == 0) SEAM(P_NORM1);

        for (int rep_ = 0; rep_ < NREP(2); ++rep_) if (KIND(2) && IN(P_INPROJ)) { if (rep_) { VM_WAIT(); __syncthreads(); } PHASE_BEGIN();
            pg8::Gemm g{H, Win_t + (size_t)L * IN_DIM * DM, DM, DM, DM}; pg8::StaticOrder S; S.init(NTOK, IN_DIM, G, bx);
            pg8::EpiInproj E{P};
            pg8::gemm_phase(lds, g, S, E, tid);
        }
        SEAM(P_INPROJ);

        for (int rep_ = 0; rep_ < NREP(3); ++rep_) if (KIND(3) && IN(P_MIX1)) { if (rep_) { VM_WAIT(); __syncthreads(); } PHASE_BEGIN();
            f1b_tables(lds, tid);
            for (int u = bx; u < 512; u += G) { const int b = u >> 8, c = (u >> 2) & 63, g = u & 3; f1b_unit(P, Z2R, Z2I, lds, b, c, g, tid); }
            FRESH_TID(tid);
            for (int u = bx; u < 2 * 132; u += G) kvprep_item(P, VTD, VTB, kmax, lds, u / 132, u % 132, tid);
            FRESH_TID(tid);
            if (L == 0) for (int u = G - 1 - bx; u < 64; u += G) fctxb_unit(P, YBR, lds, u >> 5, (u >> 3) & 3, u & 7, tid);
            conv_phase(P, conv_w + (size_t)L * 3 * 256, YBR, ntok, gtid, GT);
        }
        SEAM(P_MIX1);

        for (int rep_ = 0; rep_ < NREP(4); ++rep_) if (KIND(4) && IN(P_MIX2)) { if (rep_) { VM_WAIT(); __syncthreads(); } PHASE_BEGIN();
            const float lam = LAM[L];
            for (int u = bx; u < 256; u += G) diff_unit<true>(P, VTD, YBR, diff_subln_g + L * 64, lam, lam_init, kmax, lds, u >> 7, (u >> 5) & 3, (u >> 7) * SEQ + (u & 31) * 256, 0, 132, tid);
            FRESH_TID(tid);
            for (int u = bx; u < 256; u += G) { const int b = u >> 7, r = u & 127; na_unit(P, VTB, YBR, na_rel_bias + (size_t)L * 1860, kmax, lds, b, r, b * SEQ + r * 64, 16, tid); }
            FRESH_TID(tid);
            for (int u = bx; u < 256; u += G) f2b_unit(Z2R, Z2I, YBR, lds, u >> 7, u & 127, tid);
            if (L == 0) {
                FRESH_TID(tid);
                for (int u = G - 1 - bx; u < 8; u += G) diff_unit<false>(P, VTD, YBR, diff_subln_g, lam, lam_init, kmax, lds, u >> 2, u & 3, NLAT + (u >> 2) * LCTX, 128, 132, tid);
                FRESH_TID(tid);
                for (int u = G - 9 - bx; u >= 0 && u < 8; u += G) { const int b = u >> 2, cq = u & 3; na_unit(P, VTB, YBR, na_rel_bias, kmax, lds, b, 0, NLAT + b * LCTX + cq * 64, 0, tid); }
            }
        }
        SEAM(P_MIX2);

        if (KIND(5) && IN(P_MERGE)) { PHASE_BEGIN();
            pg8::Gemm g{YBR, Wb_t + (size_t)L * 4 * DM * 256, DM, 256, 256}; pg8::StaticOrder S; S.init(ntok, 4096, G, bx); S.aostep = 256; pg8::EpiBf16 E{PB, 4096};
            pg8::gemm_phase(lds, g, S, E, tid);
        }
        SEAM(P_MERGE);

        for (int rep_ = 0; rep_ < NREP(5); ++rep_) if (KIND(5) && IN(P_GATE)) { if (rep_) { VM_WAIT(); __syncthreads(); } PHASE_BEGIN();
            const int xj = G - 1 - bx;
            pg8::ExtraOrder S; S.base.init(NLAT, 4096, G, bx); S.xpm = (L == 0 && xj < 32) ? 64 + (xj >> 4) : -1; S.xpn = xj & 15;
            pg8::Gemm g{H, Wg_t + (size_t)L * 4096 * DM, DM, DM, DM}; pg8::EpiGate4 E{PB, MRG};
            pg8::gemm_phase(lds, g, S, E, tid);
        }
        SEAM(P_GATE);

        if (KIND(6) && IN(P_WOUT)) { PHASE_BEGIN();
            pg8::Gemm g{MRG, Wo_t + (size_t)L * DM * DM, DM, DM, DM}; pg8::StaticOrder S; S.init(ntok, DM, G, bx);
            pg8::EpiResid E{L ? X : in_x, L ? X + (size_t)NLAT * DM : in_ctx, X, mods};
            pg8::gemm_phase(lds, g, S, E, tid);
        }
        SEAM(P_WOUT);

        for (int rep_ = 0; rep_ < NREP(7); ++rep_) if (KIND(7) && IN(P_NORM2)) { if (rep_) { VM_WAIT(); __syncthreads(); } PHASE_BEGIN();
            for (int row = gw; row < ntok; row += NGW) {
                const int vec = row < SEQ ? 0 : (row < NLAT ? 1 : 2);
                f32x4 v[4];
#pragma unroll
                for (int j = 0; j < 4; ++j) v[j] = *(const f32x4*)(X + (size_t)row * DM + 4 * lane + 256 * j);
                norm_mod_row(v, norm2_g + L * DM, mods + (vec * 6 + 3) * DM, mods + (vec * 6 + 4) * DM, H + (size_t)row * DM, lane);
            }
        }
        SEAM(P_NORM2);

        if (KIND(8) && IN(P_ROUTE)) { PHASE_BEGIN();
            const int nM = ntok / 256;
            { pg8::Gemm g{H, Wr_t + (size_t)L * NEXP * DM, DM, DM, DM}; pg8::PanelOrder S{nM, G, bx}; pg8::EpiF32 E{LOG, NEXP};
              pg8::gemm_phase(lds, g, S, E, tid); }
            __syncthreads();
            FRESH_TID(tid);
            { pg8::Gemm g{H, Wsgu_t + (size_t)L * 512 * DM, DM, DM, DM}; pg8::OffsetOrder S{nM, 2, G, bx, nM % G}; pg8::EpiSwiGLU E{MRG};
              pg8::gemm_phase(lds, g, S, E, tid); }
        }
        SEAM(P_ROUTE);

        if (KIND(8) && IN(P_TOPK)) { PHASE_BEGIN();
            for (int t = gw; t < ntok; t += NGW) route_token(LOG, router_bias + L * NEXP, t, ecnt, LIST, TOPW, lane);
            __syncthreads();
            FRESH_TID(tid);
            { pg8::Gemm g{MRG, Wsd_t + (size_t)L * DM * EDIM, EDIM, EDIM, EDIM}; pg8::StaticOrder S; S.init(ntok, DM, G, bx); pg8::EpiSlot8 E{YS};
              pg8::gemm_phase(lds, g, S, E, tid); }
        }
        SEAM(P_TOPK);

        for (int rep_ = 0; rep_ < NREP(9); ++rep_) if (KIND(9) && IN(P_MOE)) { if (rep_) { VM_WAIT(); __syncthreads(); } PHASE_BEGIN();
            LAS int* pref = (LAS int*)(lds + LDS_MISC - 2048);
            __syncthreads();
            if (tid < 256) pref[1 + tid] = (int)((__hip_atomic_load(&ecnt[tid], __ATOMIC_RELAXED, __HIP_MEMORY_SCOPE_AGENT) + (unsigned)(MO_ROWS - 1)) / (unsigned)MO_ROWS);
            if (tid == 0) pref[0] = 0;
            __syncthreads();
            if (tid == 0) { int s = 0; for (int e = 0; e < 256; ++e) { s += pref[1 + e]; pref[1 + e] = s; } }
            __syncthreads();
            const int total = pref[256];
            int xcu = vcu;
            if (multi) {
                int base = 0, tot = 0;
                for (int j = 0; j < 16; ++j) { const int cj = (int)xb_ld(ctl + CW_BAR + XB_XCNT(j)); base += (j < (int)bar.x) ? cj : 0; tot += cj; }
                if (tot == G) xcu = base + (int)MISC[16];
            }
            xcu = __builtin_amdgcn_readfirstlane(xcu);
            for (int uid = xcu; uid < total; uid += G) {
                int e = 0; { int a = 0, bq = 256; while (bq - a > 1) { const int m = (a + bq) >> 1; if (pref[m] <= uid) a = m; else bq = m; } e = a; }
                const int t = uid - pref[e], cnt = (int)__hip_atomic_load(&ecnt[e], __ATOMIC_RELAXED, __HIP_MEMORY_SCOPE_AGENT), r0 = t * MO_ROWS, nrows = min(MO_ROWS, cnt - r0);
                __syncthreads();
                if (tid < 128) { LAS int* rtok = (LAS int*)lds; int ent = (tid < nrows) ? LIST[(size_t)e * NTOK + r0 + tid] : -8;
                    rtok[tid] = ent >> 3; rtok[128 + tid] = (ent >> 3) * NSLOT + (ent & 7); ((LAS float*)lds)[256 + tid] = (tid < nrows) ? TOPW[ent] : 0.f; }
                __syncthreads();
                const size_t eo = (size_t)(L * NEXP + e);
                const int nm = __builtin_amdgcn_readfirstlane((nrows + 31) >> 5);
                if (nm == 4)      { int t4; FRESH_TID(t4); moe_unit<4>(e_wg + eo * DM * EDIM, e_wu + eo * DM * EDIM, e_wd + eo * EDIM * DM, H, YS, lds, nrows, t4); }
                else if (nm == 3) { int t3; FRESH_TID(t3); moe_unit<3>(e_wg + eo * DM * EDIM, e_wu + eo * DM * EDIM, e_wd + eo * EDIM * DM, H, YS, lds, nrows, t3); }
                else if (nm == 2) { int t2; FRESH_TID(t2); moe_unit<2>(e_wg + eo * DM * EDIM, e_wu + eo * DM * EDIM, e_wd + eo * EDIM * DM, H, YS, lds, nrows, t2); }
                else              { int t1; FRESH_TID(t1); moe_unit<1>(e_wg + eo * DM * EDIM, e_wu + eo * DM * EDIM, e_wd + eo * EDIM * DM, H, YS, lds, nrows, t1); }
            }
        }
        SEAM(P_MOE);

        if (KIND(10) && IN(P_COMB)) { PHASE_BEGIN();
            const float* mods1 = MODS + (size_t)3 * 6 * DM;
            for (int row = gw; row < ntok; row += NGW) {
                const int vec = row < SEQ ? 0 : (row < NLAT ? 1 : 2);
                float v[2][8];
#pragma unroll
                for (int j = 0; j < 2; ++j) {
                    const int c = 8 * lane + 512 * j;
                    float a[8] = {0.f, 0.f, 0.f, 0.f, 0.f, 0.f, 0.f, 0.f};
#pragma unroll
                    for (int k = 0; k < NSLOT; ++k) { const u32x4 y = __builtin_nontemporal_load((const u32x4*)(YS + ((size_t)row * NSLOT + k) * DM + c));
#pragma unroll
                        for (int i = 0; i < 4; ++i) { a[2 * i] += bflo(y[i]); a[2 * i + 1] += bfhi(y[i]); } }
                    const f32x4 g0 = *(const f32x4*)(mods + (vec * 6 + 5) * DM + c), g1 = *(const f32x4*)(mods + (vec * 6 + 5) * DM + c + 4);
                    const f32x4 x0 = *(const f32x4*)(X + (size_t)row * DM + c), x1 = *(const f32x4*)(X + (size_t)row * DM + c + 4);
#pragma unroll
                    for (int i = 0; i < 4; ++i) { v[j][i] = x0[i] + g0[i] * a[i]; v[j][4 + i] = x1[i] + g1[i] * a[4 + i]; }
                }
                float ss = 0.f;
#pragma unroll
                for (int j = 0; j < 2; ++j)
#pragma unroll
                    for (int i = 0; i < 8; ++i) ss += v[j][i] * v[j][i];
                const float rstd = __builtin_amdgcn_rsqf(wave_sum(ss, lane) * (1.f / DM) + EPS);
#pragma unroll
                for (int j = 0; j < 2; ++j) {
                    const int c = 8 * lane + 512 * j;
                    if (L == 0) {
                        *(f32x4*)(X + (size_t)row * DM + c) = (f32x4){v[j][0], v[j][1], v[j][2], v[j][3]}; *(f32x4*)(X + (size_t)row * DM + c + 4) = (f32x4){v[j][4], v[j][5], v[j][6], v[j][7]};
                        const float* gp = norm1_g + DM + c; const float* shp = mods1 + (vec * 6 + 0) * DM + c; const float* scp = mods1 + (vec * 6 + 1) * DM + c;
                        float y[8];
#pragma unroll
                        for (int i = 0; i < 8; ++i) y[i] = v[j][i] * rstd * gp[i] * (scp[i] + 1.0f) + shp[i];
                        u32x4 w; w.x = pk2(y[0], y[1]); w.y = pk2(y[2], y[3]); w.z = pk2(y[4], y[5]); w.w = pk2(y[6], y[7]);
                        *(u32x4*)(H + (size_t)row * DM + c) = w;
                    } else {
                        const float* gp = final_g + c;
                        f32x4 o0, o1;
#pragma unroll
                        for (int i = 0; i < 4; ++i) { o0[i] = v[j][i] * rstd * gp[i]; o1[i] = v[j][4 + i] * rstd * gp[4 + i]; }
                        *(f32x4*)(OUTP + (size_t)row * DM + c) = o0; *(f32x4*)(OUTP + (size_t)row * DM + c + 4) = o1;
                    }
                }
            }
        }
        if (L == 0) SEAM(P_COMB);
    }
#undef IN
#undef SEAM
#undef KIND
}

extern "C" void kernel_launch(void* const* d_in, const int* in_sizes, int n_in, void* d_out, int out_size, void* d_ws, size_t ws_size, hipStream_t stream) {
    static int grid = 0;
    if (grid == 0) {
        if (n_in != 25 || in_sizes[0] != NLAT * DM || out_size != NLAT * DM || ws_size < WS_END) { fprintf(stderr, "kernel_launch: unexpected shapes (n_in %d, ws %zu)\n", n_in, ws_size); grid = -1; return; }
        int dev = 0, cus = 0, per_cu = 0;
        if (hipGetDevice(&dev) != hipSuccess || hipDeviceGetAttribute(&cus, hipDeviceAttributeMultiprocessorCount, dev) != hipSuccess) { grid = -1; return; }
        if (hipFuncSetAttribute((const void*)fwd_kernel, hipFuncAttributeMaxDynamicSharedMemorySize, LDS_BYTES) != hipSuccess) { fprintf(stderr, "kernel_launch: hipFuncSetAttribute failed\n"); grid = -1; return; }
        if (hipOccupancyMaxActiveBlocksPerMultiprocessor(&per_cu, (const void*)fwd_kernel, NTHREADS, LDS_BYTES) != hipSuccess || per_cu < 1) fprintf(stderr, "kernel_launch: occupancy query says %d\n", per_cu);
        (void)hipGetLastError();
        grid = cus;
    }
    if (grid < 0) return;
    (void)hipMemsetAsync((char*)d_ws + WS_CTL, 0, CTL_ZERO_BYTES, stream);
    Args a{};
    for (int i = 0; i < 25; ++i) a.in[i] = (const float*)d_in[i];
    a.out = (float*)d_out; a.ws = (unsigned char*)d_ws;
#ifndef MK_LAUNCHES
#define MK_LAUNCHES 1
#endif
    if (MK_LAUNCHES == 1) { a.ph_lo = 0; a.ph_hi = N_PHASES; hipLaunchKernelGGL(fwd_kernel, dim3(grid), dim3(NTHREADS), LDS_BYTES, stream, a); }
    else for (int p = 0; p < N_PHASES; ++p) { a.ph_lo = p; a.ph_hi = p + 1; hipLaunchKernelGGL(fwd_kernel, dim3(grid), dim3(NTHREADS), LDS_BYTES, stream, a); }
}
```

```cpp
#include <hip/hip_runtime.h>
#include <cstdio>
#include <cstdint>

#define GAS __attribute__((address_space(1)))
#define LAS __attribute__((address_space(3)))
typedef unsigned short bf16_t;
typedef short bf16x8 __attribute__((ext_vector_type(8)));
typedef float f32x4 __attribute__((ext_vector_type(4)));
typedef float f32x2 __attribute__((ext_vector_type(2)));
typedef float f32x16 __attribute__((ext_vector_type(16)));
typedef unsigned u32x4 __attribute__((ext_vector_type(4)));
typedef unsigned u32x2 __attribute__((ext_vector_type(2)));

constexpr int DM = 1024, NBATCH = 2, SEQ = 8192, NLAT = NBATCH * SEQ, LCTX = 256, NCTX = NBATCH * LCTX, NTOK = NLAT + NCTX;
constexpr int IN_DIM = 2560, NEXP = 256, TOPK = 8, EDIM = 256, NKEY = SEQ + LCTX, NSLOT = 9;
constexpr float EPS = 1e-6f, LOG2E = 1.4426950408889634f;
constexpr float QD_SCALE = 0.17677669529663687f * LOG2E;
constexpr float QB_SCALE = 0.125f * LOG2E;

constexpr size_t MiB = 1u << 20;
constexpr size_t WS_CTL = 0, CTL_ZERO_BYTES = 1 * MiB;
constexpr size_t WS_MODS = 1 * MiB;
constexpr size_t WS_WIN = 2 * MiB, WS_WG = 12 * MiB, WS_WB = 28 * MiB, WS_WO = 32 * MiB, WS_WR = 36 * MiB, WS_WSGU = 37 * MiB  , WS_WSD = 39 * MiB  ;
constexpr size_t WS_X = 40 * MiB, WS_H = 106 * MiB, WS_P = 140 * MiB, WS_VTD = 224 * MiB, WS_VTB = 233 * MiB;
constexpr size_t WS_Z2R = 242 * MiB, WS_Z2I = 258 * MiB, WS_YBR = 274 * MiB, WS_PB = 308 * MiB, WS_MACC = 440 * MiB, WS_MRG = 506 * MiB;
constexpr size_t WS_LOG = 540 * MiB, WS_TOPW = 558 * MiB, WS_LIST = 560 * MiB, WS_YS = 580 * MiB, WS_TC = 880 * MiB  , WS_END = 888 * MiB;
constexpr int CW_TMO = 0, CW_BAR = 4096, CW_KMAX = 8192  , CW_ECNT = 12288  , CW_GS = 16384, CW_PROG = 49152  , CW_RANK = 32768  , CW_MOEQ = 65792  ;

typedef __bf16 bf16x2_t __attribute__((ext_vector_type(2)));
__device__ __forceinline__ unsigned pk2a(float lo, float hi) { unsigned r; asm("v_cvt_pk_bf16_f32 %0, %1, %2" : "=v"(r) : "v"(lo), "v"(hi)); return r; }
__device__ __forceinline__ unsigned pk2(float lo, float hi) { const f32x2 v = {lo, hi}; const bf16x2_t b = __builtin_convertvector(v, bf16x2_t); return __builtin_bit_cast(unsigned, b); }
__device__ __forceinline__ float bflo(unsigned w) { return __uint_as_float(w << 16); }
__device__ __forceinline__ float bfhi(unsigned w) { return __uint_as_float(w & 0xffff0000u); }
__device__ __forceinline__ float bf1(bf16_t b) { return __uint_as_float(((unsigned)b) << 16); }
__device__ __forceinline__ float ex2(float x) { return __builtin_amdgcn_exp2f(x); }
__device__ __forceinline__ int crow(int r, int hi) { return (r & 3) + 8 * (r >> 2) + 4 * hi; }
__device__ __forceinline__ float sx(float v, int o, int lane) { return __int_as_float(__builtin_amdgcn_ds_bpermute((lane ^ o) << 2, __float_as_int(v))); }
__device__ __forceinline__ int sxi(int v, int o, int lane) { return __builtin_amdgcn_ds_bpermute((lane ^ o) << 2, v); }
__device__ __forceinline__ float shf(float v, int src) { return __int_as_float(__builtin_amdgcn_ds_bpermute(src << 2, __float_as_int(v))); }
__device__ __forceinline__ float wave_sum(float v, int lane) {
#pragma unroll
    for (int o = 1; o < 64; o <<= 1) v += sx(v, o, lane);
    return v;
}
#define LDS_WAIT() asm volatile("s_waitcnt lgkmcnt(0)" ::: "memory")
#define VM_WAIT() asm volatile("s_waitcnt vmcnt(0)" ::: "memory")

#define XB_TMO      128
#define XB_XCNT(j)  (256  + 64 * (j))
#define XB_XSUB(j)  (1280 + 64 * (j))
#define XB_XGEN(j)  (2304 + 64 * (j))
#define XB_TOP      3328
#define XB_TOPGEN   3392
#define XCD_BAR_WORDS 3456
#define XB_SPIN_CAP (1u << 22)
__device__ __forceinline__ unsigned xb_ld(unsigned* p)              { return __hip_atomic_load(p, __ATOMIC_RELAXED, __HIP_MEMORY_SCOPE_AGENT); }
__device__ __forceinline__ unsigned xb_add(unsigned* p, unsigned v) { return __hip_atomic_fetch_add(p, v, __ATOMIC_RELAXED, __HIP_MEMORY_SCOPE_AGENT); }
__device__ __forceinline__ unsigned xb_xcc_id() { return (unsigned)__builtin_amdgcn_s_getreg((3 << 11) | 20) & 0xFu; }
#define XB_SPIN(cond, bar) do { unsigned _sp = 0; while (cond) { __builtin_amdgcn_s_sleep(1); \
    if ((++_sp & 255u) == 0u) { if (xb_ld(&(bar)[XB_TMO])) break; if (_sp > XB_SPIN_CAP) { atomicAdd(&(bar)[XB_TMO], 1u); break; } } } } while (0)
struct XcdBarrier { unsigned* bar; unsigned x; volatile LAS unsigned* st; };
__device__ __forceinline__ XcdBarrier xcd_barrier_post(unsigned* bar, volatile LAS unsigned* st) {
    XcdBarrier b; b.bar = bar; b.x = xb_xcc_id(); b.st = st;
    if (threadIdx.x == 0) (void)xb_add(&bar[XB_XCNT(b.x)], 1u);
    return b;
}
__device__ __forceinline__ void xcd_barrier_complete(unsigned* bar, unsigned x, unsigned& nloc, unsigned& nx) {
    const unsigned G = gridDim.x * gridDim.y * gridDim.z;
    unsigned sum, cnt, mine, sp = 0u;
    for (;;) {
        sum = 0u; cnt = 0u; mine = 0u;
#pragma unroll
        for (unsigned j = 0; j < 16; ++j) { const unsigned c = xb_ld(&bar[XB_XCNT(j)]); sum += c; cnt += (c > 0u) ? 1u : 0u; mine = (j == x) ? c : mine; }
        if (sum == G) break;
        __builtin_amdgcn_s_sleep(1);
        if ((++sp & 255u) == 0u) { if (xb_ld(&bar[XB_TMO])) break; if (sp > XB_SPIN_CAP) { atomicAdd(&bar[XB_TMO], 1u); break; } }
    }
    nloc = mine > 0u ? mine : 1u; nx = cnt > 0u ? cnt : 1u;
}
__device__ __forceinline__ void xcd_barrier(const XcdBarrier& b) {
    asm volatile("s_waitcnt vmcnt(0)" ::: "memory");
    __syncthreads();
    if (threadIdx.x == 0) {
        unsigned* bar = b.bar;
        __builtin_amdgcn_s_waitcnt(0);
        unsigned nloc = b.st[0], nx = b.st[1];
        if (nloc == 0u) { xcd_barrier_complete(bar, b.x, nloc, nx); b.st[0] = nloc; b.st[1] = nx; }
        const unsigned old = xb_add(&bar[XB_XSUB(b.x)], 1u);
        const unsigned gen = old / nloc;
        if (old + 1u == (gen + 1u) * nloc) {
            __builtin_amdgcn_fence(__ATOMIC_RELEASE, "agent");
            asm volatile("s_waitcnt vmcnt(0)" ::: "memory");
            const unsigned og = xb_add(&bar[XB_TOP], 1u);
            const unsigned tg = og / nx;
            if (og + 1u == (tg + 1u) * nx) xb_add(&bar[XB_TOPGEN], 1u);
            else XB_SPIN(xb_ld(&bar[XB_TOPGEN]) == tg, bar);
            __builtin_amdgcn_fence(__ATOMIC_ACQUIRE, "agent");
            xb_add(&bar[XB_XGEN(b.x)], 1u);
            asm volatile("s_waitcnt vmcnt(0)" ::: "memory");
        } else {
            XB_SPIN(xb_ld(&bar[XB_XGEN(b.x)]) == gen, bar);
            __builtin_amdgcn_fence(__ATOMIC_ACQUIRE, "agent");
            asm volatile("s_waitcnt vmcnt(0)" ::: "memory");
        }
    }
    __syncthreads();
}
namespace pg8 {
constexpr int BM = 256, BK = 64, HALF = 128, HTB = HALF * BK * 2, STAGE_BYTES = 8 * HTB, NXCD = 8, WGM = 8;
__host__ __device__ __forceinline__ int lds_byte(int r, int c) { const int st = (r >> 4) * 2 + (c >> 5), rr = r & 15, cc = c & 31, ob = rr * 64 + cc * 2; return st * 1024 + (ob ^ (((ob >> 9) & 1) << 5)); }
__host__ __device__ __forceinline__ void stage_rc(int b, int& R, int& C) { const int st = b / 1024, sb = b % 1024, swz = sb ^ (((sb >> 9) & 1) << 5); R = (st >> 1) * 16 + swz / 64; C = (st & 1) * 32 + (swz % 64) / 2; }
__host__ __device__ __forceinline__ int perm32(int rho) { const int n = rho >> 4, i = rho & 15; return 8 * (i >> 2) + 4 * n + (i & 3); }

struct Unit { int pm, pn, ao; };
struct Gemm { const bf16_t* A; const bf16_t* Bt; int lda, ldb, K; };

struct StaticOrder {
    int nM, nN, nwg, G, c, aostep = 0;
    __device__ void init(int M, int N, int G_, int c_) { nM = M / BM; nN = N / BM; nwg = nM * nN; G = G_; c = c_; }
    __device__ bool next(int i, Unit& u) const {
        const long L = (long)i * G + c; if (L >= nwg) return false;
        int wgid = (int)L; { const int q = nwg / NXCD, r = nwg % NXCD, xcd = wgid % NXCD, off = wgid / NXCD; wgid = (xcd < r ? xcd * (q + 1) : r * (q + 1) + (xcd - r) * q) + off; }
        const int nig = WGM * nN, gid = wgid / nig, fm = gid * WGM, gsz = (nM - fm) < WGM ? (nM - fm) : WGM;
        u.pm = fm + ((wgid % nig) % gsz); u.pn = (wgid % nig) / gsz; u.ao = (u.pn >> 2) * aostep; return true;
    }
};
struct ExtraOrder {
    StaticOrder base; int xpm, xpn;
    __device__ bool next(int i, Unit& u) const {
        const int nb = (base.c < base.nwg) ? (base.nwg - base.c + base.G - 1) / base.G : 0;
        if (i < nb) return base.next(i, u);
        if (i == nb && xpm >= 0) { u.pm = xpm; u.pn = xpn; u.ao = 0; return true; }
        return false;
    }
};
struct ComboOrder {
    int ncombo, G, c, aostep, xpm, xpn;
    __device__ bool next(int i, Unit& u) const {
        const int ncb = (c < ncombo) ? (ncombo - c + G - 1) / G : 0;
        if (i < 4 * ncb) { const int combo = c + (i >> 2) * G; const int g = i & 3; u.pm = combo >> 2; u.pn = g * 4 + (combo & 3); u.ao = g * aostep; return true; }
        if (i == 4 * ncb && xpm >= 0) { u.pm = xpm; u.pn = xpn; u.ao = (xpn >> 2) * aostep; return true; }
        return false;
    }
};
struct ComboGate {
    int ncombo, G, c;
    __device__ bool next(int i, Unit& u) const {
        const int ncb = (c < ncombo) ? (ncombo - c + G - 1) / G : 0;
        if (i >= 4 * ncb) return false;
        const int combo = c + (i >> 2) * G; u.pm = combo >> 2; u.pn = (combo & 3) * 4 + (i & 3); u.ao = 0; return true;
    }
};
struct PanelOrder {
    int nM, G, c;
    __device__ bool next(int i, Unit& u) const { const int p = c + i * G; if (p >= nM) return false; u.pm = p; u.pn = 0; u.ao = 0; return true; }
};

template <class Epi, class Sched>
__device__ __forceinline__ void gemm_phase(LAS unsigned char* lds, const Gemm g, const Sched& S, const Epi& E, const int tid) {
    const int wid = __builtin_amdgcn_readfirstlane(tid >> 6), lane = tid & 63, wr = wid >> 2, wc = wid & 3, fr = lane & 15, fq = lane >> 4;
    const int K = g.K, nt = K / BK;
    unsigned voffA[2], voffB[2];
#pragma unroll
    for (int i = 0; i < 2; ++i) { int R, C; stage_rc(tid * 16 + i * 8192, R, C); const int Rb = Epi::PERM ? ((R & ~31) + perm32(R & 31)) : R;
        voffA[i] = (unsigned)(R * g.lda + C) * 2u; voffB[i] = (unsigned)(Rb * g.ldb + C) * 2u; }
    const size_t kstep = (size_t)(BK * 2);
    const size_t hsA = (size_t)HALF * g.lda * 2, hsB = (size_t)HALF * g.ldb * 2;
    const size_t tsA = 2 * hsA, tsB = 2 * hsB;
    const unsigned ldsw = (unsigned)wid * 1024u;
    const int aoff = lds_byte(wr * 64 + fr, fq * 8), boff = lds_byte(wc * 32 + fr, fq * 8);
#define PG8_SA(b, h) (((b) * 2 + (h)) * HTB)
#define PG8_SB(b, h) ((4 + (b) * 2 + (h)) * HTB)
#define PG8_STAGE(bufoff, gbase, voff) do { _Pragma("unroll") for (int _i = 0; _i < 2; ++_i) \
        __builtin_amdgcn_global_load_lds((const unsigned*)((const char*)(gbase) + (voff)[_i]), (LAS unsigned*)(lds + (bufoff) + ldsw + _i * 8192), 16, 0, 0); } while (0)
#define PG8_LDA(dst, b, h) do { _Pragma("unroll") for (int m = 0; m < 4; ++m) _Pragma("unroll") for (int k = 0; k < 2; ++k) dst[m][k] = *(const LAS bf16x8*)(lds + PG8_SA(b, h) + aoff + m * 2048 + k * 1024); } while (0)
#define PG8_LDB(dst, b, h) do { _Pragma("unroll") for (int n = 0; n < 2; ++n) _Pragma("unroll") for (int k = 0; k < 2; ++k) dst[n][k] = *(const LAS bf16x8*)(lds + PG8_SB(b, h) + boff + n * 2048 + k * 1024); } while (0)
#define PG8_MMA(ai, bj, At, Bt) do { __builtin_amdgcn_s_setprio(1); _Pragma("unroll") for (int m = 0; m < 4; ++m) _Pragma("unroll") for (int n = 0; n < 2; ++n) _Pragma("unroll") for (int k = 0; k < 2; ++k) \
        acc[ai][bj][m][n] = __builtin_amdgcn_mfma_f32_16x16x32_bf16(Bt[n][k], At[m][k], acc[ai][bj][m][n], 0, 0, 0); __builtin_amdgcn_s_setprio(0); } while (0)
#define PG8_WAIT_V(n) asm volatile("s_waitcnt vmcnt(" #n ")" ::: "memory")
#define PG8_WAIT_L(n) asm volatile("s_waitcnt lgkmcnt(" #n ")" ::: "memory")
#define PG8_BAR __builtin_amdgcn_s_barrier()
#define PG8_SCHED __builtin_amdgcn_sched_barrier(0)
    Unit cur, nxt; int ui = 0;
    if (!S.next(0, cur)) return;
    f32x4 acc[2][2][4][2];
#pragma unroll
    for (int a = 0; a < 2; ++a)
#pragma unroll
        for (int b = 0; b < 2; ++b)
#pragma unroll
            for (int m = 0; m < 4; ++m)
#pragma unroll
                for (int n = 0; n < 2; ++n) acc[a][b][m][n] = (f32x4){0.f, 0.f, 0.f, 0.f};
    bf16x8 At[4][2], B0[2][2], B1[2][2];
    const char* cA = (const char*)g.A + (size_t)cur.pm * tsA + (size_t)cur.ao * 2; const char* cB = (const char*)g.Bt + (size_t)cur.pn * tsB;
    PG8_STAGE(PG8_SB(0, 0), cB, voffB); PG8_STAGE(PG8_SB(0, 1), cB + hsB, voffB); PG8_STAGE(PG8_SA(0, 0), cA, voffA); PG8_STAGE(PG8_SA(0, 1), cA + hsA, voffA);
    if (wr == 1) PG8_BAR;
    PG8_WAIT_V(2); PG8_BAR;
    PG8_STAGE(PG8_SB(1, 0), cB + kstep, voffB); PG8_STAGE(PG8_SA(1, 0), cA + kstep, voffA); PG8_STAGE(PG8_SB(1, 1), cB + hsB + kstep, voffB);
    PG8_WAIT_V(6); PG8_BAR;
    for (;;) {
        const bool has_next = S.next(ui + 1, nxt);
        const char* nA = has_next ? (const char*)g.A + (size_t)nxt.pm * tsA + (size_t)nxt.ao * 2 : cA; const char* nB = has_next ? (const char*)g.Bt + (size_t)nxt.pn * tsB : cB;
#pragma unroll 1
        for (int t = 0; t < nt; t += 2) {
            const bool last = (t == nt - 2);
            const char* a1 = cA + (size_t)(t + 1) * kstep;
            const char* a2 = last ? nA : cA + (size_t)(t + 2) * kstep; const char* b2 = last ? nB : cB + (size_t)(t + 2) * kstep;
            const char* a3 = a2 + kstep; const char* b3 = b2 + kstep;
            PG8_LDB(B0, 0, 0); PG8_LDB(B1, 0, 1); PG8_SCHED; PG8_LDA(At, 0, 0); PG8_STAGE(PG8_SA(1, 1), a1 + hsA, voffA);
            PG8_WAIT_V(8); PG8_WAIT_L(0); PG8_BAR; PG8_MMA(0, 0, At, B0); PG8_MMA(0, 1, At, B1); PG8_BAR; PG8_SCHED;
            PG8_LDA(At, 0, 1); PG8_STAGE(PG8_SB(0, 0), b2, voffB); PG8_STAGE(PG8_SB(0, 1), b2 + hsB, voffB); PG8_STAGE(PG8_SA(0, 0), a2, voffA);
            PG8_WAIT_V(8); PG8_WAIT_L(0); PG8_BAR; PG8_MMA(1, 0, At, B0); PG8_MMA(1, 1, At, B1); PG8_BAR; PG8_SCHED;
            PG8_LDB(B0, 1, 0); PG8_LDB(B1, 1, 1); PG8_SCHED; PG8_LDA(At, 1, 0); PG8_STAGE(PG8_SA(0, 1), a2 + hsA, voffA);
            PG8_WAIT_V(8); PG8_WAIT_L(0); PG8_BAR; PG8_MMA(0, 0, At, B0); PG8_MMA(0, 1, At, B1); PG8_BAR; PG8_SCHED;
            PG8_LDA(At, 1, 1); PG8_STAGE(PG8_SB(1, 0), b3, voffB); PG8_STAGE(PG8_SB(1, 1), b3 + hsB, voffB); PG8_STAGE(PG8_SA(1, 0), a3, voffA);
            PG8_WAIT_V(8); PG8_WAIT_L(0); PG8_BAR; PG8_MMA(1, 0, At, B0); PG8_MMA(1, 1, At, B1); PG8_BAR; PG8_SCHED;
        }
        if (wr == 0) PG8_BAR;
        { int fr_ = fr, fq_ = fq; asm volatile("" : "+v"(fr_), "+v"(fq_)); E(acc, cur, wr, wc, fr_, fq_); }
        if (!has_next) break;
#pragma unroll
        for (int a = 0; a < 2; ++a)
#pragma unroll
            for (int b = 0; b < 2; ++b)
#pragma unroll
                for (int m = 0; m < 4; ++m)
#pragma unroll
                    for (int n = 0; n < 2; ++n) acc[a][b][m][n] = (f32x4){0.f, 0.f, 0.f, 0.f};
        cur = nxt; cA = nA; cB = nB; ++ui;
        if (wr == 1) PG8_BAR;
    }
    PG8_WAIT_V(0);
    PG8_BAR;
#undef PG8_SA
#undef PG8_SB
#undef PG8_STAGE
#undef PG8_LDA
#undef PG8_LDB
#undef PG8_MMA
#undef PG8_WAIT_V
#undef PG8_WAIT_L
#undef PG8_BAR
#undef PG8_SCHED
}
}
namespace pg8 {
struct EpiInproj {
    static constexpr bool PERM = true;
    bf16_t* P;
    __device__ __forceinline__ void operator()(const f32x4 (&acc)[2][2][4][2], const Unit& u, int wr, int wc, int fr, int fq) const {
        const int row0 = u.pm * BM + wr * 64 + fr, col0 = u.pn * BM + wc * 32 + 8 * fq;
        const bool rope = (u.pn == 7 || u.pn == 8) && (u.pm < NLAT / BM);
        const float sc = (u.pn == 7) ? QD_SCALE : (u.pn == 1 ? QB_SCALE : 1.0f);
#pragma unroll
        for (int ai = 0; ai < 2; ++ai)
#pragma unroll
            for (int m = 0; m < 4; ++m) {
                const int row = row0 + ai * HALF + m * 16;
                bf16_t* rowp = P + (size_t)row * IN_DIM + col0;
                float cs[8], sn[8];
                if (rope) {
                    const int t = row & (SEQ - 1); const float pos = (float)((fq < 2) ? (t >> 6) : (t & 63));
                    const float sg = (fq & 1) ? 1.0f : -1.0f;
#pragma unroll
                    for (int i = 0; i < 8; ++i) {
                        constexpr float INVREV[8] = {0.15915494309189535f, 0.050329212104487034f, 0.015915494309189534f, 0.0050329212104487035f,
                                                     0.0015915494309189536f, 0.00050329212104487036f, 0.00015915494309189535f, 0.000050329212104487036f};
                        const float rev = pos * INVREV[i]; const float fr_ = rev - __builtin_floorf(rev);
                        cs[i] = __builtin_amdgcn_cosf(fr_); sn[i] = __builtin_amdgcn_sinf(fr_) * sg;
                    }
                }
#pragma unroll
                for (int bj = 0; bj < 2; ++bj) {
                    float v[8];
#pragma unroll
                    for (int i = 0; i < 4; ++i) { v[i] = acc[ai][bj][m][0][i]; v[4 + i] = acc[ai][bj][m][1][i]; }
                    if (rope) {
#pragma unroll
                        for (int i = 0; i < 8; ++i) { const float pr = sx(v[i], 16, fr + 16 * fq); v[i] = v[i] * cs[i] + pr * sn[i]; }
                    }
                    u32x4 w; w.x = pk2a(v[0] * sc, v[1] * sc); w.y = pk2a(v[2] * sc, v[3] * sc); w.z = pk2a(v[4] * sc, v[5] * sc); w.w = pk2a(v[6] * sc, v[7] * sc);
                    *(u32x4*)(rowp + bj * HALF) = w;
                }
            }
    }
};
struct EpiBf16 {
    static constexpr bool PERM = true;
    bf16_t* O; int ldc;
    __device__ __forceinline__ void operator()(const f32x4 (&acc)[2][2][4][2], const Unit& u, int wr, int wc, int fr, int fq) const {
        const int row0 = u.pm * BM + wr * 64 + fr, col0 = u.pn * BM + wc * 32 + 8 * fq;
#pragma unroll
        for (int ai = 0; ai < 2; ++ai)
#pragma unroll
            for (int m = 0; m < 4; ++m) { bf16_t* rowp = O + (size_t)(row0 + ai * HALF + m * 16) * ldc + col0;
#pragma unroll
                for (int bj = 0; bj < 2; ++bj) { const f32x4 v0 = acc[ai][bj][m][0], v1 = acc[ai][bj][m][1];
                    u32x4 w; w.x = pk2a(v0[0], v0[1]); w.y = pk2a(v0[2], v0[3]); w.z = pk2a(v1[0], v1[1]); w.w = pk2a(v1[2], v1[3]);
                    *(u32x4*)(rowp + bj * HALF) = w; } }
    }
};
struct EpiGate {
    static constexpr bool PERM = true;
    const bf16_t* PB; bf16_t* MACC; bf16_t* MRG; float* TC;
    __device__ __forceinline__ void operator()(const f32x4 (&acc)[2][2][4][2], const Unit& u, int wr, int wc, int fr, int fq) const {
        const int gate = u.pn >> 2, ct = u.pn & 3;
        const int row0 = u.pm * BM + wr * 64 + fr, col0 = ct * BM + wc * 32 + 8 * fq;
        const bool ctx = u.pm >= NLAT / BM, rmw = !ctx && gate != 0;
#pragma unroll
        for (int ai = 0; ai < 2; ++ai)
#pragma unroll
            for (int m = 0; m < 4; ++m) {
                const size_t row = (size_t)(row0 + ai * HALF + m * 16);
                u32x4 pw[2], ow[2];
#pragma unroll
                for (int bj = 0; bj < 2; ++bj) { const int col = col0 + bj * HALF;
                    pw[bj] = *(const u32x4*)(PB + row * 4096 + gate * 1024 + col);
                    if (rmw) ow[bj] = *(const u32x4*)(MACC + row * DM + col); }
#pragma unroll
                for (int bj = 0; bj < 2; ++bj) {
                    const int col = col0 + bj * HALF;
                    float t[8];
                    const float pv[8] = {bflo(pw[bj].x), bfhi(pw[bj].x), bflo(pw[bj].y), bfhi(pw[bj].y), bflo(pw[bj].z), bfhi(pw[bj].z), bflo(pw[bj].w), bfhi(pw[bj].w)};
#pragma unroll
                    for (int i = 0; i < 8; ++i) { const float a = (i < 4) ? acc[ai][bj][m][0][i & 3] : acc[ai][bj][m][1][i & 3];
                        t[i] = pv[i] * __builtin_amdgcn_rcpf(1.0f + ex2(-a * LOG2E)); }
                    if (ctx) { float* tp = TC + ((size_t)gate * NCTX + (row - NLAT)) * DM + col;
                        *(f32x4*)tp = (f32x4){t[0], t[1], t[2], t[3]}; *(f32x4*)(tp + 4) = (f32x4){t[4], t[5], t[6], t[7]}; continue; }
                    if (rmw) {
#pragma unroll
                        for (int i = 0; i < 4; ++i) { t[2 * i] += bflo(ow[bj][i]); t[2 * i + 1] += bfhi(ow[bj][i]); } }
                    u32x4 w; w.x = pk2a(t[0], t[1]); w.y = pk2a(t[2], t[3]); w.z = pk2a(t[4], t[5]); w.w = pk2a(t[6], t[7]);
                    *(u32x4*)((gate != 3 ? MACC : MRG) + row * DM + col) = w;
                }
                asm volatile("" ::: "memory");
            }
    }
};
struct EpiGate4 {
    static constexpr bool PERM = true;
    const bf16_t* PB; bf16_t* MRG;
    __device__ __forceinline__ void operator()(const f32x4 (&acc)[2][2][4][2], const Unit& u, int wr, int wc, int fr, int fq) const {
        const int row0 = u.pm * BM + wr * 64 + fr, oc0 = u.pn * 64 + 16 * wc + 4 * fq;
#pragma unroll
        for (int ai = 0; ai < 2; ++ai)
#pragma unroll
            for (int m = 0; m < 4; ++m) {
                const size_t row = (size_t)(row0 + ai * HALF + m * 16);
                u32x2 pw[4];
#pragma unroll
                for (int g = 0; g < 4; ++g) pw[g] = *(const u32x2*)(PB + row * 4096 + g * 1024 + oc0);
                float t[4] = {0.f, 0.f, 0.f, 0.f};
#pragma unroll
                for (int g = 0; g < 4; ++g) { const f32x4 a = acc[ai][g >> 1][m][g & 1]; const float pv[4] = {bflo(pw[g].x), bfhi(pw[g].x), bflo(pw[g].y), bfhi(pw[g].y)};
#pragma unroll
                    for (int i = 0; i < 4; ++i) t[i] += pv[i] * __builtin_amdgcn_rcpf(1.0f + ex2(-a[i] * LOG2E)); }
                u32x2 w; w.x = pk2a(t[0], t[1]); w.y = pk2a(t[2], t[3]);
                *(u32x2*)(MRG + row * DM + oc0) = w;
                if (m & 1) asm volatile("" ::: "memory");
            }
    }
};
template <bool L0>
struct EpiResid {
    static constexpr bool PERM = true;
    const float* base_lat; const float* base_ctx; bf16_t* X; const float* mods;
    __device__ __forceinline__ void operator()(const f32x4 (&acc)[2][2][4][2], const Unit& u, int wr, int wc, int fr, int fq) const {
        const int row0 = u.pm * BM + wr * 64 + fr, col0 = u.pn * BM + wc * 32 + 8 * fq;
        const int vec = u.pm < 32 ? 0 : (u.pm < 64 ? 1 : 2);
        const float* gv = mods + (vec * 6 + 2) * DM;
        f32x4 g4[2][2];
#pragma unroll
        for (int bj = 0; bj < 2; ++bj)
#pragma unroll
            for (int n = 0; n < 2; ++n) g4[bj][n] = *(const f32x4*)(gv + col0 + bj * HALF + n * 4);
#pragma unroll
        for (int ai = 0; ai < 2; ++ai)
#pragma unroll
            for (int m = 0; m < 4; ++m) { const int row = row0 + ai * HALF + m * 16;
                bf16_t* xp = X + (size_t)row * DM;
#pragma unroll
                for (int bj = 0; bj < 2; ++bj) { const int c = col0 + bj * HALF;
                    f32x4 b0, b1;
                    if (L0) { const float* bp = (row < NLAT) ? base_lat + (size_t)row * DM : base_ctx + (size_t)(row - NLAT) * DM; b0 = *(const f32x4*)(bp + c); b1 = *(const f32x4*)(bp + c + 4); }
                    else { const u32x4 xb = *(const u32x4*)(xp + c); b0 = (f32x4){bflo(xb.x), bfhi(xb.x), bflo(xb.y), bfhi(xb.y)}; b1 = (f32x4){bflo(xb.z), bfhi(xb.z), bflo(xb.w), bfhi(xb.w)}; }
                    const f32x4 o0 = b0 + g4[bj][0] * acc[ai][bj][m][0], o1 = b1 + g4[bj][1] * acc[ai][bj][m][1];
                    u32x4 w; w.x = pk2a(o0[0], o0[1]); w.y = pk2a(o0[2], o0[3]); w.z = pk2a(o1[0], o1[1]); w.w = pk2a(o1[2], o1[3]);
                    *(u32x4*)(xp + c) = w; }
                asm volatile("" ::: "memory"); }
    }
};
struct EpiSwiGLU {
    static constexpr bool PERM = true;
    bf16_t* ACT;
    __device__ __forceinline__ void operator()(const f32x4 (&acc)[2][2][4][2], const Unit& u, int wr, int wc, int fr, int fq) const {
        const int row0 = u.pm * BM + wr * 64 + fr, col0 = u.pn * 128 + wc * 32 + 8 * fq;
#pragma unroll
        for (int ai = 0; ai < 2; ++ai)
#pragma unroll
            for (int m = 0; m < 4; ++m) {
                float a[8];
#pragma unroll
                for (int i = 0; i < 8; ++i) { const float g = (i < 4) ? acc[ai][0][m][0][i & 3] : acc[ai][0][m][1][i & 3], uu = (i < 4) ? acc[ai][1][m][0][i & 3] : acc[ai][1][m][1][i & 3];
                    a[i] = g * __builtin_amdgcn_rcpf(1.0f + ex2(-g * LOG2E)) * uu; }
                u32x4 w; w.x = pk2a(a[0], a[1]); w.y = pk2a(a[2], a[3]); w.z = pk2a(a[4], a[5]); w.w = pk2a(a[6], a[7]);
                *(u32x4*)(ACT + (size_t)(row0 + ai * HALF + m * 16) * EDIM + col0) = w;
            }
    }
};
struct EpiSlot8 {
    static constexpr bool PERM = true;
    bf16_t* YSP;
    __device__ __forceinline__ void operator()(const f32x4 (&acc)[2][2][4][2], const Unit& u, int wr, int wc, int fr, int fq) const {
        const int row0 = u.pm * BM + wr * 64 + fr, col0 = u.pn * BM + wc * 32 + 8 * fq;
#pragma unroll
        for (int ai = 0; ai < 2; ++ai)
#pragma unroll
            for (int m = 0; m < 4; ++m) { bf16_t* rowp = YSP + ((size_t)(row0 + ai * HALF + m * 16) * NSLOT + 8) * DM + col0;
#pragma unroll
                for (int bj = 0; bj < 2; ++bj) { const f32x4 v0 = acc[ai][bj][m][0], v1 = acc[ai][bj][m][1];
                    u32x4 w; w.x = pk2a(v0[0], v0[1]); w.y = pk2a(v0[2], v0[3]); w.z = pk2a(v1[0], v1[1]); w.w = pk2a(v1[2], v1[3]);
                    *(u32x4*)(rowp + bj * HALF) = w; } }
    }
};
struct OffsetOrder {
    int nM, nN, G, c, off;
    __device__ bool next(int i, Unit& u) const { const int q = ((c + G - off) % G) + i * G; if (q >= nM * nN) return false; u.pm = q / nN; u.pn = q % nN; u.ao = 0; return true; }
};
struct EpiF32 {
    static constexpr bool PERM = false;
    float* C; int ldc;
    __device__ __forceinline__ void operator()(const f32x4 (&acc)[2][2][4][2], const Unit& u, int wr, int wc, int fr, int fq) const {
        const int row0 = u.pm * BM + wr * 64 + fr, col0 = u.pn * BM + wc * 32 + 4 * fq;
#pragma unroll
        for (int ai = 0; ai < 2; ++ai)
#pragma unroll
            for (int m = 0; m < 4; ++m) { float* rowp = C + (size_t)(row0 + ai * HALF + m * 16) * ldc + col0;
#pragma unroll
                for (int bj = 0; bj < 2; ++bj)
#pragma unroll
                    for (int n = 0; n < 2; ++n) *(f32x4*)(rowp + bj * HALF + n * 16) = acc[ai][bj][m][n]; }
    }
};
}
__device__ __forceinline__ void transpose_item(const float* W, int K, int N, bf16_t* WT, LAS float* scr, int item, int lane, int gu = 0) {
    const int nblk = N / 32, kb = item / nblk, nb = item % nblk, k0 = 64 * kb, n0 = 32 * nb;
    const int d0 = (gu == 1 || gu == 2) ? ((n0 >> 7) * 256 + (gu - 1) * 128 + (n0 & 127)) : n0;
    const int gg = (gu >= 3) ? (gu - 3) : -1;
#pragma unroll 8
    for (int i = 0; i < 32; ++i) { const int kk = 2 * i + (lane >> 5); scr[kk * 33 + (lane & 31)] = W[(size_t)(k0 + kk) * N + n0 + (lane & 31)]; }
    LDS_WAIT(); asm volatile("" ::: "memory");
    const int c = lane & 7;
#pragma unroll
    for (int j = 0; j < 4; ++j) { const int n = (lane >> 3) + 8 * j; const LAS float* s = scr + (8 * c) * 33 + n;
        u32x4 o; o.x = pk2(s[0 * 33], s[1 * 33]); o.y = pk2(s[2 * 33], s[3 * 33]); o.z = pk2(s[4 * 33], s[5 * 33]); o.w = pk2(s[6 * 33], s[7 * 33]);
        const int oc = n0 + n; const int drow = (gg >= 0) ? ((oc >> 6) * 256 + 128 * (gg >> 1) + 32 * ((oc >> 4) & 3) + 8 * ((oc >> 2) & 3) + 4 * (gg & 1) + (oc & 3)) : (d0 + n);
        *(u32x4*)(WT + (size_t)drow * K + k0 + 8 * c) = o; }
    LDS_WAIT(); asm volatile("" ::: "memory");
}

__device__ __forceinline__ void norm_mod_row(const f32x4 (&v)[4], const float* g, const float* shift, const float* scale, bf16_t* orow, int lane) {
    float ss = 0.f;
#pragma unroll
    for (int j = 0; j < 4; ++j) ss += (v[j].x * v[j].x + v[j].y * v[j].y) + (v[j].z * v[j].z + v[j].w * v[j].w);
    const float rstd = __builtin_amdgcn_rsqf(wave_sum(ss, lane) * (1.f / DM) + EPS);
#pragma unroll
    for (int j = 0; j < 4; ++j) {
        const int c = 4 * lane + 256 * j;
        const f32x4 gg = *(const f32x4*)(g + c), sh = *(const f32x4*)(shift + c), sc = *(const f32x4*)(scale + c);
        const f32x4 y = v[j] * rstd * gg * (sc + 1.0f) + sh;
        u32x2 w; w.x = pk2(y.x, y.y); w.y = pk2(y.z, y.w);
        *(u32x2*)(orow + c) = w;
    }
}

__device__ __forceinline__ void conv_phase(const bf16_t* P, const float* cw  , bf16_t* YBR, int ntok, int gtid, int gthreads) {
    for (int idx = gtid; idx < ntok * 32; idx += gthreads) {
        const int tok = idx >> 5, p = idx & 31;
        int t, n; if (tok < NLAT) { t = tok & (SEQ - 1); n = SEQ; } else { t = (tok - NLAT) & (LCTX - 1); n = LCTX; }
        const bf16_t* r = P + (size_t)tok * IN_DIM + 8 * p;
        const u32x4 gb = *(const u32x4*)(r + 1024);
        const u32x4 z = {0u, 0u, 0u, 0u};
        const u32x4 c0 = (t > 0) ? *(const u32x4*)(r - IN_DIM + 1280) : z, x0 = (t > 0) ? *(const u32x4*)(r - IN_DIM + 1536) : z;
        const u32x4 c1 = *(const u32x4*)(r + 1280), x1 = *(const u32x4*)(r + 1536);
        const u32x4 c2 = (t < n - 1) ? *(const u32x4*)(r + IN_DIM + 1280) : z, x2 = (t < n - 1) ? *(const u32x4*)(r + IN_DIM + 1536) : z;
        float o[8];
#pragma unroll
        for (int i = 0; i < 4; ++i) {
            const int ch = 8 * p + 2 * i;
            const float w00 = cw[ch], w01 = cw[256 + ch], w02 = cw[512 + ch], w10 = cw[ch + 1], w11 = cw[256 + ch + 1], w12 = cw[512 + ch + 1];
            const float u0l = bflo(c0[i]) * bflo(x0[i]), u0h = bfhi(c0[i]) * bfhi(x0[i]);
            const float u1l = bflo(c1[i]) * bflo(x1[i]), u1h = bfhi(c1[i]) * bfhi(x1[i]);
            const float u2l = bflo(c2[i]) * bflo(x2[i]), u2h = bfhi(c2[i]) * bfhi(x2[i]);
            o[2 * i] = bflo(gb[i]) * (w00 * u0l + w01 * u1l + w02 * u2l);
            o[2 * i + 1] = bfhi(gb[i]) * (w10 * u0h + w11 * u1h + w12 * u2h);
        }
        u32x4 w; w.x = pk2(o[0], o[1]); w.y = pk2(o[2], o[3]); w.z = pk2(o[4], o[5]); w.w = pk2(o[6], o[7]);
        *(u32x4*)(YBR + (size_t)tok * DM + 512 + 8 * p) = w;
    }
}

__device__ __forceinline__ int key_row(int b, int key) { return key < SEQ ? b * SEQ + key : NLAT + b * LCTX + (key - SEQ); }
__device__ __forceinline__ void kvprep_item(const bf16_t* P, bf16_t* VTD, bf16_t* VTB, unsigned* kmax, LAS unsigned char* lds, int b, int kblk, int tid) {
    LAS bf16_t* T = (LAS bf16_t*)lds;
    LAS unsigned* mx = (LAS unsigned*)(lds + 64 * 264 * 2);
    const int key0 = kblk * 64, row0 = key_row(b, key0);
    if (tid < 12) mx[tid] = 0u;
#pragma unroll
    for (int which = 0; which < 2; ++which) {
        const int coff = which ? 768 : 2304; bf16_t* VT = which ? VTB : VTD;
        __syncthreads();
#pragma unroll
        for (int j = 0; j < 4; ++j) { const int pid = tid + 512 * j, kr = pid >> 5, seg = pid & 31;
            *(LAS u32x4*)(T + kr * 264 + seg * 8) = *(const u32x4*)(P + (size_t)(row0 + kr) * IN_DIM + coff + seg * 8); }
        __syncthreads();
#pragma unroll
        for (int j = 0; j < 4; ++j) { const int pid = tid + 512 * j, col = pid >> 3, kp = pid & 7;
            unsigned w[4];
#pragma unroll
            for (int i = 0; i < 4; ++i) w[i] = (unsigned)T[(kp * 8 + 2 * i) * 264 + col] | ((unsigned)T[(kp * 8 + 2 * i + 1) * 264 + col] << 16);
            *(u32x4*)(VT + ((size_t)(b * 4 + (col >> 6)) * 64 + (col & 63)) * NKEY + key0 + kp * 8) = (u32x4){w[0], w[1], w[2], w[3]}; }
    }
    {
        const int kr = tid >> 3, hm = tid & 7;
        const bf16_t* rp = P + (size_t)(row0 + kr) * IN_DIM + hm * 32;
        float sd = 0.f, sb = 0.f;
#pragma unroll
        for (int j = 0; j < 4; ++j) { const u32x4 a = *(const u32x4*)(rp + 2048 + 8 * j), c = *(const u32x4*)(rp + 512 + 8 * j);
#pragma unroll
            for (int i = 0; i < 4; ++i) { sd += bflo(a[i]) * bflo(a[i]) + bfhi(a[i]) * bfhi(a[i]); sb += bflo(c[i]) * bflo(c[i]) + bfhi(c[i]) * bfhi(c[i]); } }
        sb += sx(sb, 1, tid & 63);
        atomicMax((unsigned*)&mx[hm], __float_as_uint(sd));
        if ((hm & 1) == 0) atomicMax((unsigned*)&mx[8 + (hm >> 1)], __float_as_uint(sb));
    }
    __syncthreads();
    if (tid < 8) atomicMax(&kmax[b * 8 + tid], mx[tid]);
    else if (tid < 12) atomicMax(&kmax[16 + b * 4 + (tid - 8)], mx[tid]);
    __syncthreads();
}
#define MFMA_F32(a, b, c) __builtin_amdgcn_mfma_f32_32x32x2f32((a), (b), (c), 0, 0, 0)
#define MFMA_BF(a, b, c) __builtin_amdgcn_mfma_f32_32x32x16_bf16((a), (b), (c), 0, 0, 0)
__device__ __forceinline__ f32x16 zero16() { f32x16 z;
#pragma unroll
    for (int i = 0; i < 16; ++i) z[i] = 0.f; return z; }
__device__ __forceinline__ void f1_unit(const bf16_t* P, float* Z2R, float* Z2I, LAS unsigned char* lds, int b, int c, int g, int tid) {
    LAS float* V = (LAS float*)lds;
    LAS float* tab = (LAS float*)(lds + 128 * 132 * 4);
    const int lane = tid & 63, w = __builtin_amdgcn_readfirstlane(tid >> 6), l32 = lane & 31, hi = lane >> 5;
    if (tid < 64) { const float x = (float)tid * (1.f / 64.f); tab[tid] = __builtin_amdgcn_cosf(x); tab[64 + tid] = __builtin_amdgcn_sinf(x); }
    else if (tid < 192) { const int i = tid - 64; const float x = (float)i * (1.f / 128.f); tab[128 + i] = __builtin_amdgcn_cosf(x); tab[256 + i] = __builtin_amdgcn_sinf(x); }
    __syncthreads();
    {
        const int mt = w >> 1, part = w & 1, r = mt * 32 + l32;
        const bf16_t* up = P + (size_t)(b * SEQ + r * 64 + c) * IN_DIM + g * 64;
        u32x4 uq[8];
#pragma unroll
        for (int i = 0; i < 8; ++i) uq[i] = *(const u32x4*)(up + 8 * i);
        f32x16 a0 = zero16(), a1 = zero16();
        const LAS float* tb = tab + part * 64; const float sgn = part ? -1.f : 1.f;
#pragma unroll
        for (int s = 0; s < 32; ++s) {
            const unsigned wv = uq[s >> 2][s & 3]; const float a = hi ? bfhi(wv) : bflo(wv);
            const int j = 2 * s + hi;
            const float b0 = tb[(j * l32) & 63] * sgn, b1 = tb[(j * (32 + l32)) & 63] * sgn;
            a0 = MFMA_F32(a, b0, a0); a1 = MFMA_F32(a, b1, a1);
        }
#pragma unroll
        for (int q = 0; q < 16; ++q) { const int rr = mt * 32 + crow(q, hi); V[rr * 132 + part * 64 + l32] = a0[q]; V[rr * 132 + part * 64 + 32 + l32] = a1[q]; }
    }
    __syncthreads();
    {
        const int mt = w >> 1, mh = w & 1, ka = mt * 32 + l32;
        f32x16 Tr = zero16(), Ti = zero16();
#pragma unroll 4
        for (int s = 0; s < 64; ++s) {
            const int r = 2 * s + hi, idx = (ka * r) & 127;
            const float aC = tab[128 + idx], aS = tab[256 + idx];
            const float bR = V[r * 132 + mh * 32 + l32], bI = V[r * 132 + 64 + mh * 32 + l32];
            Tr = MFMA_F32(aC, bR, Tr); Tr = MFMA_F32(aS, bI, Tr); Ti = MFMA_F32(aC, bI, Ti); Ti = MFMA_F32(-aS, bR, Ti);
        }
#pragma unroll
        for (int q = 0; q < 16; ++q) {
            const int k = mt * 32 + crow(q, hi); const float x = (float)((k * c) & 8191) * (1.f / 8192.f);
            const float cs = __builtin_amdgcn_cosf(x), sn = __builtin_amdgcn_sinf(x);
            const size_t o = ((((size_t)(b * 128 + k) * 4 + g) * 64 + c) * 64) + mh * 32 + l32;
            Z2R[o] = Tr[q] * cs + Ti[q] * sn; Z2I[o] = Ti[q] * cs - Tr[q] * sn;
        }
    }
    __syncthreads();
}

constexpr int F1_TSTR = 272, F1_TC = 0, F1_TS = 128 * F1_TSTR, F1_TF = 2 * 128 * F1_TSTR, F1_FSTR = 144, F1_VT = F1_TF + 128 * F1_FSTR;
__device__ __forceinline__ void f1b_tables(LAS unsigned char* lds, int tid) {
    for (int i = tid; i < 128 * 128; i += 512) { const int ka = i >> 7, r = i & 127; const float x = (float)((ka * r) & 127) * (1.f / 128.f);
        *(LAS bf16_t*)(lds + F1_TC + ka * F1_TSTR + r * 2) = (bf16_t)(pk2(__builtin_amdgcn_cosf(x), 0.f) & 0xffffu);
        *(LAS bf16_t*)(lds + F1_TS + ka * F1_TSTR + r * 2) = (bf16_t)(pk2(__builtin_amdgcn_sinf(x), 0.f) & 0xffffu); }
    for (int i = tid; i < 128 * 64; i += 512) { const int xx = i >> 6, j = i & 63; const float x = (float)((j * (xx & 63)) & 63) * (1.f / 64.f);
        const float v = (xx < 64) ? __builtin_amdgcn_cosf(x) : -__builtin_amdgcn_sinf(x);
        *(LAS bf16_t*)(lds + F1_TF + xx * F1_FSTR + j * 2) = (bf16_t)(pk2(v, 0.f) & 0xffffu); }
    __syncthreads();
}
__device__ __forceinline__ void f1b_unit(const bf16_t* P, float* Z2R, float* Z2I, LAS unsigned char* lds, int b, int c, int g, int tid) {
    const int lane = tid & 63, w = __builtin_amdgcn_readfirstlane(tid >> 6), l32 = lane & 31, hi = lane >> 5;
    {
        const int mt = w >> 1, xh = w & 1, r = mt * 32 + l32;
        const bf16_t* up = P + (size_t)(b * SEQ + r * 64 + c) * IN_DIM + g * 64;
        f32x16 a0 = zero16(), a1 = zero16();
#pragma unroll
        for (int ks = 0; ks < 4; ++ks) {
            const bf16x8 uf = *(const bf16x8*)(up + ks * 16 + 8 * hi);
            const bf16x8 f0 = *(const LAS bf16x8*)(lds + F1_TF + (xh * 64 + l32) * F1_FSTR + (ks * 16 + 8 * hi) * 2), f1 = *(const LAS bf16x8*)(lds + F1_TF + (xh * 64 + 32 + l32) * F1_FSTR + (ks * 16 + 8 * hi) * 2);
            a0 = MFMA_BF(uf, f0, a0); a1 = MFMA_BF(uf, f1, a1);
        }
#pragma unroll
        for (int rg = 0; rg < 4; ++rg) {
            const int r0 = mt * 32 + 8 * rg + 4 * hi;
            u32x2 v0, v1; v0.x = pk2(a0[4 * rg], a0[4 * rg + 1]); v0.y = pk2(a0[4 * rg + 2], a0[4 * rg + 3]); v1.x = pk2(a1[4 * rg], a1[4 * rg + 1]); v1.y = pk2(a1[4 * rg + 2], a1[4 * rg + 3]);
            *(LAS u32x2*)(lds + F1_VT + (xh * 64 + l32) * F1_TSTR + r0 * 2) = v0; *(LAS u32x2*)(lds + F1_VT + (xh * 64 + 32 + l32) * F1_TSTR + r0 * 2) = v1;
            if (xh == 0) { v0.x ^= 0x80008000u; v0.y ^= 0x80008000u; v1.x ^= 0x80008000u; v1.y ^= 0x80008000u;
                *(LAS u32x2*)(lds + F1_VT + (128 + l32) * F1_TSTR + r0 * 2) = v0; *(LAS u32x2*)(lds + F1_VT + (160 + l32) * F1_TSTR + r0 * 2) = v1; }
        }
    }
    __syncthreads();
    {
        const int mt = w >> 1, mh = w & 1;
        f32x16 Tr = zero16(), Ti = zero16();
#pragma unroll
        for (int ks = 0; ks < 8; ++ks) {
            const int ko = (ks * 16 + 8 * hi) * 2;
            const bf16x8 aC = *(const LAS bf16x8*)(lds + F1_TC + (mt * 32 + l32) * F1_TSTR + ko), aS = *(const LAS bf16x8*)(lds + F1_TS + (mt * 32 + l32) * F1_TSTR + ko);
            const bf16x8 bR = *(const LAS bf16x8*)(lds + F1_VT + (mh * 32 + l32) * F1_TSTR + ko), bI = *(const LAS bf16x8*)(lds + F1_VT + (64 + mh * 32 + l32) * F1_TSTR + ko),
                         bN = *(const LAS bf16x8*)(lds + F1_VT + (128 + mh * 32 + l32) * F1_TSTR + ko);
            Tr = MFMA_BF(aC, bR, Tr); Tr = MFMA_BF(aS, bI, Tr); Ti = MFMA_BF(aC, bI, Ti); Ti = MFMA_BF(aS, bN, Ti);
        }
#pragma unroll
        for (int q = 0; q < 16; ++q) {
            const int k = mt * 32 + crow(q, hi); const float x = (float)((k * c) & 8191) * (1.f / 8192.f);
            const float cs = __builtin_amdgcn_cosf(x), sn = __builtin_amdgcn_sinf(x);
            const size_t o = ((((size_t)(b * 128 + k) * 4 + g) * 64 + c) * 64) + mh * 32 + l32;
            Z2R[o] = Tr[q] * cs + Ti[q] * sn; Z2I[o] = Ti[q] * cs - Tr[q] * sn;
        }
    }
    __syncthreads();
}
__device__ __forceinline__ void f2_unit(const float* Z2R, const float* Z2I, bf16_t* YBR, LAS unsigned char* lds, int b, int ka, int tid) {
    LAS float* tab = (LAS float*)lds;
    const int lane = tid & 63, w = __builtin_amdgcn_readfirstlane(tid >> 6), l32 = lane & 31, hi = lane >> 5;
    if (tid < 64) { const float x = (float)tid * (1.f / 64.f); tab[tid] = __builtin_amdgcn_cosf(x); tab[64 + tid] = __builtin_amdgcn_sinf(x); }
    __syncthreads();
    const int g = w >> 1, kbh = w & 1, kb = kbh * 32 + l32;
    const size_t base = ((size_t)(b * 128 + ka) * 4 + g) * 4096;
    f32x16 Y0 = zero16(), Y1 = zero16();
#pragma unroll 4
    for (int s = 0; s < 32; ++s) {
        const int c = 2 * s + hi, idx = (kb * c) & 63;
        const float aC = tab[idx], aS = tab[64 + idx];
        const float r0 = Z2R[base + c * 64 + l32], r1 = Z2R[base + c * 64 + 32 + l32], i0 = Z2I[base + c * 64 + l32], i1 = Z2I[base + c * 64 + 32 + l32];
        Y0 = MFMA_F32(aC, r0, Y0); Y0 = MFMA_F32(aS, i0, Y0); Y1 = MFMA_F32(aC, r1, Y1); Y1 = MFMA_F32(aS, i1, Y1);
    }
    constexpr float NORM = 0.0013810679320049757f;
#pragma unroll
    for (int q = 0; q < 16; ++q) {
        const int kbo = kbh * 32 + crow(q, hi); bf16_t* op = YBR + (size_t)(b * SEQ + ka + 128 * kbo) * DM + g * 64 + l32;
        op[0] = (bf16_t)(pk2(Y0[q] * NORM, 0.f) & 0xffffu); op[32] = (bf16_t)(pk2(Y1[q] * NORM, 0.f) & 0xffffu);
    }
    __syncthreads();
}

__device__ __forceinline__ void f2b_unit(const float* Z2R, const float* Z2I, bf16_t* YBR, LAS unsigned char* lds, int b, int ka, int tid) {
    const int lane = tid & 63, w = __builtin_amdgcn_readfirstlane(tid >> 6), l32 = lane & 31, hi = lane >> 5;
    for (int i = tid; i < 64 * 64; i += 512) { const int kb = i >> 6, cc = i & 63; const float x = (float)((kb * cc) & 63) * (1.f / 64.f);
        *(LAS bf16_t*)(lds + kb * 144 + cc * 2) = (bf16_t)(pk2(__builtin_amdgcn_cosf(x), 0.f) & 0xffffu);
        *(LAS bf16_t*)(lds + 9216 + kb * 144 + cc * 2) = (bf16_t)(pk2(__builtin_amdgcn_sinf(x), 0.f) & 0xffffu); }
    const int g = w >> 1, nt = w & 1;
    LAS unsigned char* zt = lds + 18432 + w * 9216;
    const size_t base = ((size_t)(b * 128 + ka) * 4 + g) * 4096 + nt * 32;
    {
        const int cp = lane >> 3, m4 = lane & 7;
#pragma unroll
        for (int part = 0; part < 2; ++part) {
            const float* zp = (part ? Z2I : Z2R) + base + 4 * m4;
#pragma unroll
            for (int j = 0; j < 4; ++j) { const int c0 = 2 * cp + 16 * j;
                const f32x4 v0 = *(const f32x4*)(zp + (size_t)c0 * 64), v1 = *(const f32x4*)(zp + (size_t)(c0 + 1) * 64);
#pragma unroll
                for (int q = 0; q < 4; ++q) *(LAS unsigned*)(zt + part * 4608 + (4 * m4 + q) * 144 + c0 * 2) = pk2(v0[q], v1[q]); }
        }
    }
    __syncthreads();
    f32x16 Y0 = zero16(), Y1 = zero16();
#pragma unroll
    for (int ks = 0; ks < 4; ++ks) {
        const int ko = (ks * 16 + 8 * hi) * 2;
        const bf16x8 bR = *(const LAS bf16x8*)(zt + l32 * 144 + ko), bI = *(const LAS bf16x8*)(zt + 4608 + l32 * 144 + ko);
        const bf16x8 c0 = *(const LAS bf16x8*)(lds + l32 * 144 + ko), s0 = *(const LAS bf16x8*)(lds + 9216 + l32 * 144 + ko);
        const bf16x8 c1 = *(const LAS bf16x8*)(lds + (32 + l32) * 144 + ko), s1 = *(const LAS bf16x8*)(lds + 9216 + (32 + l32) * 144 + ko);
        Y0 = MFMA_BF(c0, bR, Y0); Y0 = MFMA_BF(s0, bI, Y0); Y1 = MFMA_BF(c1, bR, Y1); Y1 = MFMA_BF(s1, bI, Y1);
    }
    constexpr float NORM = 0.0013810679320049757f;
#pragma unroll
    for (int q = 0; q < 16; ++q) {
        const int kb0 = crow(q, hi); bf16_t* op = YBR + (size_t)(b * SEQ + ka + 128 * kb0) * DM + g * 64 + nt * 32 + l32;
        op[0] = (bf16_t)(pk2(Y0[q] * NORM, 0.f) & 0xffffu); op[(size_t)128 * 32 * DM] = (bf16_t)(pk2(Y1[q] * NORM, 0.f) & 0xffffu);
    }
    __syncthreads();
}

constexpr int FC_TF = 0, FC_TC = 18432, FC_TS = FC_TC + 32 * 528, FC_VT = FC_TS + 32 * 528;
__device__ __forceinline__ void fctxb_unit(const bf16_t* P, bf16_t* YBR, LAS unsigned char* lds, int b, int g, int kq, int tid) {
    const int lane = tid & 63, w = __builtin_amdgcn_readfirstlane(tid >> 6), l32 = lane & 31, hi = lane >> 5;
    for (int i = tid; i < 128 * 64; i += 512) { const int xx = i >> 6, j = i & 63; const float x = (float)((j * (xx & 63)) & 63) * (1.f / 64.f);
        const float v = (xx < 64) ? __builtin_amdgcn_cosf(x) : -__builtin_amdgcn_sinf(x);
        *(LAS bf16_t*)(lds + FC_TF + xx * 144 + j * 2) = (bf16_t)(pk2(v, 0.f) & 0xffffu); }
    for (int i = tid; i < 32 * 256; i += 512) { const int kk = i >> 8, t = i & 255; const float x = (float)(((kq * 32 + kk) * t) & 255) * (1.f / 256.f);
        *(LAS bf16_t*)(lds + FC_TC + kk * 528 + t * 2) = (bf16_t)(pk2(__builtin_amdgcn_cosf(x), 0.f) & 0xffffu);
        *(LAS bf16_t*)(lds + FC_TS + kk * 528 + t * 2) = (bf16_t)(pk2(__builtin_amdgcn_sinf(x), 0.f) & 0xffffu); }
    __syncthreads();
    {
        const int t = w * 32 + l32;
        const bf16_t* up = P + (size_t)(NLAT + b * LCTX + t) * IN_DIM + g * 64;
        f32x16 a[4] = {zero16(), zero16(), zero16(), zero16()};
#pragma unroll
        for (int ks = 0; ks < 4; ++ks) {
            const bf16x8 uf = *(const bf16x8*)(up + ks * 16 + 8 * hi);
#pragma unroll
            for (int xt = 0; xt < 4; ++xt) { const bf16x8 ff = *(const LAS bf16x8*)(lds + FC_TF + (xt * 32 + l32) * 144 + (ks * 16 + 8 * hi) * 2); a[xt] = MFMA_BF(uf, ff, a[xt]); }
        }
#pragma unroll
        for (int xt = 0; xt < 4; ++xt)
#pragma unroll
            for (int rg = 0; rg < 4; ++rg) { u32x2 v; v.x = pk2(a[xt][4 * rg], a[xt][4 * rg + 1]); v.y = pk2(a[xt][4 * rg + 2], a[xt][4 * rg + 3]);
                *(LAS u32x2*)(lds + FC_VT + (xt * 32 + l32) * 528 + (w * 32 + 8 * rg + 4 * hi) * 2) = v; }
    }
    __syncthreads();
    if (w < 2) {
        f32x16 Y = zero16();
#pragma unroll
        for (int ks = 0; ks < 16; ++ks) {
            const int ko = (ks * 16 + 8 * hi) * 2;
            const bf16x8 aC = *(const LAS bf16x8*)(lds + FC_TC + l32 * 528 + ko), aS = *(const LAS bf16x8*)(lds + FC_TS + l32 * 528 + ko);
            const bf16x8 bR = *(const LAS bf16x8*)(lds + FC_VT + (w * 32 + l32) * 528 + ko), bI = *(const LAS bf16x8*)(lds + FC_VT + (64 + w * 32 + l32) * 528 + ko);
            Y = MFMA_BF(aC, bR, Y); Y = MFMA_BF(aS, bI, Y);
        }
#pragma unroll
        for (int q = 0; q < 16; ++q) { const int ko = kq * 32 + crow(q, hi);
            YBR[(size_t)(NLAT + b * LCTX + ko) * DM + g * 64 + w * 32 + l32] = (bf16_t)(pk2(Y[q] * (1.f / 128.f), 0.f) & 0xffffu); }
    }
    __syncthreads();
}
__device__ __forceinline__ void fctx_unit(const bf16_t* P, bf16_t* YBR, LAS unsigned char* lds, int b, int g, int kq, int tid) {
    LAS float* V = (LAS float*)lds;
    LAS float* tab = (LAS float*)(lds + 256 * 132 * 4);
    const int lane = tid & 63, w = __builtin_amdgcn_readfirstlane(tid >> 6), l32 = lane & 31, hi = lane >> 5;
    if (tid < 64) { const float x = (float)tid * (1.f / 64.f); tab[tid] = __builtin_amdgcn_cosf(x); tab[64 + tid] = __builtin_amdgcn_sinf(x); }
    else if (tid < 320) { const int i = tid - 64; const float x = (float)i * (1.f / 256.f); tab[128 + i] = __builtin_amdgcn_cosf(x); tab[384 + i] = __builtin_amdgcn_sinf(x); }
    __syncthreads();
    {
        const int t = w * 32 + l32;
        const bf16_t* up = P + (size_t)(NLAT + b * LCTX + t) * IN_DIM + g * 64;
        u32x4 uq[8];
#pragma unroll
        for (int i = 0; i < 8; ++i) uq[i] = *(const u32x4*)(up + 8 * i);
        f32x16 a0 = zero16(), a1 = zero16(), a2 = zero16(), a3 = zero16();
#pragma unroll
        for (int s = 0; s < 32; ++s) {
            const unsigned wv = uq[s >> 2][s & 3]; const float a = hi ? bfhi(wv) : bflo(wv);
            const int j = 2 * s + hi, i0 = (j * l32) & 63, i1 = (j * (32 + l32)) & 63;
            a0 = MFMA_F32(a, tab[i0], a0); a1 = MFMA_F32(a, tab[i1], a1); a2 = MFMA_F32(a, -tab[64 + i0], a2); a3 = MFMA_F32(a, -tab[64 + i1], a3);
        }
#pragma unroll
        for (int q = 0; q < 16; ++q) { const int rr = w * 32 + crow(q, hi); LAS float* vp = V + rr * 132 + l32; vp[0] = a0[q]; vp[32] = a1[q]; vp[64] = a2[q]; vp[96] = a3[q]; }
    }
    __syncthreads();
    {
        const int mt = w >> 1, nt = w & 1, k = kq * 128 + mt * 32 + l32;
        f32x16 Y = zero16();
#pragma unroll 4
        for (int s = 0; s < 128; ++s) {
            const int t = 2 * s + hi, idx = (k * t) & 255;
            const float aC = tab[128 + idx], aS = tab[384 + idx];
            const float bR = V[t * 132 + nt * 32 + l32], bI = V[t * 132 + 64 + nt * 32 + l32];
            Y = MFMA_F32(aC, bR, Y); Y = MFMA_F32(aS, bI, Y);
        }
#pragma unroll
        for (int q = 0; q < 16; ++q) { const int ko = kq * 128 + mt * 32 + crow(q, hi);
            YBR[(size_t)(NLAT + b * LCTX + ko) * DM + g * 64 + nt * 32 + l32] = (bf16_t)(pk2(Y[q] * (1.f / 128.f), 0.f) & 0xffffu); }
    }
    __syncthreads();
}
__device__ __forceinline__ bf16x8 mk8(u32x2 lo, u32x2 hi) { u32x4 t = {lo.x, lo.y, hi.x, hi.y}; return __builtin_bit_cast(bf16x8, t); }
__device__ __forceinline__ float ssq8(bf16x8 v) { const u32x4 t = __builtin_bit_cast(u32x4, v); float s = 0.f;
#pragma unroll
    for (int i = 0; i < 4; ++i) s += bflo(t[i]) * bflo(t[i]) + bfhi(t[i]) * bfhi(t[i]);
    return s; }
__device__ __forceinline__ bf16x8 packp(const f32x16& p, int j) { u32x4 t = {pk2(p[8 * j], p[8 * j + 1]), pk2(p[8 * j + 2], p[8 * j + 3]), pk2(p[8 * j + 4], p[8 * j + 5]), pk2(p[8 * j + 6], p[8 * j + 7])}; return __builtin_bit_cast(bf16x8, t); }

constexpr int DA_KSTR = 144, DA_TILE = 64 * DA_KSTR;
__device__ __forceinline__ float sum16(const f32x16& S) {
    float a, b;
    asm("s_nop 0\n\tv_add_f32 %0, %2, %3\n\tv_add_f32 %1, %4, %5\n\tv_add_f32 %0, %0, %6\n\tv_add_f32 %1, %1, %7\n\tv_add_f32 %0, %0, %8\n\tv_add_f32 %1, %1, %9\n\t"
        "v_add_f32 %0, %0, %10\n\tv_add_f32 %1, %1, %11\n\tv_add_f32 %0, %0, %12\n\tv_add_f32 %1, %1, %13\n\tv_add_f32 %0, %0, %14\n\tv_add_f32 %1, %1, %15\n\t"
        "v_add_f32 %0, %0, %16\n\tv_add_f32 %1, %1, %17\n\tv_add_f32 %0, %0, %1"
        : "=&v"(a), "=&v"(b)
        : "v"(S[0]), "v"(S[1]), "v"(S[2]), "v"(S[3]), "v"(S[4]), "v"(S[5]), "v"(S[6]), "v"(S[7]), "v"(S[8]), "v"(S[9]), "v"(S[10]), "v"(S[11]), "v"(S[12]), "v"(S[13]), "v"(S[14]), "v"(S[15]));
    return a;
}
constexpr int DA_KT = 128 * DA_KSTR, DA_VSTR = 272, DA_VT = 64 * DA_VSTR;
template <bool FAST>
__device__ __forceinline__ void diff_loop(const bf16_t* P, const bf16_t* vsrc, LAS unsigned char* Kl, LAS unsigned char* Vl, const bf16x8 (&qf)[2][2], const float (&nb)[2],
                                          f32x16 (&O)[2][2], float (&ls)[2], int b, int h, int kt0, int kt1, int sr, int sg, int l32, int hi) {
#define DA_PV(Vbuf, koff) do { _Pragma("unroll") for (int t = 0; t < 2; ++t) _Pragma("unroll") for (int j = 0; j < 2; ++j) { \
        const LAS unsigned char* vp = (Vbuf) + (t * 32 + l32) * DA_VSTR + ((koff) + 16 * j + 4 * hi) * 2; \
        const bf16x8 vf = mk8(*(const LAS u32x2*)vp, *(const LAS u32x2*)(vp + 16)); \
        O[0][t] = MFMA_BF(vf, pb[0][j], O[0][t]); O[1][t] = MFMA_BF(vf, pb[1][j], O[1][t]); } } while (0)
#define DA_LOADK(T) do { const int key0 = (T) * 128; \
        st[0] = *(const u32x4*)(P + (size_t)key_row(b, key0 + sr) * IN_DIM + 2048 + h * 64 + sg * 8); st[1] = *(const u32x4*)(P + (size_t)key_row(b, key0 + 64 + sr) * IN_DIM + 2048 + h * 64 + sg * 8); } while (0)
#define DA_LOADV(T) do { const int key0 = (T) * 128; st[0] = *(const u32x4*)(vsrc + key0); st[1] = *(const u32x4*)(vsrc + key0 + 64); } while (0)
#define DA_STOREK(Kdst) do { *(LAS u32x4*)((Kdst) + sr * DA_KSTR + sg * 16) = st[0]; *(LAS u32x4*)((Kdst) + (64 + sr) * DA_KSTR + sg * 16) = st[1]; } while (0)
#define DA_STOREV(Vdst) do { *(LAS u32x4*)((Vdst) + sr * DA_VSTR + sg * 16) = st[0]; *(LAS u32x4*)((Vdst) + sr * DA_VSTR + 128 + sg * 16) = st[1]; } while (0)
    const int T0 = kt0 >> 1, T1 = kt1 >> 1;
    u32x4 st[2];
    DA_LOADK(T0); DA_STOREK(Kl); DA_LOADV(T0); DA_STOREV(Vl);
    __syncthreads();
    bf16x8 pb[2][2];
    int vc = 0, vp_ = 2 * DA_VT, vn = DA_VT;
    for (int T = T0; T < T1; ++T) {
        const int buf = (T - T0) & 1;
        if (T + 1 < T1) DA_LOADK(T + 1);
        const LAS unsigned char* Kb = Kl + buf * DA_KT;
#pragma unroll
        for (int kb = 0; kb < 4; ++kb) {
            f32x16 S[2];
#pragma unroll
            for (int mp = 0; mp < 2; ++mp) {
                if (FAST) S[mp] = zero16();
                else {
#pragma unroll
                    for (int i = 0; i < 16; ++i) S[mp][i] = nb[mp];
                }
#pragma unroll
                for (int ks = 0; ks < 2; ++ks) { const bf16x8 kf = *(const LAS bf16x8*)(Kb + (kb * 32 + l32) * DA_KSTR + (mp * 32 + ks * 16 + 8 * hi) * 2); S[mp] = MFMA_BF(kf, qf[mp][ks], S[mp]); }
            }
            if (kb > 0) DA_PV(Vl + vc, (kb - 1) * 32);
            else if (T != T0) DA_PV(Vl + vp_, 96);
#pragma unroll
            for (int mp = 0; mp < 2; ++mp) {
#pragma unroll
                for (int i = 0; i < 16; ++i) S[mp][i] = ex2(S[mp][i]);
                ls[mp] += sum16(S[mp]);
            }
#pragma unroll
            for (int mp = 0; mp < 2; ++mp) { pb[mp][0] = packp(S[mp], 0); pb[mp][1] = packp(S[mp], 1); }
            if (kb == 1 && T + 1 < T1) { DA_STOREK(Kl + (buf ^ 1) * DA_KT); DA_LOADV(T + 1); }
        }
        if (T + 1 < T1) DA_STOREV(Vl + vn);
        { const int t_ = vp_; vp_ = vc; vc = vn; vn = t_; }
        __syncthreads();
    }
    DA_PV(Vl + vp_, 96);
    __syncthreads();
#undef DA_PV
#undef DA_LOADK
#undef DA_LOADV
#undef DA_STOREK
#undef DA_STOREV
}
template <bool ALLOW_FAST>
__device__ __forceinline__ void diff_unit(const bf16_t* P, const bf16_t* VTD, bf16_t* YBR, const float* subg, float lam, float lam_init, const unsigned* kmax,
                                          LAS unsigned char* lds, int b, int h, int qrow0, int kt0, int kt1, int tid) {
    const int lane = tid & 63, w = __builtin_amdgcn_readfirstlane(tid >> 6), l32 = lane & 31, hi = lane >> 5;
    LAS unsigned char* Kl = lds; LAS unsigned char* Vl = lds + 2 * DA_KT;
    const int qrow = qrow0 + 32 * w + l32;
    bf16x8 qf[2][2];
#pragma unroll
    for (int mp = 0; mp < 2; ++mp)
#pragma unroll
        for (int ks = 0; ks < 2; ++ks) qf[mp][ks] = *(const bf16x8*)(P + (size_t)qrow * IN_DIM + 1792 + h * 64 + mp * 32 + ks * 16 + 8 * hi);
    float nb[2];
#pragma unroll
    for (int mp = 0; mp < 2; ++mp) { float s = ssq8(qf[mp][0]) + ssq8(qf[mp][1]); s += sx(s, 32, lane);
        nb[mp] = -(__builtin_sqrtf(s * __uint_as_float(kmax[b * 8 + h * 2 + mp])) * 1.0002f + 0.01f); }
    f32x16 O[2][2]; float ls[2] = {0.f, 0.f};
#pragma unroll
    for (int mp = 0; mp < 2; ++mp)
#pragma unroll
        for (int t = 0; t < 2; ++t) O[mp][t] = zero16();
    const int sr = tid >> 3, sg = tid & 7;
    const bf16_t* vsrc = VTD + ((size_t)(b * 4 + h) * 64 + sr) * NKEY + sg * 8;
    if (ALLOW_FAST && __all(nb[0] > -64.f && nb[1] > -64.f)) diff_loop<true>(P, vsrc, Kl, Vl, qf, nb, O, ls, b, h, kt0, kt1, sr, sg, l32, hi);
    else diff_loop<false>(P, vsrc, Kl, Vl, qf, nb, O, ls, b, h, kt0, kt1, sr, sg, l32, hi);
    ls[0] += sx(ls[0], 32, lane); ls[1] += sx(ls[1], 32, lane);
    const float i0 = 1.0f / ls[0], i1 = lam / ls[1];
    float ss = 0.f;
#pragma unroll
    for (int t = 0; t < 2; ++t)
#pragma unroll
        for (int i = 0; i < 16; ++i) { const float o = O[0][t][i] * i0 - O[1][t][i] * i1; O[0][t][i] = o; ss += o * o; }
    ss += sx(ss, 32, lane);
    const float rs = __builtin_amdgcn_rsqf(ss * (1.f / 64.f) + EPS) * (1.0f - lam_init);
    bf16_t* op = YBR + (size_t)qrow * DM + 768 + h * 64;
#pragma unroll
    for (int t = 0; t < 2; ++t)
#pragma unroll
        for (int rg = 0; rg < 4; ++rg) { const int d0 = t * 32 + 8 * rg + 4 * hi; const f32x4 gg = *(const f32x4*)(subg + d0);
            u32x2 wv; wv.x = pk2(O[0][t][4 * rg] * rs * gg.x, O[0][t][4 * rg + 1] * rs * gg.y); wv.y = pk2(O[0][t][4 * rg + 2] * rs * gg.z, O[0][t][4 * rg + 3] * rs * gg.w);
            *(u32x2*)(op + d0) = wv; }
}

constexpr int NA_KSTR = 528, NA_KT = 32 * NA_KSTR, NA_VSTR = 80, NA_VT = 256 * NA_VSTR, NA_BIAS_OFF = 2 * NA_KT + 2 * NA_VT;
__device__ __forceinline__ void na_unit(const bf16_t* P, const bf16_t* VTB, bf16_t* YBR, const float* relb  , const unsigned* kmax,
                                        LAS unsigned char* lds, int b, int r, int qrow0, int nwin, int tid) {
    const int lane = tid & 63, w = __builtin_amdgcn_readfirstlane(tid >> 6), l32 = lane & 31, hi = lane >> 5;
    const int h = w >> 1, qb = w & 1;
    LAS unsigned char* Kl = lds; LAS unsigned char* Vl = lds + 2 * NA_KT; LAS float* bl = (LAS float*)(lds + NA_BIAS_OFF);
    const int R0 = min(max(r - 4, 0), 120);
    for (int i = tid; i < 4 * 15 * 32; i += 512) { const int hd = i >> 5, dc = i & 31; bl[i] = (dc < 31) ? relb[hd * 31 + dc] * LOG2E : -1e30f; }
    const int qrow = qrow0 + 32 * qb + l32, qc = 32 * qb + l32;
    bf16x8 qf[4];
#pragma unroll
    for (int ks = 0; ks < 4; ++ks) qf[ks] = *(const bf16x8*)(P + (size_t)qrow * IN_DIM + 256 + h * 64 + ks * 16 + 8 * hi);
    __syncthreads();
    float mb = 0.f;
    if (nwin) { for (int i = lane; i < 465; i += 64) mb = fmaxf(mb, fabsf(relb[h * 465 + i]) * LOG2E);
#pragma unroll
        for (int o = 1; o < 64; o <<= 1) mb = fmaxf(mb, sx(mb, o, lane)); }
    float nb; { float s = ssq8(qf[0]) + ssq8(qf[1]) + ssq8(qf[2]) + ssq8(qf[3]); s += sx(s, 32, lane);
        nb = -(__builtin_sqrtf(s * __uint_as_float(kmax[16 + b * 4 + h])) * 1.0002f + mb + 0.01f); }
    f32x16 O[2] = {zero16(), zero16()}; float ls = 0.f;
    const int ntile = nwin + 8;
    u32x4 kreg[2], vreg[2];
#define NA_LOAD(tile) do { int krow0, vkey0; if ((tile) < nwin) { const int kr = R0 + ((tile) >> 1); vkey0 = kr * 64 + 32 * ((tile) & 1); krow0 = b * SEQ + vkey0; } \
        else { const int j_ = (tile) - nwin; vkey0 = SEQ + 32 * j_; krow0 = NLAT + b * LCTX + 32 * j_; } \
        _Pragma("unroll") for (int j = 0; j < 2; ++j) { const int pid = tid + 512 * j; \
            kreg[j] = *(const u32x4*)(P + (size_t)(krow0 + (pid >> 5)) * IN_DIM + 512 + (pid & 31) * 8); \
            const int rowhd = pid >> 2; vreg[j] = *(const u32x4*)(VTB + ((size_t)(b * 4 + (rowhd >> 6)) * 64 + (rowhd & 63)) * NKEY + vkey0 + (pid & 3) * 8); } } while (0)
#define NA_STORE(buf) do { _Pragma("unroll") for (int j = 0; j < 2; ++j) { const int pid = tid + 512 * j; \
            *(LAS u32x4*)(Kl + (buf) * NA_KT + (pid >> 5) * NA_KSTR + (pid & 31) * 16) = kreg[j]; \
            *(LAS u32x4*)(Vl + (buf) * NA_VT + (pid >> 2) * NA_VSTR + (pid & 3) * 16) = vreg[j]; } } while (0)
    NA_LOAD(0); NA_STORE(0);
    __syncthreads();
    const int col_lo = min(max(qc - 8, 0), 48);
    int boff[2][16];
#pragma unroll
    for (int hf = 0; hf < 2; ++hf)
#pragma unroll
        for (int i = 0; i < 16; ++i) { const int kc = 32 * hf + crow(i, hi); const bool ok = (kc >= col_lo) && (kc < col_lo + 16); boff[hf][i] = 4 * (ok ? (kc - qc + 15) : 31); }
    for (int tile0 = 0; tile0 < ntile; tile0 += 2) {
#pragma unroll
    for (int tb = 0; tb < 2; ++tb) {
        const int tile = tile0 + tb, buf = tb;
        if (tile + 1 < ntile) NA_LOAD(tile + 1);
        const LAS unsigned char* Kb = Kl + buf * NA_KT; const LAS unsigned char* Vb = Vl + buf * NA_VT;
        f32x16 S;
#pragma unroll
        for (int i = 0; i < 16; ++i) S[i] = nb;
#pragma unroll
        for (int ks = 0; ks < 4; ++ks) { const bf16x8 kf = *(const LAS bf16x8*)(Kb + l32 * NA_KSTR + (h * 64 + ks * 16 + 8 * hi) * 2); S = MFMA_BF(kf, qf[ks], S); }
        float ps = 0.f;
        if (tile < nwin) {
            const int kr = R0 + (tile >> 1);
            const LAS unsigned char* bp = (const LAS unsigned char*)(bl + (h * 15 + (kr - r + 7)) * 32);
#pragma unroll
            for (int i = 0; i < 16; ++i) { const float bv = *(const LAS float*)(bp + boff[tb][i]); S[i] = ex2(S[i] + bv); ps += S[i]; }
        } else {
#pragma unroll
            for (int i = 0; i < 16; ++i) { S[i] = ex2(S[i]); ps += S[i]; }
        }
        ls += ps;
        const bf16x8 p0 = packp(S, 0), p1 = packp(S, 1);
#pragma unroll
        for (int t = 0; t < 2; ++t) {
            const LAS unsigned char* vp = Vb + (h * 64 + t * 32 + l32) * NA_VSTR + (4 * hi) * 2;
            const bf16x8 v0 = mk8(*(const LAS u32x2*)vp, *(const LAS u32x2*)(vp + 16)), v1 = mk8(*(const LAS u32x2*)(vp + 32), *(const LAS u32x2*)(vp + 48));
            O[t] = MFMA_BF(v0, p0, O[t]); O[t] = MFMA_BF(v1, p1, O[t]);
        }
        if (tile + 1 < ntile) NA_STORE(buf ^ 1);
        __syncthreads();
    }
    }
#undef NA_LOAD
#undef NA_STORE
    ls += sx(ls, 32, lane);
    const float il = 1.0f / ls;
    bf16_t* op = YBR + (size_t)qrow * DM + 256 + h * 64;
#pragma unroll
    for (int t = 0; t < 2; ++t)
#pragma unroll
        for (int rg = 0; rg < 4; ++rg) { const int d0 = t * 32 + 8 * rg + 4 * hi;
            u32x2 wv; wv.x = pk2(O[t][4 * rg] * il, O[t][4 * rg + 1] * il); wv.y = pk2(O[t][4 * rg + 2] * il, O[t][4 * rg + 3] * il);
            *(u32x2*)(op + d0) = wv; }
}
constexpr int MO_META = 2048, MO_XSTR = 144, MO_XT = 128 * MO_XSTR, MO_ASTR = 528, MO_WT_OFF = MO_META + 2 * MO_XT, MO_ACT_OFF = MO_WT_OFF + 8 * 4096;
__device__ __forceinline__ void moe_wt_store(LAS unsigned char* wt, const f32x4 (&f)[4], int kq, int n4) {
#pragma unroll
    for (int c = 0; c < 4; ++c) { u32x2 d; d.x = pk2(f[0][c], f[1][c]); d.y = pk2(f[2][c], f[3][c]);
        *(LAS u32x2*)(wt + (4 * n4 + c) * 64 + (((kq >> 1) ^ (n4 & 3)) << 4) + ((kq & 1) << 3)) = d; }
}
__device__ __forceinline__ bf16x8 moe_wt_frag(const LAS unsigned char* wt, int n, int gi) { return *(const LAS bf16x8*)(wt + n * 64 + ((gi ^ ((n >> 2) & 3)) << 4)); }
constexpr int MO_ROWS = 128, MO_D = 1, MO_D2 = 2;
template <int NMT>
__device__ __forceinline__ void moe_unit(const float* __restrict__ Wg, const float* __restrict__ Wu, const float* __restrict__ Wd, const bf16_t* __restrict__ H2, bf16_t* YS,
                                         LAS unsigned char* lds, int nrows, int tid) {
    const int lane = tid & 63, w = __builtin_amdgcn_readfirstlane(tid >> 6), l32 = lane & 31, hi = lane >> 5, kq = lane >> 3, n4 = lane & 7;
    LAS int* rtok = (LAS int*)lds; LAS int* rslot = rtok + 128; LAS float* rw = (LAS float*)(rslot + 128);
    LAS unsigned char* Xl = lds + MO_META; LAS unsigned char* Al = lds + MO_ACT_OFF; LAS unsigned char* wt = lds + MO_WT_OFF + w * 4096;
    VM_WAIT();
    {
        f32x16 ag[NMT], au[NMT];
#pragma unroll
        for (int m = 0; m < NMT; ++m) { ag[m] = zero16(); au[m] = zero16(); }
        const int n0 = 32 * w;
        const unsigned woff = (unsigned)((4 * kq) * EDIM + n0 + 4 * n4);
#define GP4(k, j) (*(const f32x4*)(Wg + (size_t)((k) + (j)) * EDIM + woff))
#define UP4(k, j) (*(const f32x4*)(Wu + (size_t)((k) + (j)) * EDIM + woff))
        const int xr0 = tid >> 3, xr1 = (tid + 512) >> 3, xs = tid & 7;
        const bf16_t* xp0 = H2 + (size_t)max(rtok[xr0], 0) * DM + xs * 8; const bf16_t* xp1 = H2 + (size_t)max(rtok[xr1], 0) * DM + xs * 8;
        u32x4 xa = *(const u32x4*)xp0, xb = xa; if (NMT > 2) xb = *(const u32x4*)xp1;
        *(LAS u32x4*)(Xl + xr0 * MO_XSTR + xs * 16) = xa; if (NMT > 2) *(LAS u32x4*)(Xl + xr1 * MO_XSTR + xs * 16) = xb;
        f32x4 fg[MO_D][4], fu[MO_D][4];
#pragma unroll
        for (int h = 0; h < MO_D; ++h)
#pragma unroll
            for (int j = 0; j < 4; ++j) { fg[h][j] = GP4(h * 32, j); fu[h][j] = UP4(h * 32, j); }
        __syncthreads();
        for (int kc = 0; kc < 16; ++kc) {
            const int buf = kc & 1;
            if (kc + 1 < 16) { xa = *(const u32x4*)(xp0 + (kc + 1) * 64); if (NMT > 2) xb = *(const u32x4*)(xp1 + (kc + 1) * 64); }
#pragma unroll
            for (int hf = 0; hf < 2; ++hf) {
                moe_wt_store(wt, fg[hf % MO_D], kq, n4); moe_wt_store(wt + 2048, fu[hf % MO_D], kq, n4);
                __builtin_amdgcn_sched_barrier(0);
                const int knext = kc * 64 + (hf + MO_D) * 32;
                if (knext < DM) {
#pragma unroll
                    for (int j = 0; j < 4; ++j) { fg[hf % MO_D][j] = GP4(knext, j); fu[hf % MO_D][j] = UP4(knext, j); }
                }
                __builtin_amdgcn_sched_barrier(0);
#pragma unroll
                for (int ks = 0; ks < 2; ++ks) {
                    const bf16x8 wgf = moe_wt_frag(wt, l32, 2 * ks + hi), wuf = moe_wt_frag(wt + 2048, l32, 2 * ks + hi);
#pragma unroll
                    for (int m = 0; m < NMT; ++m) {
                        const bf16x8 xf = *(const LAS bf16x8*)(Xl + buf * MO_XT + (m * 32 + l32) * MO_XSTR + (hf * 32 + ks * 16 + 8 * hi) * 2);
                        ag[m] = MFMA_BF(wgf, xf, ag[m]); au[m] = MFMA_BF(wuf, xf, au[m]);
                    }
                }
                __builtin_amdgcn_sched_barrier(0);
            }
            if (kc + 1 < 16) { *(LAS u32x4*)(Xl + (buf ^ 1) * MO_XT + xr0 * MO_XSTR + xs * 16) = xa; if (NMT > 2) *(LAS u32x4*)(Xl + (buf ^ 1) * MO_XT + xr1 * MO_XSTR + xs * 16) = xb; }
            __syncthreads();
        }
#pragma unroll
        for (int m = 0; m < NMT; ++m) {
#pragma unroll
            for (int rg = 0; rg < 4; ++rg) {
                float a[4];
#pragma unroll
                for (int i = 0; i < 4; ++i) { const float g = ag[m][4 * rg + i]; a[i] = g * __builtin_amdgcn_rcpf(1.0f + ex2(-g * LOG2E)) * au[m][4 * rg + i]; }
                u32x2 wv; wv.x = pk2(a[0], a[1]); wv.y = pk2(a[2], a[3]);
                *(LAS u32x2*)(Al + (m * 32 + l32) * MO_ASTR + (n0 + 8 * rg + 4 * hi) * 2) = wv;
            }
        }
#undef GP4
#undef UP4
    }
    __syncthreads();
#pragma unroll 1
    for (int pass = 0; pass < 2; ++pass) {
        const int c0 = 128 * w + 64 * pass;
        VM_WAIT();
        f32x16 ac[2][NMT];
#pragma unroll
        for (int n = 0; n < 2; ++n)
#pragma unroll
            for (int m = 0; m < NMT; ++m) ac[n][m] = zero16();
        const unsigned doff = (unsigned)((4 * kq) * DM + c0 + 4 * n4);
#define DP4(k, j, n) (*(const f32x4*)(Wd + (size_t)((k) + (j)) * DM + (n) * 32 + doff))
        f32x4 f0[MO_D2][4], f1[MO_D2][4];
#pragma unroll
        for (int h = 0; h < MO_D2; ++h)
#pragma unroll
            for (int j = 0; j < 4; ++j) { f0[h][j] = DP4(h * 32, j, 0); f1[h][j] = DP4(h * 32, j, 1); }
#pragma unroll
        for (int kh = 0; kh < 8; ++kh) {
            moe_wt_store(wt, f0[kh % MO_D2], kq, n4); moe_wt_store(wt + 2048, f1[kh % MO_D2], kq, n4);
            __builtin_amdgcn_sched_barrier(0);
            if (kh + MO_D2 < 8) {
#pragma unroll
                for (int j = 0; j < 4; ++j) { f0[kh % MO_D2][j] = DP4((kh + MO_D2) * 32, j, 0); f1[kh % MO_D2][j] = DP4((kh + MO_D2) * 32, j, 1); }
            }
            __builtin_amdgcn_sched_barrier(0);
#pragma unroll
            for (int ks = 0; ks < 2; ++ks) {
                const bf16x8 w0 = moe_wt_frag(wt, l32, 2 * ks + hi), w1 = moe_wt_frag(wt + 2048, l32, 2 * ks + hi);
#pragma unroll
                for (int m = 0; m < NMT; ++m) {
                    const bf16x8 af = *(const LAS bf16x8*)(Al + (m * 32 + l32) * MO_ASTR + (kh * 32 + ks * 16 + 8 * hi) * 2);
                    ac[0][m] = MFMA_BF(w0, af, ac[0][m]); ac[1][m] = MFMA_BF(w1, af, ac[1][m]);
                }
            }
            __builtin_amdgcn_sched_barrier(0);
        }
#undef DP4
        int ln2 = lane; asm volatile("" : "+v"(ln2));
        const int l32e = ln2 & 31, hie = ln2 >> 5;
#pragma unroll
        for (int m = 0; m < NMT; ++m) {
            const float wt_ = rw[m * 32 + l32e];
#pragma unroll
            for (int n = 0; n < 2; ++n)
#pragma unroll
                for (int rg = 0; rg < 4; ++rg) { u32x2 wv; wv.x = pk2(ac[n][m][4 * rg] * wt_, ac[n][m][4 * rg + 1] * wt_); wv.y = pk2(ac[n][m][4 * rg + 2] * wt_, ac[n][m][4 * rg + 3] * wt_);
                    *(LAS u32x2*)(wt + l32e * 128 + (((n * 4 + rg) ^ (l32e & 7)) << 4) + hie * 8) = wv; }
#pragma unroll
            for (int jj = 0; jj < 4; ++jj) { const int rl = (ln2 >> 3) + 8 * jj, sg_ = ln2 & 7, grow = m * 32 + rl;
                const u32x4 v = *(const LAS u32x4*)(wt + rl * 128 + ((sg_ ^ (rl & 7)) << 4));
                if (grow < nrows) *(u32x4*)(YS + (size_t)rslot[grow] * DM + c0 + sg_ * 8) = v; }
        }
    }
    __syncthreads();
}

__device__ __forceinline__ void route_token(const float* logits, const float* rbias, int tok, unsigned* ecnt, int* lists, float* topw, int lane) {
    const f32x4 lg = *(const f32x4*)(logits + (size_t)tok * NEXP + 4 * lane);
    const f32x4 bs = *(const f32x4*)(rbias + 4 * lane);
    float sc[4], sel[4];
#pragma unroll
    for (int i = 0; i < 4; ++i) { sc[i] = 1.0f / (1.0f + __expf(-lg[i])); sel[i] = sc[i] + bs[i]; }
    float t1 = fmaxf(fmaxf(sel[0], sel[1]), fmaxf(sel[2], sel[3]));
    float t2; { const float a = fmaxf(sel[0], sel[1]), bq = fminf(sel[0], sel[1]), c = fmaxf(sel[2], sel[3]), d = fminf(sel[2], sel[3]); t2 = fmaxf(fminf(a, c), fmaxf(bq, d)); }
#pragma unroll
    for (int o = 1; o < 8; o <<= 1) { const float o1 = sx(t1, o, lane), o2 = sx(t2, o, lane); const float n1 = fmaxf(t1, o1); t2 = fmaxf(fminf(t1, o1), fmaxf(t2, o2)); t1 = n1; }
    const float gs = t1 + t2; const int grp = lane >> 3;
    int rank = 0;
#pragma unroll
    for (int j = 0; j < 8; ++j) { const float oj = shf(gs, 8 * j); rank += (oj > gs || (oj == gs && j < grp)) ? 1 : 0; }
    const bool gsel = rank < 4;
    float cand[4];
#pragma unroll
    for (int i = 0; i < 4; ++i) cand[i] = gsel ? sel[i] : -__builtin_inff();
    float wk[8]; int ek[8]; float wsum = 0.f;
#pragma unroll
    for (int k = 0; k < 8; ++k) {
        float bv = cand[0]; int bi = 0;
#pragma unroll
        for (int i = 1; i < 4; ++i) if (cand[i] > bv) { bv = cand[i]; bi = i; }
        int be = 4 * lane + bi;
#pragma unroll
        for (int o = 1; o < 64; o <<= 1) { const float ov = sx(bv, o, lane); const int oe = sxi(be, o, lane); if (ov > bv || (ov == bv && oe < be)) { bv = ov; be = oe; } }
        float s = 0.f;
#pragma unroll
        for (int i = 0; i < 4; ++i) if ((be & 3) == i) s = sc[i];
        s = shf(s, be >> 2);
        if ((be >> 2) == lane) {
#pragma unroll
            for (int i = 0; i < 4; ++i) if ((be & 3) == i) cand[i] = -__builtin_inff();
        }
        wk[k] = s; ek[k] = be; wsum += s;
    }
    const float inv = 2.5f / wsum;
    if (lane < 8) {
        float wv = 0.f; int e = 0;
#pragma unroll
        for (int k = 0; k < 8; ++k) if (lane == k) { wv = wk[k]; e = ek[k]; }
        const unsigned pos = atomicAdd(&ecnt[e], 1u);
        lists[(size_t)e * NTOK + pos] = tok * 8 + lane;
        topw[tok * 8 + lane] = wv * inv;
    }
}
constexpr int NTHREADS = 512, NWAVES = 8;
constexpr int LDS_BYTES = 147456;
constexpr int LDS_MISC = 147456 - 256;
constexpr int N_PHASES = 24;
struct Args { const float* in[25]; float* out; unsigned char* ws; int ph_lo, ph_hi; };

__global__ void __launch_bounds__(NTHREADS, 2) fwd_kernel(Args args) {
    extern __shared__ __attribute__((aligned(16))) unsigned char lds_raw[];
    LAS unsigned char* lds = (LAS unsigned char*)lds_raw;
    volatile LAS unsigned* MISC = (volatile LAS unsigned*)(lds + LDS_MISC);
    const int wave0 = __builtin_amdgcn_readfirstlane((int)threadIdx.x >> 6);
    const int G = gridDim.x, bx0 = blockIdx.x;
    const int NGW = G * NWAVES, GT = G * NTHREADS;
#define FRESH_TID(t) do { asm volatile("v_mbcnt_lo_u32_b32 %0, -1, 0\n\tv_mbcnt_hi_u32_b32 %0, -1, %0" : "=v"(t)); t += wave0 * 64; } while (0)
#define PHASE_BEGIN() LAUNDER(); int tid; FRESH_TID(tid); int bx = bx0; asm volatile("" : "+s"(bx)); \
    const int lane = tid & 63, wave = __builtin_amdgcn_readfirstlane(tid >> 6); const int gw = bx * NWAVES + wave, gtid = bx * NTHREADS + tid; \
    const int vcu = (G % 8 == 0) ? (bx % 8) * (G / 8) + bx / 8 : bx; (void)lane; (void)gw; (void)gtid; (void)vcu;
    typedef const __attribute__((address_space(1))) float* gfp_t;
    typedef __attribute__((address_space(1))) unsigned char* gws_t;
    typedef gfp_t __attribute__((address_space(4))) const* kargp_t;
    kargp_t kap = (kargp_t)__builtin_amdgcn_kernarg_segment_ptr();
    gws_t ws = (gws_t)kap[26];
    unsigned* ctl = (unsigned*)(ws + WS_CTL);
#define LAUNDER() asm volatile("" : "+s"(kap), "+s"(ws))
#define INP(k) ((const float*)kap[k])
#define in_x INP(0)
#define in_c INP(1)
#define in_ctx INP(2)
#define in_cctx INP(3)
#define ada_w INP(4)
#define ada_b INP(5)
#define norm1_g INP(6)
#define w_in INP(7)
#define conv_w INP(8)
#define na_rel_bias INP(9)
#define diff_lambda INP(10)
#define diff_subln_g INP(11)
#define w_branch_gate INP(12)
#define w_branch INP(13)
#define w_out INP(14)
#define norm2_g INP(15)
#define router_w INP(16)
#define router_bias INP(17)
#define e_wg INP(18)
#define e_wu INP(19)
#define e_wd INP(20)
#define s_wg INP(21)
#define s_wu INP(22)
#define s_wd INP(23)
#define final_g INP(24)
#define OUTP ((float*)kap[25])
#define MODS ((float*)(ws + WS_MODS))
#define LAM ((float*)(ws + WS_MODS + 512 * 1024))
#define Win_t ((bf16_t*)(ws + WS_WIN))
#define Wg_t ((bf16_t*)(ws + WS_WG))
#define Wb_t ((bf16_t*)(ws + WS_WB))
#define Wo_t ((bf16_t*)(ws + WS_WO))
#define Wr_t ((bf16_t*)(ws + WS_WR))
#define Wsgu_t ((bf16_t*)(ws + WS_WSGU))
#define Wsd_t ((bf16_t*)(ws + WS_WSD))
#define X ((bf16_t*)(ws + WS_X))
#define H ((bf16_t*)(ws + WS_H))
#define P ((bf16_t*)(ws + WS_P))
#define VTD ((bf16_t*)(ws + WS_VTD))
#define VTB ((bf16_t*)(ws + WS_VTB))
#define Z2R ((float*)(ws + WS_Z2R))
#define Z2I ((float*)(ws + WS_Z2I))
#define YBR ((bf16_t*)(ws + WS_YBR))
#define PB ((bf16_t*)(ws + WS_PB))
#define MACC ((bf16_t*)(ws + WS_MACC))
#define MRG ((bf16_t*)(ws + WS_MRG))
#define LOG ((float*)(ws + WS_LOG))
#define TOPW ((float*)(ws + WS_TOPW))
#define LIST ((int*)(ws + WS_LIST))
#define YS ((bf16_t*)(ws + WS_YS))
#define TCB ((float*)(ws + WS_TC))
    if (threadIdx.x < 64) MISC[threadIdx.x] = 0u;
    __syncthreads();
    const int lo = args.ph_lo, hi_ph = args.ph_hi;
    const bool multi = (hi_ph - lo) > 1;
    XcdBarrier bar; bar.bar = ctl + CW_BAR; bar.x = 0; bar.st = nullptr;
    if (multi) bar = xcd_barrier_post(ctl + CW_BAR, MISC + 8);
    if (multi && threadIdx.x == 0) MISC[16] = __hip_atomic_fetch_add(ctl + CW_RANK + 16 * bar.x, 1u, __ATOMIC_RELAXED, __HIP_MEMORY_SCOPE_AGENT);
    __syncthreads();
#ifndef PHMASK
#define PHMASK 0xFFFF
#endif
#define KIND(k) (((PHMASK) >> (k)) & 1)
#ifndef REPKIND
#define REPKIND -1
#endif
#ifndef REPN
#define REPN 1
#endif
#define NREP(k) (((k) == REPKIND) ? (1 + REPN) : 1)
#define IN(k) (lo <= (k) && (k) < hi_ph)
#define SEAM(k) do { if (IN(k) && IN((k) + 1)) xcd_barrier(bar); } while (0)

    for (int rep_ = 0; rep_ < NREP(0); ++rep_) if (KIND(0) && IN(0)) { if (rep_) { VM_WAIT(); __syncthreads(); } PHASE_BEGIN();
        LAS float* scr = (LAS float*)(lds + wave * 16384);
        for (int it = gw; it < 4864; it += NGW) {
            const int L = 0; int r = it;
            if (r < 1280) { transpose_item(w_in + (size_t)L * DM * IN_DIM, DM, IN_DIM, Win_t + (size_t)L * IN_DIM * DM, scr, r, lane); continue; } r -= 1280;
            if (r < 2048) { const int i = r >> 9; transpose_item(w_branch_gate + (size_t)(L * 4 + i) * DM * DM, DM, DM, Wg_t + (size_t)L * 4096 * DM, scr, r & 511, lane, 3 + i); continue; } r -= 2048;
            if (r < 512) { const int i = r >> 7; transpose_item(w_branch + (size_t)(L * 4 + i) * 256 * DM, 256, DM, Wb_t + (size_t)(L * 4 + i) * DM * 256, scr, r & 127, lane); continue; } r -= 512;
            if (r < 512) { transpose_item(w_out + (size_t)L * DM * DM, DM, DM, Wo_t + (size_t)L * DM * DM, scr, r, lane); continue; } r -= 512;
            if (r < 128) { transpose_item(router_w + (size_t)L * DM * NEXP, DM, NEXP, Wr_t + (size_t)L * NEXP * DM, scr, r, lane); continue; } r -= 128;
            if (r < 128) { transpose_item(s_wg + (size_t)L * DM * EDIM, DM, EDIM, Wsgu_t + (size_t)L * 512 * DM, scr, r, lane, 1); continue; } r -= 128;
            if (r < 128) { transpose_item(s_wu + (size_t)L * DM * EDIM, DM, EDIM, Wsgu_t + (size_t)L * 512 * DM, scr, r, lane, 2); continue; } r -= 128;
            transpose_item(s_wd + (size_t)L * EDIM * DM, EDIM, DM, Wsd_t + (size_t)L * DM * EDIM, scr, r, lane);
        }
        __syncthreads();
        {
            LAS float* sv = (LAS float*)lds;
            LAS float* part = sv + 3 * DM;
            for (int i = tid; i < 3 * DM; i += NTHREADS) { const int v = i >> 10, k = i & 1023; const float c = (v < 2) ? in_c[v * DM + k] : in_cctx[k]; sv[i] = c / (1.0f + __expf(-c)); }
            __syncthreads();
            for (int item = bx; item < 2 * 96; item += G) {
                const int L = item / 96, col = (item % 96) * 64 + lane;
                const float* wp = ada_w + (size_t)L * DM * 6 * DM + col;
                float a0 = 0.f, a1 = 0.f, a2 = 0.f;
#pragma unroll 32
                for (int k = wave * 128; k < wave * 128 + 128; ++k) { const float wv = wp[(size_t)k * 6 * DM]; a0 += sv[k] * wv; a1 += sv[DM + k] * wv; a2 += sv[2 * DM + k] * wv; }
                part[(wave * 3 + 0) * 64 + lane] = a0; part[(wave * 3 + 1) * 64 + lane] = a1; part[(wave * 3 + 2) * 64 + lane] = a2;
                __syncthreads();
                if (tid < 192) { const int v = tid >> 6, l = tid & 63; float s = ada_b[(size_t)L * 6 * DM + (item % 96) * 64 + l];
#pragma unroll
                    for (int q = 0; q < 8; ++q) s += part[(q * 3 + v) * 64 + l];
                    MODS[((size_t)L * 3 + v) * 6 * DM + (item % 96) * 64 + l] = s; }
                __syncthreads();
            }
        }
        if (bx == 0 && tid < 2) {
            const float* lp = diff_lambda + tid * 128; float s0 = 0.f, s1 = 0.f;
            for (int i = 0; i < 32; ++i) { s0 += lp[i] * lp[32 + i]; s1 += lp[64 + i] * lp[96 + i]; }
            const float li = tid ? 0.35550906759f : 0.2f;
            LAM[tid] = __expf(s0) - __expf(s1) + li;
        }
    }
    SEAM(0);

    for (int L = 0; L < 2; ++L) {
        const int pb = 1 + 10 * L - (L ? 1 : 0);
        const int P_NORM1 = 1, P_INPROJ = L ? 13 : 2, P_MIX1 = P_INPROJ + 1, P_MIX2 = P_INPROJ + 2, P_MERGE = P_INPROJ + 3, P_GATE = P_INPROJ + 4, P_WOUT = P_INPROJ + 5,
                  P_NORM2 = P_WOUT + 1, P_ROUTE = P_WOUT + 2, P_TOPK = P_WOUT + 3, P_MOE = P_WOUT + 4, P_COMB = P_WOUT + 5;
        (void)pb;
#define mods (MODS + (size_t)L * 3 * 6 * DM)
        const int ntok = L ? NLAT : NTOK;
        const float lam_init = L ? 0.35550906759f : 0.2f;
#define kmax (ctl + CW_KMAX + 32 * L)
#define ecnt (ctl + CW_ECNT + 256 * L)

        if (KIND(1) && L == 0 && IN(P_NORM1)) { PHASE_BEGIN();
            for (int row = gw; row < NTOK; row += NGW) {
                const float* xr = row < NLAT ? in_x + (size_t)row * DM : in_ctx + (size_t)(row - NLAT) * DM;
                const int vec = row < SEQ ? 0 : (row < NLAT ? 1 : 2);
                f32x4 v[4];
#pragma unroll
                for (int j = 0; j < 4; ++j) v[j] = *(const f32x4*)(xr + 4 * lane + 256 * j);
                norm_mod_row(v, norm1_g, mods + (vec * 6 + 0) * DM, mods + (vec * 6 + 1) * DM, H + (size_t)row * DM, lane);
            }
        }
        if (L == 0) SEAM(P_NORM1);

        for (int rep_ = 0; rep_ < NREP(2); ++rep_) if (KIND(2) && IN(P_INPROJ)) { if (rep_) { VM_WAIT(); __syncthreads(); } PHASE_BEGIN();
            pg8::Gemm g{H, Win_t + (size_t)L * IN_DIM * DM, DM, DM, DM}; pg8::StaticOrder S; S.init(NTOK, IN_DIM, G, bx);
            pg8::EpiInproj E{P};
            pg8::gemm_phase(lds, g, S, E, tid);
        }
        SEAM(P_INPROJ);

        for (int rep_ = 0; rep_ < NREP(3); ++rep_) if (KIND(3) && IN(P_MIX1)) { if (rep_) { VM_WAIT(); __syncthreads(); } PHASE_BEGIN();
            f1b_tables(lds, tid);
            for (int u = bx; u < 512; u += G) { const int b = u >> 8, c = (u >> 2) & 63, g = u & 3; f1b_unit(P, Z2R, Z2I, lds, b, c, g, tid); }
            FRESH_TID(tid);
            for (int u = bx; u < 2 * 132; u += G) kvprep_item(P, VTD, VTB, kmax, lds, u / 132, u % 132, tid);
            FRESH_TID(tid);
            if (L == 0) for (int u = G - 1 - bx; u < 64; u += G) fctxb_unit(P, YBR, lds, u >> 5, (u >> 3) & 3, u & 7, tid);
            conv_phase(P, conv_w + (size_t)L * 3 * 256, YBR, ntok, gtid, GT);
        }
        SEAM(P_MIX1);

        for (int rep_ = 0; rep_ < NREP(4); ++rep_) if (KIND(4) && IN(P_MIX2)) { if (rep_) { VM_WAIT(); __syncthreads(); } PHASE_BEGIN();
            const float lam = LAM[L];
            for (int u = vcu; u < 256; u += G) diff_unit<true>(P, VTD, YBR, diff_subln_g + L * 64, lam, lam_init, kmax, lds, u >> 7, (u >> 5) & 3, (u >> 7) * SEQ + (u & 31) * 256, 0, 132, tid);
            FRESH_TID(tid);
            for (int u = vcu; u < 256; u += G) { const int b = u >> 7, r = u & 127; na_unit(P, VTB, YBR, na_rel_bias + (size_t)L * 1860, kmax, lds, b, r, b * SEQ + r * 64, 16, tid); }
            FRESH_TID(tid);
            for (int u = bx; u < 256; u += G) f2b_unit(Z2R, Z2I, YBR, lds, u >> 7, u & 127, tid);
            if (L == 0) {
                FRESH_TID(tid);
                for (int u = G - 1 - bx; u < 8; u += G) diff_unit<false>(P, VTD, YBR, diff_subln_g, lam, lam_init, kmax, lds, u >> 2, u & 3, NLAT + (u >> 2) * LCTX, 128, 132, tid);
                FRESH_TID(tid);
                for (int u = G - 9 - bx; u >= 0 && u < 8; u += G) { const int b = u >> 2, cq = u & 3; na_unit(P, VTB, YBR, na_rel_bias, kmax, lds, b, 0, NLAT + b * LCTX + cq * 64, 0, tid); }
            }
        }
        SEAM(P_MIX2);

        if (KIND(5) && IN(P_MERGE)) { PHASE_BEGIN();
            if (L == 0) {
                pg8::Gemm g{YBR, Wb_t + (size_t)L * 4 * DM * 256, DM, 256, 256}; pg8::StaticOrder S; S.init(ntok, 4096, G, bx); S.aostep = 256; pg8::EpiBf16 E{PB, 4096};
                pg8::gemm_phase(lds, g, S, E, tid);
            } else {
                const int ncombo = (NLAT / 256) * 4;
                { pg8::Gemm g{YBR, Wb_t + (size_t)L * 4 * DM * 256, DM, 256, 256}; pg8::ComboOrder S{ncombo, G, vcu, 256, -1, 0}; pg8::EpiBf16 E{PB, 4096};
                  pg8::gemm_phase(lds, g, S, E, tid); }
                __syncthreads();
                FRESH_TID(tid);
                { pg8::Gemm g{H, Wg_t + (size_t)L * 4096 * DM, DM, DM, DM}; pg8::ComboGate S{ncombo, G, vcu}; pg8::EpiGate4 E{PB, MRG};
                  pg8::gemm_phase(lds, g, S, E, tid); }
            }
        }
        if (L == 0) SEAM(P_MERGE);

        for (int rep_ = 0; rep_ < NREP(5); ++rep_) if (L == 0 && KIND(5) && IN(P_GATE)) { if (rep_) { VM_WAIT(); __syncthreads(); } PHASE_BEGIN();
            const int xj = G - 1 - bx;
            pg8::ExtraOrder S; S.base.init(NLAT, 4096, G, bx); S.xpm = (L == 0 && xj < 32) ? 64 + (xj >> 4) : -1; S.xpn = xj & 15;
            pg8::Gemm g{H, Wg_t + (size_t)L * 4096 * DM, DM, DM, DM}; pg8::EpiGate4 E{PB, MRG};
            pg8::gemm_phase(lds, g, S, E, tid);
            const int nfree = (G > 32) ? G - 32 : G;
            if (bx < nfree) {
                __syncthreads();
                FRESH_TID(tid);
                const int lane = tid & 63, wave = __builtin_amdgcn_readfirstlane(tid >> 6);
                LAS float* scr = (LAS float*)(lds + wave * 16384);
                for (int it = bx * NWAVES + wave; it < 4864; it += nfree * NWAVES) {
                    const int L = 1; int r = it;
                    if (r < 1280) { transpose_item(w_in + (size_t)L * DM * IN_DIM, DM, IN_DIM, Win_t + (size_t)L * IN_DIM * DM, scr, r, lane); continue; } r -= 1280;
                    if (r < 2048) { const int i = r >> 9; transpose_item(w_branch_gate + (size_t)(L * 4 + i) * DM * DM, DM, DM, Wg_t + (size_t)L * 4096 * DM, scr, r & 511, lane, 3 + i); continue; } r -= 2048;
                    if (r < 512) { const int i = r >> 7; transpose_item(w_branch + (size_t)(L * 4 + i) * 256 * DM, 256, DM, Wb_t + (size_t)(L * 4 + i) * DM * 256, scr, r & 127, lane); continue; } r -= 512;
                    if (r < 512) { transpose_item(w_out + (size_t)L * DM * DM, DM, DM, Wo_t + (size_t)L * DM * DM, scr, r, lane); continue; } r -= 512;
                    if (r < 128) { transpose_item(router_w + (size_t)L * DM * NEXP, DM, NEXP, Wr_t + (size_t)L * NEXP * DM, scr, r, lane); continue; } r -= 128;
                    if (r < 128) { transpose_item(s_wg + (size_t)L * DM * EDIM, DM, EDIM, Wsgu_t + (size_t)L * 512 * DM, scr, r, lane, 1); continue; } r -= 128;
                    if (r < 128) { transpose_item(s_wu + (size_t)L * DM * EDIM, DM, EDIM, Wsgu_t + (size_t)L * 512 * DM, scr, r, lane, 2); continue; } r -= 128;
                    transpose_item(s_wd + (size_t)L * EDIM * DM, EDIM, DM, Wsd_t + (size_t)L * DM * EDIM, scr, r, lane);
                }
            }
        }
        SEAM(P_GATE);

        if (KIND(6) && IN(P_WOUT)) { PHASE_BEGIN();
            pg8::Gemm g{MRG, Wo_t + (size_t)L * DM * DM, DM, DM, DM}; pg8::StaticOrder S; S.init(ntok, DM, G, bx);
            if (L == 0) { pg8::EpiResid<true> E{in_x, in_ctx, X, mods}; pg8::gemm_phase(lds, g, S, E, tid); }
            else { pg8::EpiResid<false> E{nullptr, nullptr, X, mods}; pg8::gemm_phase(lds, g, S, E, tid); }
        }
        SEAM(P_WOUT);

        for (int rep_ = 0; rep_ < NREP(7); ++rep_) if (KIND(7) && IN(P_NORM2)) { if (rep_) { VM_WAIT(); __syncthreads(); } PHASE_BEGIN();
            for (int row = gw; row < ntok; row += NGW) {
                const int vec = row < SEQ ? 0 : (row < NLAT ? 1 : 2);
                f32x4 v[4];
#pragma unroll
                for (int j = 0; j < 4; ++j) { const u32x2 xb = *(const u32x2*)(X + (size_t)row * DM + 4 * lane + 256 * j); v[j] = (f32x4){bflo(xb.x), bfhi(xb.x), bflo(xb.y), bfhi(xb.y)}; }
                norm_mod_row(v, norm2_g + L * DM, mods + (vec * 6 + 3) * DM, mods + (vec * 6 + 4) * DM, H + (size_t)row * DM, lane);
            }
        }
        SEAM(P_NORM2);

        if (KIND(8) && IN(P_ROUTE)) { PHASE_BEGIN();
            const int nM = ntok / 256;
            { pg8::Gemm g{H, Wr_t + (size_t)L * NEXP * DM, DM, DM, DM}; pg8::PanelOrder S{nM, G, bx}; pg8::EpiF32 E{LOG, NEXP};
              pg8::gemm_phase(lds, g, S, E, tid); }
            __syncthreads();
            FRESH_TID(tid);
            { pg8::Gemm g{H, Wsgu_t + (size_t)L * 512 * DM, DM, DM, DM}; pg8::OffsetOrder S{nM, 2, G, bx, nM % G}; pg8::EpiSwiGLU E{MRG};
              pg8::gemm_phase(lds, g, S, E, tid); }
        }
        SEAM(P_ROUTE);

        if (KIND(8) && IN(P_TOPK)) { PHASE_BEGIN();
            for (int t = gw; t < ntok; t += NGW) route_token(LOG, router_bias + L * NEXP, t, ecnt, LIST, TOPW, lane);
        }
        SEAM(P_TOPK);

        for (int rep_ = 0; rep_ < NREP(9); ++rep_) if (KIND(9) && IN(P_MOE)) { if (rep_) { VM_WAIT(); __syncthreads(); } PHASE_BEGIN();
            LAS int* pref = (LAS int*)(lds + LDS_MISC - 2048);
            __syncthreads();
            if (tid < 256) pref[1 + tid] = (int)((__hip_atomic_load(&ecnt[tid], __ATOMIC_RELAXED, __HIP_MEMORY_SCOPE_AGENT) + (unsigned)(MO_ROWS - 1)) / (unsigned)MO_ROWS);
            if (tid == 0) pref[0] = 0;
            __syncthreads();
            if (tid == 0) { int s = 0; for (int e = 0; e < 256; ++e) { s += pref[1 + e]; pref[1 + e] = s; } }
            __syncthreads();
            const int total = pref[256];
            int xcu = vcu;
            if (multi) {
                int base = 0, tot = 0;
                for (int j = 0; j < 16; ++j) { const int cj = (int)xb_ld(ctl + CW_BAR + XB_XCNT(j)); base += (j < (int)bar.x) ? cj : 0; tot += cj; }
                if (tot == G) xcu = base + (int)MISC[16];
            }
            xcu = __builtin_amdgcn_readfirstlane(xcu);
            for (int uid = xcu; uid < total; uid += G) {
                int e = 0; { int a = 0, bq = 256; while (bq - a > 1) { const int m = (a + bq) >> 1; if (pref[m] <= uid) a = m; else bq = m; } e = a; }
                const int t = uid - pref[e], cnt = (int)__hip_atomic_load(&ecnt[e], __ATOMIC_RELAXED, __HIP_MEMORY_SCOPE_AGENT), r0 = t * MO_ROWS, nrows = min(MO_ROWS, cnt - r0);
                __syncthreads();
                if (tid < 128) { LAS int* rtok = (LAS int*)lds; int ent = (tid < nrows) ? LIST[(size_t)e * NTOK + r0 + tid] : -8;
                    rtok[tid] = ent >> 3; rtok[128 + tid] = (ent >> 3) * NSLOT + (ent & 7); ((LAS float*)lds)[256 + tid] = (tid < nrows) ? TOPW[ent] : 0.f; }
                __syncthreads();
                const size_t eo = (size_t)(L * NEXP + e);
                const int nm = __builtin_amdgcn_readfirstlane((nrows + 31) >> 5);
                if (nm == 4)      { int t4; FRESH_TID(t4); moe_unit<4>(e_wg + eo * DM * EDIM, e_wu + eo * DM * EDIM, e_wd + eo * EDIM * DM, H, YS, lds, nrows, t4); }
                else if (nm == 3) { int t3; FRESH_TID(t3); moe_unit<3>(e_wg + eo * DM * EDIM, e_wu + eo * DM * EDIM, e_wd + eo * EDIM * DM, H, YS, lds, nrows, t3); }
                else if (nm == 2) { int t2; FRESH_TID(t2); moe_unit<2>(e_wg + eo * DM * EDIM, e_wu + eo * DM * EDIM, e_wd + eo * EDIM * DM, H, YS, lds, nrows, t2); }
                else              { int t1; FRESH_TID(t1); moe_unit<1>(e_wg + eo * DM * EDIM, e_wu + eo * DM * EDIM, e_wd + eo * EDIM * DM, H, YS, lds, nrows, t1); }
            }
            {
                const int nlast = total % G, nidle = G - nlast;
                if (xcu >= nlast) {
                    __syncthreads();
                    FRESH_TID(tid);
                    pg8::Gemm g{MRG, Wsd_t + (size_t)L * DM * EDIM, EDIM, EDIM, EDIM}; pg8::StaticOrder S; S.init(ntok, DM, nidle, xcu - nlast); pg8::EpiSlot8 E{YS};
                    pg8::gemm_phase(lds, g, S, E, tid);
                }
            }
        }
        SEAM(P_MOE);

        if (KIND(10) && IN(P_COMB)) { PHASE_BEGIN();
            const float* mods1 = MODS + (size_t)3 * 6 * DM;
            for (int row = gw; row < ntok; row += NGW) {
                const int vec = row < SEQ ? 0 : (row < NLAT ? 1 : 2);
                float v[2][8];
#pragma unroll
                for (int j = 0; j < 2; ++j) {
                    const int c = 8 * lane + 512 * j;
                    float a[8] = {0.f, 0.f, 0.f, 0.f, 0.f, 0.f, 0.f, 0.f};
#pragma unroll
                    for (int k = 0; k < NSLOT; ++k) { const u32x4 y = __builtin_nontemporal_load((const u32x4*)(YS + ((size_t)row * NSLOT + k) * DM + c));
#pragma unroll
                        for (int i = 0; i < 4; ++i) { a[2 * i] += bflo(y[i]); a[2 * i + 1] += bfhi(y[i]); } }
                    const f32x4 g0 = *(const f32x4*)(mods + (vec * 6 + 5) * DM + c), g1 = *(const f32x4*)(mods + (vec * 6 + 5) * DM + c + 4);
                    const u32x4 xb = *(const u32x4*)(X + (size_t)row * DM + c);
                    const f32x4 x0 = (f32x4){bflo(xb.x), bfhi(xb.x), bflo(xb.y), bfhi(xb.y)}, x1 = (f32x4){bflo(xb.z), bfhi(xb.z), bflo(xb.w), bfhi(xb.w)};
#pragma unroll
                    for (int i = 0; i < 4; ++i) { v[j][i] = x0[i] + g0[i] * a[i]; v[j][4 + i] = x1[i] + g1[i] * a[4 + i]; }
                }
                float ss = 0.f;
#pragma unroll
                for (int j = 0; j < 2; ++j)
#pragma unroll
                    for (int i = 0; i < 8; ++i) ss += v[j][i] * v[j][i];
                const float rstd = __builtin_amdgcn_rsqf(wave_sum(ss, lane) * (1.f / DM) + EPS);
#pragma unroll
                for (int j = 0; j < 2; ++j) {
                    const int c = 8 * lane + 512 * j;
                    if (L == 0) {
                        { u32x4 xw; xw.x = pk2(v[j][0], v[j][1]); xw.y = pk2(v[j][2], v[j][3]); xw.z = pk2(v[j][4], v[j][5]); xw.w = pk2(v[j][6], v[j][7]); *(u32x4*)(X + (size_t)row * DM + c) = xw; }
                        const float* gp = norm1_g + DM + c; const float* shp = mods1 + (vec * 6 + 0) * DM + c; const float* scp = mods1 + (vec * 6 + 1) * DM + c;
                        float y[8];
#pragma unroll
                        for (int i = 0; i < 8; ++i) y[i] = v[j][i] * rstd * gp[i] * (scp[i] + 1.0f) + shp[i];
                        u32x4 w; w.x = pk2(y[0], y[1]); w.y = pk2(y[2], y[3]); w.z = pk2(y[4], y[5]); w.w = pk2(y[6], y[7]);
                        *(u32x4*)(H + (size_t)row * DM + c) = w;
                    } else {
                        const float* gp = final_g + c;
                        f32x4 o0, o1;
#pragma unroll
                        for (int i = 0; i < 4; ++i) { o0[i] = v[j][i] * rstd * gp[i]; o1[i] = v[j][4 + i] * rstd * gp[4 + i]; }
                        *(f32x4*)(OUTP + (size_t)row * DM + c) = o0; *(f32x4*)(OUTP + (size_t)row * DM + c + 4) = o1;
                    }
                }
            }
        }
        if (L == 0) SEAM(P_COMB);
    }
#undef IN
#undef SEAM
#undef KIND
}

extern "C" void kernel_launch(void* const* d_in, const int* in_sizes, int n_in, void* d_out, int out_size, void* d_ws, size_t ws_size, hipStream_t stream) {
    static int grid = 0;
    if (grid == 0) {
        if (n_in != 25 || in_sizes[0] != NLAT * DM || out_size != NLAT * DM || ws_size < WS_END) { fprintf(stderr, "kernel_launch: unexpected shapes (n_in %d, ws %zu)\n", n_in, ws_size); grid = -1; return; }
        int dev = 0, cus = 0, per_cu = 0;
        if (hipGetDevice(&dev) != hipSuccess || hipDeviceGetAttribute(&cus, hipDeviceAttributeMultiprocessorCount, dev) != hipSuccess) { grid = -1; return; }
        if (hipFuncSetAttribute((const void*)fwd_kernel, hipFuncAttributeMaxDynamicSharedMemorySize, LDS_BYTES) != hipSuccess) { fprintf(stderr, "kernel_launch: hipFuncSetAttribute failed\n"); grid = -1; return; }
        if (hipOccupancyMaxActiveBlocksPerMultiprocessor(&per_cu, (const void*)fwd_kernel, NTHREADS, LDS_BYTES) != hipSuccess || per_cu < 1) fprintf(stderr, "kernel_launch: occupancy query says %d\n", per_cu);
        (void)hipGetLastError();
        grid = cus;
    }
    if (grid < 0) return;
    (void)hipMemsetAsync((char*)d_ws + WS_CTL, 0, CTL_ZERO_BYTES, stream);
    Args a{};
    for (int i = 0; i < 25; ++i) a.in[i] = (const float*)d_in[i];
    a.out = (float*)d_out; a.ws = (unsigned char*)d_ws;
#ifndef MK_LAUNCHES
#define MK_LAUNCHES 1
#endif
    if (MK_LAUNCHES == 1) { a.ph_lo = 0; a.ph_hi = N_PHASES; hipLaunchKernelGGL(fwd_kernel, dim3(grid), dim3(NTHREADS), LDS_BYTES, stream, a); }
    else for (int p = 0; p < N_PHASES; ++p) { a.ph_lo = p; a.ph_hi = p + 1; hipLaunchKernelGGL(fwd_kernel, dim3(grid), dim3(NTHREADS), LDS_BYTES, stream, a); }
}
```
